# Optimizing an MI355X kernel written in HIP

```python
import math
import functools
import jax
import jax.numpy as jnp
from jax import lax
import numpy as np

D_MODEL = 1024
BATCH = 32
SEQ = 256
DEPTH = 2
DEC_BATCH = 2
DEC_SEQ = 1024
PAST_LEN = 512

GRID_W = 64
HEAD_DIM = 64
MIX_WIDTH = D_MODEL
GROUP_WIDTH = MIX_WIDTH // 4
H_SWA = GROUP_WIDTH // HEAD_DIM
KV_SWA = H_SWA // 2
WINDOW = 128
BLOCK = 128
H_GQA = GROUP_WIDTH // HEAD_DIM
KV_GQA = H_GQA // 2
HY_CH = GROUP_WIDTH
HY_ORDER = 2
HY_BANDS = 16
HY_EMB = 2 * HY_BANDS + 1
HY_FH = 64
HY_TARGET = 1e-2
HY_FAST = 0.3
HY_SLOW = 1.5
H_GLA = 4
DV_GLA = GROUP_WIDTH // H_GLA
DK_GLA = DV_GLA // 2
GLA_RANK = 16
GLA_CHUNK = 64
GLA_NORM = 16.0
D_FF = 2816
N_MOD = 9
ROPE_THETA = 10000.0
EPS = 1e-6
IN_SIZES = (H_SWA * HEAD_DIM, KV_SWA * HEAD_DIM, KV_SWA * HEAD_DIM,
            3 * HY_CH,
            H_GQA * HEAD_DIM, KV_GQA * HEAD_DIM, KV_GQA * HEAD_DIM,
            H_GLA * DK_GLA, H_GLA * DK_GLA, H_GLA * DV_GLA, 2 * GLA_RANK, H_GLA * DV_GLA)
IN_WIDTH = sum(IN_SIZES)

kernel_name = 'hymba_style_diffusion_prefix_step'


def rms_norm(x, g):
    xf = x.astype(jnp.float32)
    y = xf * lax.rsqrt(jnp.mean(jnp.square(xf), axis=-1, keepdims=True) + EPS)
    return (y * g.astype(jnp.float32)).astype(x.dtype)


def modulation(cond, w_mod, b_mod):
    m = jax.nn.silu(cond) @ w_mod + b_mod
    return jnp.split(m[..., None, :], N_MOD, axis=-1)


def modulate(x, shift, scale):
    return x * (1 + scale) + shift


def swiglu(x, w_in, w_out):
    a, b = jnp.split(x @ w_in, 2, axis=-1)
    return (jax.nn.silu(a) * b) @ w_out


def grid_rope(L):
    rows = L // GRID_W
    r = jnp.repeat(jnp.arange(rows, dtype=jnp.float32), GRID_W)
    col = jnp.tile(jnp.arange(GRID_W, dtype=jnp.float32), rows)
    nf = HEAD_DIM // 4
    inv = ROPE_THETA ** (-jnp.arange(nf, dtype=jnp.float32) / nf)
    ang = jnp.concatenate([r[:, None] * inv, col[:, None] * inv], axis=-1)
    return jnp.cos(ang), jnp.sin(ang)


def apply_rope(x, cos, sin):
    xf = x.astype(jnp.float32)
    x1, x2 = xf[..., :HEAD_DIM // 2], xf[..., HEAD_DIM // 2:]
    c, s = cos[:, None, :], sin[:, None, :]
    return jnp.concatenate([x1 * c - x2 * s, x2 * c + x1 * s], axis=-1).astype(x.dtype)


def dense_attention(q, k, v, sink):
    B, Lq, H, hd = q.shape
    KV = k.shape[2]
    G = H // KV
    nb = Lq // BLOCK
    kf = k.astype(jnp.float32)
    vf = v.astype(jnp.float32)
    qb = q.astype(jnp.float32).reshape(B, nb, BLOCK, KV, G, hd).transpose(1, 0, 2, 3, 4, 5) * (hd ** -0.5)

    def block(qblk):
        s = jnp.einsum('bqkgd,bskd->bkgqs', qblk, kf)
        if sink is not None:
            sk = jnp.broadcast_to(sink.astype(jnp.float32).reshape(1, KV, G, 1, 1), s.shape[:-1] + (1,))
            s = jnp.concatenate([s, sk], axis=-1)
        p = jax.nn.softmax(s, axis=-1)
        if sink is not None:
            p = p[..., :-1]
        return jnp.einsum('bkgqs,bskd->bqkgd', p, vf)

    o = lax.map(block, qb)
    return o.transpose(1, 0, 2, 3, 4, 5).reshape(B, Lq, H, hd).astype(q.dtype)


def window_attention(q, k, v, k_ctx, v_ctx, sink):
    B, L, H, hd = q.shape
    KV = k.shape[2]
    G = H // KV
    nb = L // BLOCK
    f32 = jnp.float32
    qb = q.astype(f32).reshape(B, nb, BLOCK, KV, G, hd) * (hd ** -0.5)

    def band(x):
        xb = x.astype(f32).reshape(B, nb, BLOCK, KV, hd)
        z = jnp.zeros_like(xb[:, :1])
        prev = jnp.concatenate([z, xb[:, :-1]], axis=1)
        nxt = jnp.concatenate([xb[:, 1:], z], axis=1)
        return jnp.concatenate([prev, xb, nxt], axis=2)

    kb, vb = band(k), band(v)
    qpos = jnp.arange(nb)[:, None] * BLOCK + jnp.arange(BLOCK)[None, :]
    kpos = (jnp.arange(nb)[:, None] - 1) * BLOCK + jnp.arange(3 * BLOCK)[None, :]
    valid = ((jnp.abs(qpos[:, :, None] - kpos[:, None, :]) <= WINDOW)
             & (kpos[:, None, :] >= 0) & (kpos[:, None, :] < L))
    s_loc = jnp.where(valid, jnp.einsum('bnqkgd,bnskd->bkgnqs', qb, kb), -1e30)
    s_ctx = jnp.einsum('bnqkgd,bckd->bkgnqc', qb, k_ctx.astype(f32))
    s_sink = jnp.broadcast_to(sink.astype(f32).reshape(1, KV, G, 1, 1, 1), s_loc.shape[:-1] + (1,))
    p = jax.nn.softmax(jnp.concatenate([s_loc, s_ctx, s_sink], axis=-1), axis=-1)
    nloc = 3 * BLOCK
    nctx = k_ctx.shape[1]
    o = (jnp.einsum('bkgnqs,bnskd->bnqkgd', p[..., :nloc], vb)
         + jnp.einsum('bkgnqc,bckd->bnqkgd', p[..., nloc:nloc + nctx], v_ctx.astype(f32)))
    return o.reshape(B, L, H, hd).astype(q.dtype)


def short_conv(u, w, b):
    up = jnp.pad(u, ((0, 0), (1, 1), (0, 0)))
    return up[:, :-2] * w[0] + up[:, 1:-1] * w[1] + up[:, 2:] * w[2] + b


def hyena_kernels(L, lp):
    f32 = jnp.float32
    t = jnp.linspace(0.0, 1.0, L, dtype=f32)[:, None]
    w = (2.0 * math.pi / L) * jnp.arange(L, dtype=f32)[:, None]
    bands = jnp.linspace(1e-4, HY_BANDS - 1, HY_BANDS, dtype=f32)[None, :]
    z = jnp.concatenate([t, jnp.cos(bands * w), -jnp.sin(bands * w)], axis=-1)
    freq = lp['hy_freq'].astype(f32)
    h = jnp.sin(freq[0] * (z @ lp['hy_w1'].astype(f32) + lp['hy_b1'].astype(f32)))
    h = jnp.sin(freq[1] * (h @ lp['hy_w2'].astype(f32) + lp['hy_b2'].astype(f32)))
    h = (h @ lp['hy_w3'].astype(f32)).reshape(L, 2, HY_ORDER, HY_CH)
    deltas = jnp.linspace(math.log(HY_TARGET) / HY_SLOW, math.log(HY_TARGET) / HY_FAST, HY_CH, dtype=f32)
    h = h * jnp.exp(-t * jnp.abs(deltas))[:, None, None, :]
    k2 = jnp.concatenate([h[:, 0], jnp.zeros((1, HY_ORDER, HY_CH), f32), h[:0:-1, 1]], axis=0)
    return jnp.fft.rfft(k2, axis=0)


def long_conv(u, kf, bias):
    L = u.shape[1]
    U = jnp.fft.rfft(u, n=2 * L, axis=1)
    y = jnp.fft.irfft(U * kf[None], n=2 * L, axis=1)[:, :L]
    return y + u * bias


def hyena_mixer(z, lp):
    L = z.shape[1]
    z = short_conv(z, lp['hy_conv_w'], lp['hy_conv_b']).astype(jnp.float32)
    v, x1, x2 = jnp.split(z, 3, axis=-1)
    kf = hyena_kernels(L, lp)
    bias = lp['hy_bias'].astype(jnp.float32)
    y = x1 * long_conv(v, kf[:, 0], bias[0])
    y = x2 * long_conv(y, kf[:, 1], bias[1])
    return y


def gla_scan(q, k, v, g, s0):
    B, L, H, DK = q.shape
    DV = v.shape[-1]
    C = GLA_CHUNK
    n = L // C
    q, k, v, g = (x.astype(jnp.float32).reshape(B, n, C, H, x.shape[-1]) for x in (q, k, v, g))
    b = jnp.cumsum(g, axis=2)
    b_last = b[:, :, -1:]
    q_t = q * jnp.exp(b) * (DK ** -0.5)
    k_t = k * jnp.exp(-b)
    k_e = k * jnp.exp(b_last - b)
    mask = jnp.tril(jnp.ones((C, C), dtype=bool))
    att = jnp.where(mask, jnp.einsum('bnihd,bnjhd->bnhij', q_t, k_t), 0.0)
    o_intra = jnp.einsum('bnhij,bnjhv->bnihv', att, v)
    contrib = jnp.einsum('bnjhd,bnjhv->nbhdv', k_e, v)
    decay = jnp.exp(b_last[:, :, 0]).transpose(1, 0, 2, 3)

    def step(S, inp):
        dec, add = inp
        return dec[..., None] * S + add, S

    s_final, s_prev = lax.scan(step, s0.astype(jnp.float32), (decay, contrib))
    o_inter = jnp.einsum('bnihd,nbhdv->bnihv', q_t, s_prev)
    return (o_intra + o_inter).reshape(B, L, H, DV), s_final


def gla_bidir(q, k, v, gl, lp, s0_fwd, s0_bwd):
    B, L = q.shape[:2]
    logits = jnp.einsum('blzr,zrd->blzd', gl, lp['gla_gate_w']) + lp['gla_gate_b']
    g = (jax.nn.log_sigmoid(logits.astype(jnp.float32)) / GLA_NORM).reshape(B, L, 2, H_GLA, DK_GLA)
    o_f, s_f = gla_scan(q, k, v, g[:, :, 0], s0_fwd)
    flip = lambda x: x[:, ::-1]
    o_b, s_b = gla_scan(flip(q), flip(k), flip(v), flip(g[:, :, 1]), s0_bwd)
    return o_f + flip(o_b), jnp.stack([s_f, s_b], axis=1)


def project(u, lp):
    B, L, _ = u.shape
    idx = np.cumsum(IN_SIZES)[:-1].tolist()
    qa, ka, va, hy, qc, kc, vc, qd, kd, vd, gd, rd = jnp.split(u @ lp['w_in'], idx, axis=-1)
    heads = lambda t, h, d: t.reshape(B, L, h, d)
    qkg = lp['qk_norm_g']
    return (heads(qa, H_SWA, HEAD_DIM), heads(ka, KV_SWA, HEAD_DIM), heads(va, KV_SWA, HEAD_DIM), hy,
            rms_norm(heads(qc, H_GQA, HEAD_DIM), qkg[0]), rms_norm(heads(kc, KV_GQA, HEAD_DIM), qkg[1]),
            heads(vc, KV_GQA, HEAD_DIM),
            heads(qd, H_GLA, DK_GLA), heads(kd, H_GLA, DK_GLA), heads(vd, H_GLA, DV_GLA),
            gd.reshape(B, L, 2, GLA_RANK), rd)


def merge_groups(oa, ob, oc, od, rd, lp):
    B, L = oa.shape[:2]
    ga, gb, gc, gd = jnp.split(lp['mix_g'], 4)
    dt = rd.dtype
    ya = rms_norm(oa.reshape(B, L, GROUP_WIDTH), ga)
    yb = rms_norm(ob.astype(dt), gb)
    yc = rms_norm(oc.reshape(B, L, GROUP_WIDTH), gc)
    yd = rms_norm(od.astype(dt), gd.reshape(H_GLA, DV_GLA)).reshape(B, L, GROUP_WIDTH) * jax.nn.silu(rd)
    return jnp.concatenate([ya, yb.astype(dt), yc, yd], axis=-1) @ lp['w_out']


def mixer_context(u, lp):
    B = u.shape[0]
    qa, ka, va, hy, qc, kc, vc, qd, kd, vd, gd, rd = project(u, lp)
    oa = dense_attention(qa, ka, va, lp['swa_sink'])
    ob = hyena_mixer(hy, lp)
    oc = dense_attention(qc, kc, vc, None)
    s0 = jnp.zeros((B, H_GLA, DK_GLA, DV_GLA), jnp.float32)
    od, st = gla_bidir(qd, kd, vd, gd, lp, s0, s0)
    return merge_groups(oa, ob, oc, od, rd, lp), (ka, va, kc, vc, st.astype(u.dtype))


def mixer_latent(u, lp, ck_a, cv_a, ck_c, cv_c, st):
    L = u.shape[1]
    cos, sin = grid_rope(L)
    qa, ka, va, hy, qc, kc, vc, qd, kd, vd, gd, rd = project(u, lp)
    oa = window_attention(apply_rope(qa, cos, sin), apply_rope(ka, cos, sin), va, ck_a, cv_a, lp['swa_sink'])
    ob = hyena_mixer(hy, lp)
    k_all = jnp.concatenate([apply_rope(kc, cos, sin), ck_c.astype(kc.dtype)], axis=1)
    v_all = jnp.concatenate([vc, cv_c.astype(vc.dtype)], axis=1)
    oc = dense_attention(apply_rope(qc, cos, sin), k_all, v_all, None)
    od, _ = gla_bidir(qd, kd, vd, gd, lp, st[:, 0], st[:, 1])
    return merge_groups(oa, ob, oc, od, rd, lp), ()


def trunk_layer(x, cond, lp, mixer):
    sh1, sc1, g1, sh2, sc2, g2, sh3, sc3, g3 = modulation(cond, lp['w_mod'], lp['b_mod'])
    ng = lp['norm_g']
    h = x + 0.5 * g1 * swiglu(modulate(rms_norm(x, ng[0]), sh1, sc1), lp['ffn_w_in'][0], lp['ffn_w_out'][0])
    mix, ctx_tensors = mixer(modulate(rms_norm(h, ng[1]), sh2, sc2))
    h = h + g2 * mix
    h = h + 0.5 * g3 * swiglu(modulate(rms_norm(h, ng[2]), sh3, sc3), lp['ffn_w_in'][1], lp['ffn_w_out'][1])
    return h, ctx_tensors


def setup_inputs(seed: int = 0) -> dict:
    key = jax.random.key(seed)
    ks = jax.random.split(key, 32)
    f32 = jnp.float32
    nrm = lambda i, shape, scale: jax.random.normal(ks[i], shape, f32) * scale
    D = D_MODEL
    return {
        'x_prompt': nrm(0, (BATCH, SEQ, D), 1.0),
        'x_sample': nrm(1, (DEC_BATCH, DEC_SEQ, D), 1.0),
        'cache_swa_k': nrm(2, (DEC_BATCH, DEPTH, PAST_LEN, KV_SWA, HEAD_DIM), 1.0),
        'cache_swa_v': nrm(3, (DEC_BATCH, DEPTH, PAST_LEN, KV_SWA, HEAD_DIM), 1.0),
        'cache_gqa_k': nrm(4, (DEC_BATCH, DEPTH, PAST_LEN, KV_GQA, HEAD_DIM), 1.0),
        'cache_gqa_v': nrm(5, (DEC_BATCH, DEPTH, PAST_LEN, KV_GQA, HEAD_DIM), 1.0),
        'state_gla': nrm(6, (DEC_BATCH, DEPTH, 2, H_GLA, DK_GLA, DV_GLA), 0.3),
        'c': nrm(7, (DEC_BATCH, D), 1.0),
        'c_ctx': nrm(8, (D,), 1.0),
        'w_mod': nrm(9, (DEPTH, D, N_MOD * D), D ** -0.5),
        'b_mod': nrm(10, (DEPTH, N_MOD * D), 0.02),
        'norm_g': 1.0 + nrm(11, (DEPTH, 3, D), 0.02),
        'ffn_w_in': nrm(12, (DEPTH, 2, D, 2 * D_FF), D ** -0.5),
        'ffn_w_out': nrm(13, (DEPTH, 2, D_FF, D), D_FF ** -0.5),
        'w_in': nrm(14, (DEPTH, D, IN_WIDTH), D ** -0.5),
        'w_out': nrm(15, (DEPTH, MIX_WIDTH, D), MIX_WIDTH ** -0.5),
        'mix_g': 1.0 + nrm(16, (DEPTH, MIX_WIDTH), 0.02),
        'swa_sink': nrm(17, (DEPTH, H_SWA), 0.5),
        'qk_norm_g': 1.0 + nrm(18, (DEPTH, 2, HEAD_DIM), 0.02),
        'hy_conv_w': nrm(19, (DEPTH, 3, 3 * HY_CH), 3 ** -0.5),
        'hy_conv_b': nrm(20, (DEPTH, 3 * HY_CH), 0.02),
        'hy_w1': nrm(21, (DEPTH, HY_EMB, HY_FH), HY_EMB ** -0.5),
        'hy_b1': nrm(22, (DEPTH, HY_FH), 0.02),
        'hy_w2': nrm(23, (DEPTH, HY_FH, HY_FH), HY_FH ** -0.5),
        'hy_b2': nrm(24, (DEPTH, HY_FH), 0.02),
        'hy_w3': nrm(25, (DEPTH, HY_FH, 2 * HY_ORDER * HY_CH), HY_FH ** -0.5),
        'hy_freq': 1.0 + nrm(26, (DEPTH, 2, HY_FH), 0.02),
        'hy_bias': nrm(27, (DEPTH, HY_ORDER, HY_CH), 0.1),
        'gla_gate_w': nrm(28, (DEPTH, 2, GLA_RANK, H_GLA * DK_GLA), GLA_RANK ** -0.5),
        'gla_gate_b': nrm(29, (DEPTH, 2, H_GLA * DK_GLA), 0.02),
        'final_g': 1.0 + nrm(30, (D,), 0.02),
    }


def reference(x_prompt, x_sample, cache_swa_k, cache_swa_v, cache_gqa_k, cache_gqa_v, state_gla, c,
              c_ctx, w_mod, b_mod, norm_g, ffn_w_in, ffn_w_out, w_in, w_out, mix_g, swa_sink, qk_norm_g,
              hy_conv_w, hy_conv_b, hy_w1, hy_b1, hy_w2, hy_b2, hy_w3, hy_freq, hy_bias,
              gla_gate_w, gla_gate_b, final_g):
    def layer_params(l):
        return {'w_mod': w_mod[l], 'b_mod': b_mod[l], 'norm_g': norm_g[l], 'ffn_w_in': ffn_w_in[l],
                'ffn_w_out': ffn_w_out[l], 'w_in': w_in[l], 'w_out': w_out[l], 'mix_g': mix_g[l],
                'swa_sink': swa_sink[l], 'qk_norm_g': qk_norm_g[l], 'hy_conv_w': hy_conv_w[l],
                'hy_conv_b': hy_conv_b[l], 'hy_w1': hy_w1[l], 'hy_b1': hy_b1[l], 'hy_w2': hy_w2[l],
                'hy_b2': hy_b2[l], 'hy_w3': hy_w3[l], 'hy_freq': hy_freq[l], 'hy_bias': hy_bias[l],
                'gla_gate_w': gla_gate_w[l], 'gla_gate_b': gla_gate_b[l]}

    hp = x_prompt
    ks_a, vs_a, ks_c, vs_c, sts = [], [], [], [], []
    for l in range(DEPTH):
        lp = layer_params(l)
        hp, (ka, va, kc, vc, st) = trunk_layer(hp, c_ctx, lp, functools.partial(mixer_context, lp=lp))
        ks_a.append(ka)
        vs_a.append(va)
        ks_c.append(kc)
        vs_c.append(vc)
        sts.append(st)
    y_prompt = rms_norm(hp, final_g)
    new_swa_k = jnp.stack(ks_a, axis=1)
    new_swa_v = jnp.stack(vs_a, axis=1)
    new_gqa_k = jnp.stack(ks_c, axis=1)
    new_gqa_v = jnp.stack(vs_c, axis=1)
    new_state_gla = jnp.stack(sts, axis=1)

    hs = x_sample
    for l in range(DEPTH):
        lp = layer_params(l)
        mixer = functools.partial(mixer_latent, lp=lp, ck_a=cache_swa_k[:, l], cv_a=cache_swa_v[:, l],
                                  ck_c=cache_gqa_k[:, l], cv_c=cache_gqa_v[:, l], st=state_gla[:, l])
        hs, _ = trunk_layer(hs, c, lp, mixer)
    y_sample = rms_norm(hs, final_g)
    return (y_prompt, y_sample, new_swa_k, new_swa_v, new_gqa_k, new_gqa_v, new_state_gla)
```

```cpp
#include <hip/hip_runtime.h>
#include <hip/hip_cooperative_groups.h>
#include <cstdio>
#include <cstdint>
namespace cg = cooperative_groups;

#define DI __device__ __forceinline__
typedef unsigned short bf16_t;
typedef short bf16x8 __attribute__((ext_vector_type(8)));
typedef float f32x4 __attribute__((ext_vector_type(4)));
typedef float f32x16 __attribute__((ext_vector_type(16)));
typedef unsigned u32x4 __attribute__((ext_vector_type(4)));
typedef unsigned u32x2 __attribute__((ext_vector_type(2)));
typedef __bf16 bf16x2_t __attribute__((ext_vector_type(2)));
typedef float f32x2_t __attribute__((ext_vector_type(2)));

DI unsigned cvtpk(float lo, float hi) { f32x2_t v = {lo, hi}; bf16x2_t b = __builtin_convertvector(v, bf16x2_t); return __builtin_bit_cast(unsigned, b); }
DI float bf2f(bf16_t x) { return __uint_as_float(((unsigned)x) << 16); }
DI bf16_t f2bf(float x) { return (bf16_t)(cvtpk(x, 0.f) & 0xffffu); }
DI float bflo(unsigned w) { return __uint_as_float(w << 16); }
DI float bfhi(unsigned w) { return __uint_as_float(w & 0xffff0000u); }
DI float wave_sum(float v) {
#pragma unroll
  for (int o = 32; o >= 1; o >>= 1) v += __shfl_xor(v, o, 64);
  return v;
}
DI float siluf(float a) { return a * __builtin_amdgcn_rcpf(1.f + __expf(-a)); }
DI int crow(int r, int hi) { return (r & 3) + 8 * (r >> 2) + 4 * hi; }

constexpr int MT = 10240, MCTX = 8192, DM = 1024, DFF = 2816, NINP = 2816, NIN = 2592, UW = 1824;
constexpr int U_QA = 0, U_KA = 256, U_VA = 384, U_QC = 512, U_KC = 768, U_VC = 896, U_QD = 1024, U_KD = 1152, U_VD = 1280, U_GD = 1536, U_RD = 1568;
constexpr float EPSF = 1e-6f;
constexpr float QSCALE = 0.125f * 1.4426950408889634f;
constexpr size_t OUT_SWAK = 10485760, OUT_SWAV = 12582912, OUT_GQAK = 14680064, OUT_GQAV = 16777216, OUT_STATE = 18874368;
constexpr size_t WS_CTL = 0;
constexpr size_t WS_WFI = 4096;
constexpr size_t WS_WFO = WS_WFI + (size_t)4 * 5632 * 1024 * 2;
constexpr size_t WS_WIN = WS_WFO + (size_t)4 * 1024 * 2816 * 2;
constexpr size_t WS_WOUT = WS_WIN + (size_t)2 * 2816 * 1024 * 2;
constexpr size_t WS_MOD = WS_WOUT + (size_t)2 * 1024 * 1024 * 2;
constexpr size_t WS_FILT = WS_MOD + (size_t)2 * 3 * 9216 * 4;
constexpr size_t WS_XN = WS_FILT + (size_t)2 * 2 * 256 * 2560 * 2;
constexpr size_t WS_ACT = WS_XN + (size_t)MT * 1024 * 2;
constexpr size_t WS_H = WS_ACT + (size_t)MT * 2816 * 2;
constexpr size_t WS_O = WS_H + (size_t)MT * 1024 * 4;
constexpr size_t WS_OBT = WS_O + (size_t)MT * 768 * 2;
constexpr size_t WS_HYT = WS_OBT + (size_t)256 * MT * 2;
constexpr size_t WS_Y1T = WS_HYT + (size_t)768 * MT * 2;
constexpr size_t WS_OD = WS_Y1T + (size_t)256 * MT * 2;
constexpr size_t WS_GLC = WS_OD + (size_t)MT * 256 * 4;
constexpr size_t WS_GLD = WS_GLC + (size_t)160 * 4 * 2 * 2048 * 4;
constexpr size_t WS_END = WS_GLD + (size_t)160 * 4 * 2 * 32 * 4;
constexpr int LDS_BYTES = 147456;
constexpr int LDS_CTL_OFF = LDS_BYTES - 64;

struct Args { const float* in[31]; float* out; unsigned char* ws; int ph_lo, ph_hi; };
typedef const __attribute__((address_space(4))) Args CArgs;


DI int BID() { int b = blockIdx.x; asm volatile("" : "+s"(b)); return b; }
namespace pg8 {
#define PG8_LAS __attribute__((address_space(3)))
typedef unsigned short bf16_t;
typedef short bf16x8 __attribute__((ext_vector_type(8)));
typedef float f32x4 __attribute__((ext_vector_type(4)));
typedef unsigned u32x4 __attribute__((ext_vector_type(4)));
constexpr int BM = 256, BK = 64, HALF = 128, HTB = HALF * BK * 2  , STAGE_BYTES = 8 * HTB, NXCD = 8, WGM = 8;

__host__ __device__ __forceinline__ int lds_byte(int r, int c) { const int st = (r >> 4) * 2 + (c >> 5), rr = r & 15, cc = c & 31, ob = rr * 64 + cc * 2; return st * 1024 + (ob ^ (((ob >> 9) & 1) << 5)); }
__host__ __device__ __forceinline__ void stage_rc(int b, int& R, int& C) { const int st = b / 1024, sb = b % 1024, swz = sb ^ (((sb >> 9) & 1) << 5); R = (st >> 1) * 16 + swz / 64; C = (st & 1) * 32 + (swz % 64) / 2; }
__host__ __device__ __forceinline__ int perm32(int rho) { const int n = rho >> 4, i = rho & 15; return 8 * (i >> 2) + 4 * n + (i & 3); }

struct Unit { int pm, pn; };
struct Gemm { const bf16_t* A; const bf16_t* Bt; int M, N, K; };

struct StaticOrder {
    int nM, nN, nwg, G, c;
    __host__ __device__ void init(int M, int N, int G_, int c_) { nM = M / BM; nN = N / BM; nwg = nM * nN; G = G_; c = c_; }
    __host__ __device__ bool next(int i, Unit& u) const {
        const long L = (long)i * G + c; if (L >= nwg) return false;
        int wgid = (int)L; { const int q = nwg / NXCD, r = nwg % NXCD, xcd = wgid % NXCD, off = wgid / NXCD; wgid = (xcd < r ? xcd * (q + 1) : r * (q + 1) + (xcd - r) * q) + off; }
        const int nig = WGM * nN, gid = wgid / nig, fm = gid * WGM, gsz = (nM - fm) < WGM ? (nM - fm) : WGM;
        u.pm = fm + ((wgid % nig) % gsz); u.pn = (wgid % nig) / gsz; return true;
    }
    __device__ __forceinline__ void a_ready(const Unit&) const {}
    __device__ __forceinline__ void done(const Unit&) const {}
};
template <class Epi, class Sched, bool ALIGN_EPI = false, bool SP2 = false>
__device__ __forceinline__ void gemm_phase(PG8_LAS unsigned char* lds, const Gemm g, const Sched& S, const Epi& E) {
    int tid_l = threadIdx.x; asm volatile("" : "+v"(tid_l));
    const int tid = tid_l, wid = __builtin_amdgcn_readfirstlane(tid >> 6), lane = tid & 63, wr = wid >> 2, wc = wid & 3, fr = lane & 15, fq = lane >> 4;
    const int K = g.K, nt = K / BK;
    unsigned voffA[2], voffB[2];
#pragma unroll
    for (int i = 0; i < 2; ++i) { int R, C; stage_rc(tid * 16 + i * 8192, R, C); const int Rb = Epi::PERM ? ((R & ~31) + perm32(R & 31)) : R;
        voffA[i] = (unsigned)(R * K + C) * 2u; voffB[i] = (unsigned)(Rb * K + C) * 2u; }
    const size_t kstep = (size_t)(BK * 2);
    const size_t hstep = (size_t)HALF * K * 2;
    const size_t tstep = 2 * hstep;
    const unsigned ldsw = (unsigned)wid * 1024u;
    const int aoff = lds_byte(wr * 64 + fr, fq * 8), boff = lds_byte(wc * 32 + fr, fq * 8);
#define PG8_SA(b, h) (((b) * 2 + (h)) * HTB)
#define PG8_SB(b, h) ((4 + (b) * 2 + (h)) * HTB)
#define PG8_STAGE(bufoff, gbase, voff) do { _Pragma("unroll") for (int _i = 0; _i < 2; ++_i) \
        __builtin_amdgcn_global_load_lds((const unsigned*)((const char*)(gbase) + (voff)[_i]), (PG8_LAS unsigned*)(lds + (bufoff) + ldsw + _i * 8192), 16, 0, 0); } while (0)
#define PG8_LDA(dst, b, h) do { _Pragma("unroll") for (int m = 0; m < 4; ++m) _Pragma("unroll") for (int k = 0; k < 2; ++k) dst[m][k] = *(const PG8_LAS bf16x8*)(lds + PG8_SA(b, h) + aoff + m * 2048 + k * 1024); } while (0)
#define PG8_LDB(dst, b, h) do { _Pragma("unroll") for (int n = 0; n < 2; ++n) _Pragma("unroll") for (int k = 0; k < 2; ++k) dst[n][k] = *(const PG8_LAS bf16x8*)(lds + PG8_SB(b, h) + boff + n * 2048 + k * 1024); } while (0)
#define PG8_MMA(ai, bj, At, Bt) do { __builtin_amdgcn_s_setprio(1); _Pragma("unroll") for (int m = 0; m < 4; ++m) _Pragma("unroll") for (int n = 0; n < 2; ++n) _Pragma("unroll") for (int k = 0; k < 2; ++k) \
        acc[ai][bj][m][n] = __builtin_amdgcn_mfma_f32_16x16x32_bf16(Bt[n][k], At[m][k], acc[ai][bj][m][n], 0, 0, 0); __builtin_amdgcn_s_setprio(0); } while (0)
#define PG8_WAIT_V(n) asm volatile("s_waitcnt vmcnt(" #n ")" ::: "memory")
#define PG8_WAIT_L(n) asm volatile("s_waitcnt lgkmcnt(" #n ")" ::: "memory")
#define PG8_BAR __builtin_amdgcn_s_barrier()
#define PG8_SCHED __builtin_amdgcn_sched_barrier(0)
    Unit cur, nxt; int ui = 0;
    if (!S.next(0, cur)) return;
    f32x4 acc[2][2][4][2];
#pragma unroll
    for (int a = 0; a < 2; ++a)
#pragma unroll
        for (int b = 0; b < 2; ++b)
#pragma unroll
            for (int m = 0; m < 4; ++m)
#pragma unroll
                for (int n = 0; n < 2; ++n) acc[a][b][m][n] = (f32x4){0.f, 0.f, 0.f, 0.f};
    bf16x8 At[4][2], B0[2][2], B1[2][2];
    const char* cA = (const char*)g.A + (size_t)cur.pm * tstep; const char* cB = (const char*)g.Bt + (size_t)cur.pn * tstep;
    S.a_ready(cur);
    if constexpr (SP2) {
        PG8_STAGE(PG8_SB(0, 0), cB, voffB); PG8_STAGE(PG8_SB(0, 1), cB + hstep, voffB); PG8_STAGE(PG8_SA(0, 0), cA, voffA); PG8_STAGE(PG8_SA(0, 1), cA + hstep, voffA);
        if (wr == 1) PG8_BAR;
        PG8_WAIT_V(2); PG8_BAR;
        PG8_STAGE(PG8_SB(1, 0), cB + kstep, voffB); PG8_STAGE(PG8_SA(1, 0), cA + kstep, voffA); PG8_STAGE(PG8_SB(1, 1), cB + hstep + kstep, voffB);
        PG8_WAIT_V(6); PG8_BAR;
    } else {
        PG8_STAGE(PG8_SB(0, 0), cB, voffB); PG8_STAGE(PG8_SA(0, 0), cA, voffA); PG8_STAGE(PG8_SB(0, 1), cB + hstep, voffB); PG8_STAGE(PG8_SA(0, 1), cA + hstep, voffA);
        if (wr == 1) PG8_BAR;
        PG8_WAIT_V(4); PG8_BAR;
        PG8_STAGE(PG8_SB(1, 0), cB + kstep, voffB); PG8_STAGE(PG8_SA(1, 0), cA + kstep, voffA); PG8_STAGE(PG8_SB(1, 1), cB + hstep + kstep, voffB);
        PG8_WAIT_V(6); PG8_BAR;
    }
    for (;;) {
        const bool has_next = S.next(ui + 1, nxt);
        const char* nA = has_next ? (const char*)g.A + (size_t)nxt.pm * tstep : cA; const char* nB = has_next ? (const char*)g.Bt + (size_t)nxt.pn * tstep : cB;
        for (int t = 0; t < nt; t += 2) {
            const bool last = (t == nt - 2);
            const char* a1 = cA + (size_t)(t + 1) * kstep;
            const char* a2 = last ? nA : cA + (size_t)(t + 2) * kstep; const char* b2 = last ? nB : cB + (size_t)(t + 2) * kstep;
            const char* a3 = a2 + kstep; const char* b3 = b2 + kstep;
            if (last && has_next) S.a_ready(nxt);
            if constexpr (SP2) {
            PG8_LDB(B0, 0, 0); PG8_LDB(B1, 0, 1); PG8_SCHED; PG8_LDA(At, 0, 0); PG8_STAGE(PG8_SA(1, 1), a1 + hstep, voffA);
            PG8_WAIT_V(8); PG8_WAIT_L(0); PG8_BAR; PG8_MMA(0, 0, At, B0); PG8_MMA(0, 1, At, B1); PG8_BAR; PG8_SCHED;
            PG8_LDA(At, 0, 1); PG8_STAGE(PG8_SB(0, 0), b2, voffB); PG8_STAGE(PG8_SB(0, 1), b2 + hstep, voffB); PG8_STAGE(PG8_SA(0, 0), a2, voffA);
            PG8_WAIT_V(8); PG8_WAIT_L(0); PG8_BAR; PG8_MMA(1, 0, At, B0); PG8_MMA(1, 1, At, B1); PG8_BAR; PG8_SCHED;
            PG8_LDB(B0, 1, 0); PG8_LDB(B1, 1, 1); PG8_SCHED; PG8_LDA(At, 1, 0); PG8_STAGE(PG8_SA(0, 1), a2 + hstep, voffA);
            PG8_WAIT_V(8); PG8_WAIT_L(0); PG8_BAR; PG8_MMA(0, 0, At, B0); PG8_MMA(0, 1, At, B1); PG8_BAR; PG8_SCHED;
            PG8_LDA(At, 1, 1); PG8_STAGE(PG8_SB(1, 0), b3, voffB); PG8_STAGE(PG8_SB(1, 1), b3 + hstep, voffB); PG8_STAGE(PG8_SA(1, 0), a3, voffA);
            PG8_WAIT_V(8); PG8_WAIT_L(0); PG8_BAR; PG8_MMA(1, 0, At, B0); PG8_MMA(1, 1, At, B1); PG8_BAR; PG8_SCHED;
            } else {
            PG8_LDB(B0, 0, 0); PG8_SCHED; PG8_LDA(At, 0, 0); PG8_STAGE(PG8_SA(1, 1), a1 + hstep, voffA);
            PG8_WAIT_L(8); PG8_BAR; PG8_WAIT_L(0); PG8_MMA(0, 0, At, B0); PG8_BAR; PG8_SCHED;
            PG8_LDB(B1, 0, 1); PG8_STAGE(PG8_SB(0, 0), b2, voffB);
            PG8_BAR; PG8_WAIT_L(0); PG8_MMA(0, 1, At, B1); PG8_BAR;
            PG8_LDA(At, 0, 1); PG8_STAGE(PG8_SA(0, 0), a2, voffA);
            PG8_BAR; PG8_WAIT_L(0); PG8_MMA(1, 0, At, B0); PG8_BAR; PG8_SCHED;
            PG8_STAGE(PG8_SB(0, 1), b2 + hstep, voffB);
            PG8_WAIT_V(6); PG8_BAR; PG8_MMA(1, 1, At, B1); PG8_BAR;
            PG8_LDB(B0, 1, 0); PG8_SCHED; PG8_LDA(At, 1, 0); PG8_STAGE(PG8_SA(0, 1), a2 + hstep, voffA);
            PG8_WAIT_L(8); PG8_BAR; PG8_WAIT_L(0); PG8_MMA(0, 0, At, B0); PG8_BAR; PG8_SCHED;
            PG8_LDB(B1, 1, 1); PG8_STAGE(PG8_SB(1, 0), b3, voffB);
            PG8_BAR; PG8_WAIT_L(0); PG8_MMA(0, 1, At, B1); PG8_BAR;
            PG8_LDA(At, 1, 1); PG8_STAGE(PG8_SA(1, 0), a3, voffA);
            PG8_BAR; PG8_WAIT_L(0); PG8_MMA(1, 0, At, B0); PG8_BAR; PG8_SCHED;
            PG8_STAGE(PG8_SB(1, 1), b3 + hstep, voffB);
            PG8_WAIT_V(6); PG8_BAR; PG8_MMA(1, 1, At, B1); PG8_BAR;
            }
        }
        if constexpr (ALIGN_EPI) { if (wr == 0) PG8_BAR; }
        if constexpr (!Epi::AFTER_DRAIN) { E(acc, cur, wr, wc, fr, fq); S.done(cur); }
        if (!has_next) break;
#pragma unroll
        for (int a = 0; a < 2; ++a)
#pragma unroll
            for (int b = 0; b < 2; ++b)
#pragma unroll
                for (int m = 0; m < 4; ++m)
#pragma unroll
                    for (int n = 0; n < 2; ++n) acc[a][b][m][n] = (f32x4){0.f, 0.f, 0.f, 0.f};
        cur = nxt; cA = nA; cB = nB; ++ui;
        if constexpr (ALIGN_EPI) { if (wr == 1) PG8_BAR; }
    }
    PG8_WAIT_V(0);
    if constexpr (!ALIGN_EPI) { if (wr == 0) PG8_BAR; }
    PG8_BAR;
    if constexpr (Epi::AFTER_DRAIN) { E.fused(acc, cur, wr, wc, fr, fq, lds, wid, lane); S.done(cur); }
#undef PG8_SA
#undef PG8_SB
#undef PG8_STAGE
#undef PG8_LDA
#undef PG8_LDB
#undef PG8_MMA
#undef PG8_WAIT_V
#undef PG8_WAIT_L
#undef PG8_BAR
#undef PG8_SCHED
}
}

struct EpiSwiglu {
  static constexpr bool PERM = true, AFTER_DRAIN = false;
  bf16_t* act;
  DI void operator()(const f32x4 (&acc)[2][2][4][2], const pg8::Unit& u, int wr, int wc, int fr, int fq) const {
    const int row0 = u.pm * 256 + wr * 64 + fr, col0 = u.pn * 128 + wc * 32 + 8 * fq;
#pragma unroll
    for (int ai = 0; ai < 2; ++ai)
#pragma unroll
      for (int m = 0; m < 4; ++m) {
        bf16_t* rowp = act + (size_t)(row0 + ai * 128 + m * 16) * DFF + col0;
        const f32x4 a0 = acc[ai][0][m][0], a1 = acc[ai][0][m][1], b0 = acc[ai][1][m][0], b1 = acc[ai][1][m][1];
        u32x4 w;
        w.x = cvtpk(siluf(a0[0]) * b0[0], siluf(a0[1]) * b0[1]); w.y = cvtpk(siluf(a0[2]) * b0[2], siluf(a0[3]) * b0[3]);
        w.z = cvtpk(siluf(a1[0]) * b1[0], siluf(a1[1]) * b1[1]); w.w = cvtpk(siluf(a1[2]) * b1[2], siluf(a1[3]) * b1[3]);
        *(u32x4*)rowp = w;
      }
  }
};

struct EpiRes {
  static constexpr bool PERM = true, AFTER_DRAIN = false;
  float* h; const float* resA; const float* resB; const float* gate; float coef;
  DI void operator()(const f32x4 (&acc)[2][2][4][2], const pg8::Unit& u, int wr, int wc, int fr, int fq) const {
    const int g = u.pm < 32 ? 0 : (u.pm < 36 ? 1 : 2);
    const float* res = u.pm < 32 ? resA : resB;
    const int row0 = u.pm * 256 + wr * 64 + fr, col0 = u.pn * 256 + wc * 32 + 8 * fq;
    f32x4 gv[2][2];
#pragma unroll
    for (int bj = 0; bj < 2; ++bj)
#pragma unroll
      for (int n = 0; n < 2; ++n) gv[bj][n] = *(const f32x4*)(gate + (size_t)g * 9216 + col0 + bj * 128 + 4 * n) * coef;
#pragma unroll
    for (int ai = 0; ai < 2; ++ai)
#pragma unroll
      for (int m = 0; m < 4; ++m)
#pragma unroll
        for (int bj = 0; bj < 2; ++bj)
#pragma unroll
          for (int n = 0; n < 2; ++n) {
            const size_t idx = (size_t)(row0 + ai * 128 + m * 16) * DM + col0 + bj * 128 + 4 * n;
            const f32x4 r = *(const f32x4*)(res + idx);
            *(f32x4*)(h + idx) = r + gv[bj][n] * acc[ai][bj][m][n];
          }
  }
};

struct EpiInproj {
  static constexpr bool PERM = true, AFTER_DRAIN = false;
  bf16_t* U; bf16_t* HYT; float* out; int l;
  DI void operator()(const f32x4 (&acc)[2][2][4][2], const pg8::Unit& u, int wr, int wc, int fr, int fq) const {
    const int row0 = u.pm * 256 + wr * 64 + fr, cw = wc * 32 + 8 * fq;
    const int pn = u.pn;
    if (pn >= 2 && pn <= 4) {
#pragma unroll
      for (int ai = 0; ai < 2; ++ai)
#pragma unroll
        for (int m = 0; m < 4; ++m)
#pragma unroll
          for (int bj = 0; bj < 2; ++bj)
#pragma unroll
            for (int n = 0; n < 2; ++n)
#pragma unroll
              for (int e = 0; e < 4; ++e) {
                const int c = pn * 256 - 512 + bj * 128 + cw + 4 * n + e, row = row0 + ai * 128 + m * 16;
                HYT[(size_t)c * MT + row] = f2bf(acc[ai][bj][m][n][e]);
              }
    } else {
      const int ub = (pn < 2 ? pn * 256 : pn * 256 - 768) + cw;
#pragma unroll
      for (int ai = 0; ai < 2; ++ai)
#pragma unroll
        for (int m = 0; m < 4; ++m)
#pragma unroll
          for (int bj = 0; bj < 2; ++bj) {
            const int row = row0 + ai * 128 + m * 16;
            const bool ok = (pn < 10) || (bj == 0 && wc == 0);
            if (ok) {
              const f32x4 v0 = acc[ai][bj][m][0], v1 = acc[ai][bj][m][1];
              u32x4 w; w.x = cvtpk(v0[0], v0[1]); w.y = cvtpk(v0[2], v0[3]); w.z = cvtpk(v1[0], v1[1]); w.w = cvtpk(v1[2], v1[3]);
              *(u32x4*)(U + (size_t)row * UW + ub + bj * 128) = w;
              if (u.pm < 32 && (pn == 1 || (pn == 6 && bj == 1))) {
                const int b = row >> 8, t = row & 255;
                const size_t off = (pn == 1 ? (bj == 0 ? OUT_SWAK : OUT_SWAV) : OUT_GQAV) + ((size_t)(b * 512 + l * 256 + t)) * 128 + cw;
                *(f32x4*)(out + off) = v0; *(f32x4*)(out + off + 4) = v1;
              }
            }
          }
    }
  }
};

DI void tr_item(const float* __restrict__ W, int Nsrc, int K, bf16_t* __restrict__ WT, int n0, int sc0, int k0, float* tile, int tid) {
  const int c4 = tid & 15;
#pragma unroll
  for (int rr = 0; rr < 2; ++rr) {
    const int r = (tid >> 4) + 32 * rr, col = sc0 + 4 * c4;
    f32x4 v = {0.f, 0.f, 0.f, 0.f};
    if (col < Nsrc) v = *(const f32x4*)(W + (size_t)(k0 + r) * Nsrc + col);
    float* tp = tile + r * 65 + 4 * c4; tp[0] = v[0]; tp[1] = v[1]; tp[2] = v[2]; tp[3] = v[3];
  }
  __syncthreads();
  const int n = tid >> 3, kq = tid & 7;
  const float* sp = tile + (8 * kq) * 65 + n;
  u32x4 w; w.x = cvtpk(sp[0], sp[65]); w.y = cvtpk(sp[130], sp[195]); w.z = cvtpk(sp[260], sp[325]); w.w = cvtpk(sp[390], sp[455]);
  *(u32x4*)(WT + (size_t)(n0 + n) * K + k0 + 8 * kq) = w;
  __syncthreads();
}

DI void p0_convert(CArgs& a, unsigned char* ldsb, int tid) {
  float* tile = (float*)ldsb;
  bf16_t* WFI = (bf16_t*)(a.ws + WS_WFI); bf16_t* WFO = (bf16_t*)(a.ws + WS_WFO); bf16_t* WIN = (bf16_t*)(a.ws + WS_WIN); bf16_t* WOUT = (bf16_t*)(a.ws + WS_WOUT);
  for (int idx = BID(); idx < 10368; idx += gridDim.x) {
    if (idx < 5632) {
      const int mat = idx / 1408, rem = idx % 1408, nt = rem >> 4, kt = rem & 15, n0 = 64 * nt;
      const int pn = n0 >> 8, bj = (n0 >> 7) & 1, c = n0 & 127, sc0 = bj * 2816 + 128 * pn + c;
      tr_item(a.in[12] + (size_t)mat * 1024 * 5632, 5632, 1024, WFI + (size_t)mat * 5632 * 1024, n0, sc0, 64 * kt, tile, tid);
    } else if (idx < 8448) {
      const int q = idx - 5632, mat = q / 704, rem = q % 704, nt = rem / 44, kt = rem % 44;
      tr_item(a.in[13] + (size_t)mat * 2816 * 1024, 1024, 2816, WFO + (size_t)mat * 1024 * 2816, 64 * nt, 64 * nt, 64 * kt, tile, tid);
    } else if (idx < 9856) {
      const int q = idx - 8448, l = q / 704, rem = q % 704, nt = rem >> 4, kt = rem & 15;
      tr_item(a.in[14] + (size_t)l * 1024 * NIN, NIN, 1024, WIN + (size_t)l * NINP * 1024, 64 * nt, 64 * nt, 64 * kt, tile, tid);
    } else {
      const int q = idx - 9856, l = q >> 8, rem = q & 255, nt = rem >> 4, kt = rem & 15;
      tr_item(a.in[15] + (size_t)l * 1024 * 1024, 1024, 1024, WOUT + (size_t)l * 1024 * 1024, 64 * nt, 64 * nt, 64 * kt, tile, tid);
    }
  }
}

DI void p0_modulation(CArgs& a, unsigned char* ldsb, int tid) {
  float* sc = (float*)ldsb;
  float* red = sc + 3072;
  float* mod = (float*)(a.ws + WS_MOD);
  for (int i = tid; i < 3072; i += 512) { const int g = i >> 10, k = i & 1023; const float x = g == 0 ? a.in[8][k] : a.in[7][(g - 1) * 1024 + k]; sc[i] = x / (1.f + expf(-x)); }
  __syncthreads();
  for (int item = BID(); item < 288; item += gridDim.x) {
    const int l = item / 144, n0 = (item % 144) * 64, cg4 = tid & 15, kg = tid >> 4;
    const float* wp = a.in[9] + (size_t)l * 1024 * 9216 + (size_t)(kg * 32) * 9216 + n0 + 4 * cg4;
    f32x4 acc0 = {0, 0, 0, 0}, acc1 = {0, 0, 0, 0}, acc2 = {0, 0, 0, 0};
#pragma unroll 8
    for (int kk = 0; kk < 32; ++kk) {
      const f32x4 w = *(const f32x4*)(wp + (size_t)kk * 9216);
      const int k = kg * 32 + kk;
      acc0 += w * sc[k]; acc1 += w * sc[1024 + k]; acc2 += w * sc[2048 + k];
    }
    float* rp = red + kg * 192 + 4 * cg4;
#pragma unroll
    for (int e = 0; e < 4; ++e) { rp[e] = acc0[e]; rp[64 + e] = acc1[e]; rp[128 + e] = acc2[e]; }
    __syncthreads();
    if (tid < 192) {
      const int g = tid >> 6, n = tid & 63; float s = 0.f;
      for (int q = 0; q < 32; ++q) s += red[q * 192 + g * 64 + n];
      mod[(size_t)(l * 3 + g) * 9216 + n0 + n] = s + a.in[10][l * 9216 + n0 + n];
    }
    __syncthreads();
  }
}

DI void p0_filters(CArgs& a, unsigned char* ldsb, int tid) {
  float* zs = (float*)ldsb;
  float* h1 = zs + 512;
  float* h2 = h1 + 512;
  bf16_t* F = (bf16_t*)(a.ws + WS_FILT);
  const int w = tid >> 6, lane = tid & 63;
  for (int item = BID(); item < 320; item += gridDim.x) {
    const int l = item / 160, r = item % 160;
    const int L = r < 32 ? 256 : 1024, t = (r < 32 ? 8 * r : 8 * (r - 32)) + w, Loff = r < 32 ? 0 : 512;
    const float tt = (float)t / (float)(L - 1);
    const float wt = (6.283185307179586f / (float)L) * (float)t;
    if (lane < 33) {
      float z;
      if (lane == 0) z = tt;
      else { const int bi = (lane - 1) & 15; const float band = 1e-4f + (float)bi * ((15.f - 1e-4f) / 15.f); z = lane <= 16 ? cosf(band * wt) : -sinf(band * wt); }
      zs[w * 64 + lane] = z;
    }
    __syncthreads();
    { float s = a.in[22][l * 64 + lane];
      for (int i = 0; i < 33; ++i) s += zs[w * 64 + i] * a.in[21][(l * 33 + i) * 64 + lane];
      h1[w * 64 + lane] = sinf(a.in[26][(l * 2 + 0) * 64 + lane] * s); }
    __syncthreads();
    { float s = a.in[24][l * 64 + lane];
      for (int i = 0; i < 64; ++i) s += h1[w * 64 + i] * a.in[23][(l * 64 + i) * 64 + lane];
      h2[w * 64 + lane] = sinf(a.in[26][(l * 2 + 1) * 64 + lane] * s); }
    __syncthreads();
    for (int qq = 0; qq < 16; ++qq) {
      const int col = lane + 64 * qq;
      float s = 0.f;
      for (int i = 0; i < 64; ++i) s += h2[w * 64 + i] * a.in[25][(size_t)(l * 64 + i) * 1024 + col];
      const int dir = col >> 9, o = (col >> 8) & 1, ch = col & 255;
      const float d0 = -4.605170185988091f / 1.5f, d1 = -4.605170185988091f / 0.3f;
      const float delta = d0 + (float)ch * ((d1 - d0) / 255.f);
      s *= expf(-tt * fabsf(delta));
      bf16_t* fp = F + ((size_t)((l * 2 + o) * 256 + ch)) * 2560 + Loff;
      if (dir == 0) fp[L - t] = f2bf(s);
      else { if (t == 0) fp[0] = 0; else fp[L + t] = f2bf(s); }
    }
    __syncthreads();
  }
}

DI const float* xrow(const float* A, const float* B, int row) { return row < MCTX ? A + (size_t)row * DM : B + (size_t)(row - MCTX) * DM; }
DI int grp_of(int row) { return row < MCTX ? 0 : 1 + ((row - MCTX) >> 10); }

DI void norm_mod_phase(const float* srcA, const float* srcB, bf16_t* xn, const float* ng, const float* mod_l, int j, int tid) {
  const int w = tid >> 6, lane = tid & 63;
  for (int row = BID() * 8 + w; row < MT; row += gridDim.x * 8) {
    const float* x = xrow(srcA, srcB, row);
    const float* mg = mod_l + (size_t)grp_of(row) * 9216 + (3 * j) * 1024;
    f32x4 v[4]; float ss = 0.f;
#pragma unroll
    for (int q = 0; q < 4; ++q) { v[q] = *(const f32x4*)(x + 256 * q + 4 * lane); ss += v[q][0] * v[q][0] + v[q][1] * v[q][1] + v[q][2] * v[q][2] + v[q][3] * v[q][3]; }
    ss = wave_sum(ss);
    const float rstd = rsqrtf(ss * (1.f / 1024.f) + EPSF);
#pragma unroll
    for (int q = 0; q < 4; ++q) {
      const int k = 256 * q + 4 * lane;
      const f32x4 g = *(const f32x4*)(ng + k), sh = *(const f32x4*)(mg + k), sc = *(const f32x4*)(mg + 1024 + k);
      const f32x4 y = (v[q] * rstd * g) * (sc + 1.f) + sh;
      u32x2 o; o.x = cvtpk(y[0], y[1]); o.y = cvtpk(y[2], y[3]);
      *(u32x2*)(xn + (size_t)row * DM + k) = o;
    }
  }
}

DI void final_norm_phase(const float* h, float* out, const float* fg, int tid) {
  const int w = tid >> 6, lane = tid & 63;
  for (int row = BID() * 8 + w; row < MT; row += gridDim.x * 8) {
    const float* x = h + (size_t)row * DM;
    f32x4 v[4]; float ss = 0.f;
#pragma unroll
    for (int q = 0; q < 4; ++q) { v[q] = *(const f32x4*)(x + 256 * q + 4 * lane); ss += v[q][0] * v[q][0] + v[q][1] * v[q][1] + v[q][2] * v[q][2] + v[q][3] * v[q][3]; }
    ss = wave_sum(ss);
    const float rstd = rsqrtf(ss * (1.f / 1024.f) + EPSF);
#pragma unroll
    for (int q = 0; q < 4; ++q) { const int k = 256 * q + 4 * lane; *(f32x4*)(out + (size_t)row * DM + k) = v[q] * rstd * *(const f32x4*)(fg + k); }
  }
}

DI void post_proj_phase(bf16_t* U, float* out, const float* qkg, int l, int tid) {
  const int w = tid >> 6, lane = tid & 63;
  for (int row = BID() * 8 + w; row < MT; row += gridDim.x * 8) {
    const bool lat = row >= MCTX;
    float cs = 1.f, sn = 0.f;
    if (lat) {
      const int t = (row - MCTX) & 1023, i = lane & 31, f = i & 15;
      const float inv = exp2f(-(float)f * (13.287712379549449f / 16.f));
      const float ang = (float)(i < 16 ? (t >> 6) : (t & 63)) * inv;
      sincosf(ang, &sn, &cs);
    }
    bf16_t* up = U + (size_t)row * UW;
#pragma unroll
    for (int s = 0; s < 12; ++s) {
      const int base = (s < 4) ? U_QA + 64 * s : (s < 6) ? U_KA + 64 * (s - 4) : (s < 10) ? U_QC + 64 * (s - 6) : U_KC + 64 * (s - 10);
      const bool isq = (s < 4) || (s >= 6 && s < 10), nrm = s >= 6;
      float x = bf2f(up[base + lane]);
      if (nrm) { const float ss = wave_sum(x * x); x = x * rsqrtf(ss * (1.f / 64.f) + EPSF) * qkg[(s < 10 ? 0 : 64) + lane]; }
      if (lat) { const float p = __shfl_xor(x, 32, 64); x = lane < 32 ? x * cs - p * sn : x * cs + p * sn; }
      if (s >= 10 && !lat) { const int b = row >> 8, t = row & 255; out[OUT_GQAK + ((size_t)(b * 512 + l * 256 + t)) * 128 + (s - 10) * 64 + lane] = x; }
      if (isq) x *= QSCALE;
      up[base + lane] = f2bf(x);
    }
  }
}

struct KVRegs { u32x4 k, v; };
constexpr int KROW = 72;
constexpr int KVBUF = 64 * KROW * 2;

DI KVRegs attn_load(const bf16_t* __restrict__ U, int R0, int kcol, int vcol, int k0start, int nt0, const float* __restrict__ ck, const float* __restrict__ cv, int ti, int tid) {
  KVRegs r; const int key = tid >> 3, ds = tid & 7;
  if (ti < nt0) {
    const bf16_t* p = U + (size_t)(R0 + k0start + 64 * ti + key) * UW;
    r.k = *(const u32x4*)(p + kcol + 8 * ds); r.v = *(const u32x4*)(p + vcol + 8 * ds);
  } else {
    const size_t off = (size_t)(64 * (ti - nt0) + key) * 128 + 8 * ds;
    const f32x4 a0 = *(const f32x4*)(ck + off), a1 = *(const f32x4*)(ck + off + 4), b0 = *(const f32x4*)(cv + off), b1 = *(const f32x4*)(cv + off + 4);
    r.k.x = cvtpk(a0[0], a0[1]); r.k.y = cvtpk(a0[2], a0[3]); r.k.z = cvtpk(a1[0], a1[1]); r.k.w = cvtpk(a1[2], a1[3]);
    r.v.x = cvtpk(b0[0], b0[1]); r.v.y = cvtpk(b0[2], b0[3]); r.v.z = cvtpk(b1[0], b1[1]); r.v.w = cvtpk(b1[2], b1[3]);
  }
  return r;
}
DI void attn_write(unsigned char* kb, unsigned char* vb, const KVRegs& r, int tid) {
  const int key = tid >> 3, ds = tid & 7;
  *(u32x4*)(kb + (key * KROW + 8 * ds) * 2) = r.k;
  bf16_t* vt = (bf16_t*)vb + (8 * ds) * KROW + key;
  vt[0] = (bf16_t)(r.v.x & 0xffff); vt[KROW] = (bf16_t)(r.v.x >> 16); vt[2 * KROW] = (bf16_t)(r.v.y & 0xffff); vt[3 * KROW] = (bf16_t)(r.v.y >> 16);
  vt[4 * KROW] = (bf16_t)(r.v.z & 0xffff); vt[5 * KROW] = (bf16_t)(r.v.z >> 16); vt[6 * KROW] = (bf16_t)(r.v.w & 0xffff); vt[7 * KROW] = (bf16_t)(r.v.w >> 16);
}

DI void attn_unit(CArgs& a, int l, int uidx, unsigned char* ldsb, int tid) {
  const bf16_t* U = (const bf16_t*)(a.ws + WS_ACT);
  bf16_t* O = (bf16_t*)(a.ws + WS_O);
  int type, b, kvh, qb;
  if (uidx < 64) { type = uidx < 32 ? 3 : 2; const int j = uidx & 31; b = j >> 4; kvh = (j >> 3) & 1; qb = j & 7; }
  else { type = uidx < 192 ? 0 : 1; const int j = (uidx - 64) & 127; b = j >> 2; kvh = (j >> 1) & 1; qb = j & 1; }
  const bool lat = type >= 2, isA = (type == 0 || type == 2);
  const int R0 = lat ? MCTX + b * 1024 : b * 256;
  const int w = tid >> 6, lane = tid & 63, hh = lane >> 5, l31 = lane & 31, g = w >> 2, head = 2 * kvh + g;
  const int qcol = (isA ? U_QA : U_QC) + head * 64, kcol = (isA ? U_KA : U_KC) + kvh * 64, vcol = (isA ? U_VA : U_VC) + kvh * 64;
  int k0start = 0, nk0 = lat ? 1024 : 256;
  if (type == 2) { const int lo = qb > 0 ? (qb - 1) * 128 : 0, hi = qb < 7 ? (qb + 2) * 128 : 1024; k0start = lo; nk0 = hi - lo; }
  const int nt0 = nk0 >> 6, nt = nt0 + (lat ? 8 : 0);
  const float* ck = nullptr; const float* cv = nullptr;
  if (lat) { const size_t co = ((size_t)((b * 2 + l) * 512)) * 128 + kvh * 64; ck = a.in[isA ? 2 : 4] + co; cv = a.in[isA ? 3 : 5] + co; }
  const int qrow = R0 + qb * 128 + (w & 3) * 32 + l31;
  const int qpos = qb * 128 + (w & 3) * 32 + l31;
  bf16x8 qf[4];
#pragma unroll
  for (int ks = 0; ks < 4; ++ks) qf[ks] = *(const bf16x8*)(U + (size_t)qrow * UW + qcol + 16 * ks + 8 * hh);
  float m_run = -1e30f, l_run = 0.f;
  if (isA) { m_run = a.in[17][l * 4 + head] * 1.4426950408889634f; l_run = hh == 0 ? 1.f : 0.f; }
  f32x16 o0, o1;
#pragma unroll
  for (int i = 0; i < 16; ++i) { o0[i] = 0.f; o1[i] = 0.f; }
  KVRegs regs = attn_load(U, R0, kcol, vcol, k0start, nt0, ck, cv, 0, tid);
  attn_write(ldsb, ldsb + KVBUF, regs, tid);
  __syncthreads();
  for (int ti = 0; ti < nt; ++ti) {
    const int cur = ti & 1;
    if (ti + 1 < nt) regs = attn_load(U, R0, kcol, vcol, k0start, nt0, ck, cv, ti + 1, tid);
    const unsigned char* kb = cur ? ldsb + 2 * KVBUF : ldsb;
    const unsigned char* vb = kb + KVBUF;
    const bool domask = (type == 2) && (ti < nt0);
#pragma unroll
    for (int sub = 0; sub < 2; ++sub) {
      f32x16 s;
#pragma unroll
      for (int i = 0; i < 16; ++i) s[i] = 0.f;
#pragma unroll
      for (int ks = 0; ks < 4; ++ks) {
        const bf16x8 ka = *(const bf16x8*)(kb + ((32 * sub + l31) * KROW + 16 * ks + 8 * hh) * 2);
        s = __builtin_amdgcn_mfma_f32_32x32x16_bf16(ka, qf[ks], s, 0, 0, 0);
      }
      if (domask) {
        const int kp0 = k0start + 64 * ti + 32 * sub;
#pragma unroll
        for (int i = 0; i < 16; ++i) { const int d = qpos - (kp0 + crow(i, hh)); if (d > 128 || d < -128) s[i] = -1e30f; }
      }
      float mt = s[0];
#pragma unroll
      for (int i = 1; i < 16; ++i) mt = fmaxf(mt, s[i]);
      mt = fmaxf(mt, __shfl_xor(mt, 32, 64));
      const float mn = fmaxf(m_run, mt);
      const float alpha = __builtin_amdgcn_exp2f(m_run - mn);
      m_run = mn;
      float ps = 0.f;
#pragma unroll
      for (int i = 0; i < 16; ++i) { s[i] = __builtin_amdgcn_exp2f(s[i] - mn); ps += s[i]; }
      l_run = l_run * alpha + ps;
#pragma unroll
      for (int i = 0; i < 16; ++i) { o0[i] *= alpha; o1[i] *= alpha; }
#pragma unroll
      for (int st = 0; st < 2; ++st) {
        u32x4 pw; pw.x = cvtpk(s[8 * st], s[8 * st + 1]); pw.y = cvtpk(s[8 * st + 2], s[8 * st + 3]); pw.z = cvtpk(s[8 * st + 4], s[8 * st + 5]); pw.w = cvtpk(s[8 * st + 6], s[8 * st + 7]);
        const bf16x8 pf = __builtin_bit_cast(bf16x8, pw);
        const int kofs = 32 * sub + 16 * st + 4 * hh;
        {
          const u32x2 lo = *(const u32x2*)(vb + (l31 * KROW + kofs) * 2), hi = *(const u32x2*)(vb + (l31 * KROW + kofs + 8) * 2);
          u32x4 vw; vw.x = lo.x; vw.y = lo.y; vw.z = hi.x; vw.w = hi.y;
          o0 = __builtin_amdgcn_mfma_f32_32x32x16_bf16(__builtin_bit_cast(bf16x8, vw), pf, o0, 0, 0, 0);
        }
        {
          const u32x2 lo = *(const u32x2*)(vb + ((32 + l31) * KROW + kofs) * 2), hi = *(const u32x2*)(vb + ((32 + l31) * KROW + kofs + 8) * 2);
          u32x4 vw; vw.x = lo.x; vw.y = lo.y; vw.z = hi.x; vw.w = hi.y;
          o1 = __builtin_amdgcn_mfma_f32_32x32x16_bf16(__builtin_bit_cast(bf16x8, vw), pf, o1, 0, 0, 0);
        }
      }
    }
    if (ti + 1 < nt) { unsigned char* nb = cur ? ldsb : ldsb + 2 * KVBUF; attn_write(nb, nb + KVBUF, regs, tid); }
    __syncthreads();
  }
  const float lt = l_run + __shfl_xor(l_run, 32, 64);
  const float inv = 1.f / lt;
  bf16_t* ost = (bf16_t*)(ldsb + w * (32 * KROW * 2));
#pragma unroll
  for (int gq = 0; gq < 4; ++gq) {
    u32x2 p0, p1;
    p0.x = cvtpk(o0[4 * gq] * inv, o0[4 * gq + 1] * inv); p0.y = cvtpk(o0[4 * gq + 2] * inv, o0[4 * gq + 3] * inv);
    p1.x = cvtpk(o1[4 * gq] * inv, o1[4 * gq + 1] * inv); p1.y = cvtpk(o1[4 * gq + 2] * inv, o1[4 * gq + 3] * inv);
    *(u32x2*)(ost + l31 * KROW + 8 * gq + 4 * hh) = p0;
    *(u32x2*)(ost + l31 * KROW + 32 + 8 * gq + 4 * hh) = p1;
  }
  __syncthreads();
  {
    const int q = lane >> 1, half = lane & 1;
    const int orow = R0 + qb * 128 + (w & 3) * 32 + q;
    bf16_t* op = O + (size_t)orow * 768 + (isA ? 0 : 256) + head * 64 + 32 * half;
    const bf16_t* sp = ost + q * KROW + 32 * half;
#pragma unroll
    for (int e = 0; e < 4; ++e) *(u32x4*)(op + 8 * e) = *(const u32x4*)(sp + 8 * e);
  }
  __syncthreads();
}

DI void hyena_unit(CArgs& a, int l, int conv, int c, int type, unsigned char* ldsb, int tid) {
  const int L = type ? 1024 : 256, nseq = type ? 2 : 32, tokbase = type ? MCTX : 0, L2 = 2 * L, L3 = 3 * L, CPS = L2 + 8;
  bf16_t* cp = (bf16_t*)ldsb;
  bf16_t* up = (bf16_t*)(ldsb + 33024);
  bf16_t* gt = (bf16_t*)(ldsb + 33024 + 49152);
  float* red = (float*)(ldsb + 33024 + 49152 + 16384);
  const bf16_t* HYT = (const bf16_t*)(a.ws + WS_HYT);
  bf16_t* Y1T = (bf16_t*)(a.ws + WS_Y1T);
  bf16_t* OBT = (bf16_t*)(a.ws + WS_OBT);
  const bf16_t* Kr = (const bf16_t*)(a.ws + WS_FILT) + ((size_t)((l * 2 + conv) * 256 + c)) * 2560 + (type ? 512 : 0);
  for (int idx = tid; idx < 8 * L2; idx += 512) { const int r = idx / L2, y = idx - r * L2; cp[r * CPS + y] = (y + r < L2) ? Kr[y + r] : (bf16_t)0; }
  const float* cw = a.in[19] + l * 3 * 768; const float* cb = a.in[20] + l * 768;
  const int gc = (conv == 0 ? 256 : 512) + c;
  const float vw0 = cw[c], vw1 = cw[768 + c], vw2 = cw[1536 + c], vb = cb[c];
  const float gw0 = cw[gc], gw1 = cw[768 + gc], gw2 = cw[1536 + gc], gb = cb[gc];
  const int ntok = nseq * L;
  for (int idx = tid; idx < ntok; idx += 512) {
    const int s = idx / L, p = idx - s * L;
    const size_t tk = (size_t)tokbase + idx;
    const bf16_t* hg = HYT + (size_t)gc * MT + tk;
    const float g0 = p > 0 ? bf2f(hg[-1]) : 0.f, g1 = bf2f(hg[0]), g2 = p < L - 1 ? bf2f(hg[1]) : 0.f;
    gt[idx] = f2bf(gw0 * g0 + gw1 * g1 + gw2 * g2 + gb);
    float uv;
    if (conv == 0) {
      const bf16_t* hv = HYT + (size_t)c * MT + tk;
      const float v0 = p > 0 ? bf2f(hv[-1]) : 0.f, v1 = bf2f(hv[0]), v2 = p < L - 1 ? bf2f(hv[1]) : 0.f;
      uv = vw0 * v0 + vw1 * v1 + vw2 * v2 + vb;
    } else uv = bf2f(Y1T[(size_t)c * MT + tk]);
    up[s * L3 + L + p] = f2bf(uv);
    up[s * L3 + p] = 0; up[s * L3 + L2 + p] = 0;
  }
  __syncthreads();
  const int w = tid >> 6, lane = tid & 63, hh = lane >> 5, i = lane & 31, r = (8 - (i & 7)) & 7;
  int aa, sq, mlo, mhi;
  if (type == 0) { aa = i & 7; sq = 4 * w + (i >> 3); mlo = -7; mhi = 7; }
  else { aa = i; sq = w >> 2; mlo = -31 + 16 * (w & 3); mhi = mlo + 15 > 31 ? 31 : mlo + 15; }
  const bf16_t* useq = up + sq * L3;
  const bf16_t* cpr = cp + r * CPS;
  f32x16 acc;
#pragma unroll
  for (int q = 0; q < 16; ++q) acc[q] = 0.f;
  for (int m = mlo; m <= mhi; ++m) {
#pragma unroll
    for (int ks = 0; ks < 2; ++ks) {
      const int xi0 = L + 16 * ks + 8 * hh - i - 32 * m;
      const bf16x8 A = *(const bf16x8*)(cpr + (xi0 - r));
      const bf16x8 B = *(const bf16x8*)(useq + 32 * (aa - m) + 16 * ks + 8 * hh + L);
      acc = __builtin_amdgcn_mfma_f32_32x32x16_bf16(A, B, acc, 0, 0, 0);
    }
  }
  if (type == 1) {
#pragma unroll
    for (int q = 0; q < 16; ++q) red[w * 1024 + q * 64 + lane] = acc[q];
    __syncthreads();
    if ((w & 3) == 0) {
#pragma unroll
      for (int q = 0; q < 16; ++q) acc[q] += red[(w + 1) * 1024 + q * 64 + lane] + red[(w + 2) * 1024 + q * 64 + lane] + red[(w + 3) * 1024 + q * 64 + lane];
    }
  }
  if (type == 0 || (w & 3) == 0) {
    const float bias = a.in[27][(l * 2 + conv) * 256 + c];
    bf16_t* dst = (conv == 0 ? Y1T : OBT) + (size_t)c * MT + tokbase + sq * L;
#pragma unroll
    for (int gq = 0; gq < 4; ++gq) {
      float y[4];
#pragma unroll
      for (int e = 0; e < 4; ++e) {
        const int t = 32 * aa + 8 * gq + 4 * hh + e;
        y[e] = (acc[4 * gq + e] + bias * bf2f(useq[L + t])) * bf2f(gt[sq * L + t]);
      }
      u32x2 o; o.x = cvtpk(y[0], y[1]); o.y = cvtpk(y[2], y[3]);
      *(u32x2*)(dst + 32 * aa + 8 * gq + 4 * hh) = o;
    }
  }
  __syncthreads();
}

struct GlaLds { float *qs, *ks, *vs, *gls, *Ws, *bs, *gb, *A1, *A2; };
DI GlaLds gla_lds(unsigned char* ldsb) {
  GlaLds g; float* p = (float*)ldsb;
  g.qs = p; p += 64 * 33; g.ks = p; p += 64 * 33; g.vs = p; p += 64 * 65; g.gls = p; p += 64 * 32; g.Ws = p; p += 1024; g.bs = p; p += 64;
  g.gb = p; p += 2 * 64 * 33; g.A1 = p; p += 64 * 65; g.A2 = p; p += 64 * 65; return g;
}
DI int gla_row0(int seq, int cidx) { return (seq < 32 ? seq * 256 : MCTX + (seq - 32) * 1024) + 64 * cidx; }
DI int gla_gc(int seq, int n) { return (seq < 32 ? 4 * seq : 128 + 16 * (seq - 32)) + n; }

DI void gla_prep(CArgs& a, int l, int seq, int h, int cidx, const GlaLds& G, int tid) {
  const bf16_t* U = (const bf16_t*)(a.ws + WS_ACT);
  const int R0 = gla_row0(seq, cidx);
  { const int i = tid >> 3, d4 = (tid & 7) * 4; const bf16_t* rp = U + (size_t)(R0 + i) * UW;
    const u32x2 qv = *(const u32x2*)(rp + U_QD + h * 32 + d4), kv = *(const u32x2*)(rp + U_KD + h * 32 + d4);
    float* qd = G.qs + i * 33 + d4; qd[0] = bflo(qv.x); qd[1] = bfhi(qv.x); qd[2] = bflo(qv.y); qd[3] = bfhi(qv.y);
    float* kd = G.ks + i * 33 + d4; kd[0] = bflo(kv.x); kd[1] = bfhi(kv.x); kd[2] = bflo(kv.y); kd[3] = bfhi(kv.y);
    const int v8 = (tid & 7) * 8; const u32x4 vv = *(const u32x4*)(rp + U_VD + h * 64 + v8);
    float* vd = G.vs + i * 65 + v8; vd[0] = bflo(vv.x); vd[1] = bfhi(vv.x); vd[2] = bflo(vv.y); vd[3] = bfhi(vv.y); vd[4] = bflo(vv.z); vd[5] = bfhi(vv.z); vd[6] = bflo(vv.w); vd[7] = bfhi(vv.w);
    if (tid < 256) { const int i2 = tid >> 2, c8 = (tid & 3) * 8; const u32x4 gv = *(const u32x4*)(U + (size_t)(R0 + i2) * UW + U_GD + c8);
      float* gd = G.gls + i2 * 32 + c8; gd[0] = bflo(gv.x); gd[1] = bfhi(gv.x); gd[2] = bflo(gv.y); gd[3] = bfhi(gv.y); gd[4] = bflo(gv.z); gd[5] = bfhi(gv.z); gd[6] = bflo(gv.w); gd[7] = bfhi(gv.w); }
  }
  for (int e = tid; e < 1024; e += 512) { const int z = e >> 9, r = (e >> 5) & 15, d = e & 31; G.Ws[e] = a.in[28][(size_t)((l * 2 + z) * 16 + r) * 128 + h * 32 + d]; }
  if (tid < 64) G.bs[tid] = a.in[29][(l * 2 + (tid >> 5)) * 128 + h * 32 + (tid & 31)];
  for (int e = tid; e < 64 * 65; e += 512) { G.A1[e] = 0.f; G.A2[e] = 0.f; }
  __syncthreads();
#pragma unroll
  for (int e = 0; e < 8; ++e) {
    const int idx = tid * 8 + e, z = idx >> 11, i = (idx >> 5) & 63, d = idx & 31;
    float s = G.bs[z * 32 + d];
#pragma unroll
    for (int r = 0; r < 16; ++r) s += G.gls[i * 32 + z * 16 + r] * G.Ws[z * 512 + r * 32 + d];
    const float ls = fminf(s, 0.f) - log1pf(expf(-fabsf(s)));
    G.gb[z * 2112 + i * 33 + d] = ls * (1.f / 16.f);
  }
  __syncthreads();
  if (tid < 64) {
    const int z = tid >> 5, d = tid & 31; float run = 0.f;
    if (z == 0) { for (int i = 0; i < 64; ++i) { run += G.gb[i * 33 + d]; G.gb[i * 33 + d] = run; } }
    else { for (int i = 63; i >= 0; --i) { run += G.gb[2112 + i * 33 + d]; G.gb[2112 + i * 33 + d] = run; } }
  }
  __syncthreads();
}

constexpr float GLA_QS = 0.17677669529663687f;

DI void gla_a_unit(CArgs& a, int l, int uidx, unsigned char* ldsb, int tid) {
  int seq, h, cidx, nc;
  if (uidx < 512) { seq = uidx >> 4; h = (uidx >> 2) & 3; cidx = uidx & 3; nc = 4; } else { const int j = uidx - 512; seq = 32 + (j >> 6); h = (j >> 4) & 3; cidx = j & 15; nc = 16; }
  const GlaLds G = gla_lds(ldsb);
  gla_prep(a, l, seq, h, cidx, G, tid);
  const int w = tid >> 6, lane = tid & 63, hh = lane >> 5, l31 = lane & 31;
  const int R0 = gla_row0(seq, cidx);
  if (w < 6) {
    const int dir = w / 3, which = w % 3;
    const int ib = dir == 0 ? (which > 0) : (which == 2), jb = dir == 0 ? (which == 2) : (which > 0);
    const float* bz = G.gb + dir * 2112;
    f32x16 acc;
#pragma unroll
    for (int q = 0; q < 16; ++q) acc[q] = 0.f;
    const int ii = 32 * ib + l31, jj = 32 * jb + l31;
#pragma unroll 4
    for (int kk = 0; kk < 16; ++kk) {
      const int d = 2 * kk + hh;
      const float av = G.qs[ii * 33 + d] * __expf(bz[ii * 33 + d]) * GLA_QS;
      const float bv = G.ks[jj * 33 + d] * __expf(-bz[jj * 33 + d]);
      acc = __builtin_amdgcn_mfma_f32_32x32x2f32(av, bv, acc, 0, 0, 0);
    }
    float* Az = dir == 0 ? G.A1 : G.A2;
#pragma unroll
    for (int q = 0; q < 16; ++q) {
      const int i2 = 32 * ib + crow(q, hh);
      const bool keep = dir == 0 ? (jj <= i2) : (jj >= i2);
      Az[i2 * 65 + jj] = keep ? acc[q] : 0.f;
    }
  }
  __syncthreads();
  if (w < 4) {
    const int ib = w >> 1, vb = w & 1, ii = 32 * ib + l31;
    f32x16 acc;
#pragma unroll
    for (int q = 0; q < 16; ++q) acc[q] = 0.f;
#pragma unroll 4
    for (int kk = 0; kk < 32; ++kk) {
      const int j = 2 * kk + hh;
      const float av = G.A1[ii * 65 + j] + G.A2[ii * 65 + j];
      const float bv = G.vs[j * 65 + 32 * vb + l31];
      acc = __builtin_amdgcn_mfma_f32_32x32x2f32(av, bv, acc, 0, 0, 0);
    }
    float* od = (float*)(a.ws + WS_OD);
#pragma unroll
    for (int q = 0; q < 16; ++q) od[(size_t)(R0 + 32 * ib + crow(q, hh)) * 256 + h * 64 + 32 * vb + l31] = acc[q];
  } else {
    const int dir = (w - 4) >> 1, vb = w & 1;
    const float* bz = G.gb + dir * 2112;
    const float blast = dir == 0 ? bz[63 * 33 + l31] : bz[l31];
    f32x16 acc;
#pragma unroll
    for (int q = 0; q < 16; ++q) acc[q] = 0.f;
#pragma unroll 4
    for (int kk = 0; kk < 32; ++kk) {
      const int j = 2 * kk + hh;
      const float av = G.ks[j * 33 + l31] * __expf(blast - bz[j * 33 + l31]);
      const float bv = G.vs[j * 65 + 32 * vb + l31];
      acc = __builtin_amdgcn_mfma_f32_32x32x2f32(av, bv, acc, 0, 0, 0);
    }
    const int n = dir == 0 ? cidx : nc - 1 - cidx;
    const size_t gi = (size_t)(gla_gc(seq, n) * 4 + h) * 2 + dir;
    float* glc = (float*)(a.ws + WS_GLC) + gi * 2048;
#pragma unroll
    for (int q = 0; q < 16; ++q) glc[crow(q, hh) * 64 + 32 * vb + l31] = acc[q];
    if (vb == 0 && hh == 0) ((float*)(a.ws + WS_GLD))[gi * 32 + l31] = __expf(blast);
  }
  __syncthreads();
}

DI void gla_b_unit(CArgs& a, int l, int uidx, unsigned char* ldsb, int tid) {
  int seq, h, cidx, nc;
  if (uidx < 512) { seq = uidx >> 4; h = (uidx >> 2) & 3; cidx = uidx & 3; nc = 4; } else { const int j = uidx - 512; seq = 32 + (j >> 6); h = (j >> 4) & 3; cidx = j & 15; nc = 16; }
  const GlaLds G = gla_lds(ldsb);
  gla_prep(a, l, seq, h, cidx, G, tid);
  float* Ss = G.A1;
  const int w = tid >> 6, lane = tid & 63, hh = lane >> 5, l31 = lane & 31;
  const int R0 = gla_row0(seq, cidx);
  {
    const int dir = tid >> 8, e = tid & 255, d = e >> 3, v0 = (e & 7) * 8;
    float S[8];
    if (seq >= 32) { const float* sp = a.in[6] + ((size_t)((((seq - 32) * 2 + l) * 2 + dir) * 4 + h)) * 2048 + d * 64 + v0;
#pragma unroll
      for (int j = 0; j < 8; ++j) S[j] = sp[j]; }
    else {
#pragma unroll
      for (int j = 0; j < 8; ++j) S[j] = 0.f; }
    const int npos = dir == 0 ? cidx : nc - 1 - cidx;
    const float* glc = (const float*)(a.ws + WS_GLC); const float* gld = (const float*)(a.ws + WS_GLD);
    for (int n = 0; n < npos; ++n) {
      const size_t gi = (size_t)(gla_gc(seq, n) * 4 + h) * 2 + dir;
      const float dec = gld[gi * 32 + d];
      const f32x4 c0 = *(const f32x4*)(glc + gi * 2048 + d * 64 + v0), c1 = *(const f32x4*)(glc + gi * 2048 + d * 64 + v0 + 4);
#pragma unroll
      for (int j = 0; j < 4; ++j) { S[j] = dec * S[j] + c0[j]; S[4 + j] = dec * S[4 + j] + c1[j]; }
    }
#pragma unroll
    for (int j = 0; j < 8; ++j) Ss[dir * 2080 + d * 65 + v0 + j] = S[j];
    if (seq < 32 && npos == nc - 1) {
      const size_t gi = (size_t)(gla_gc(seq, npos) * 4 + h) * 2 + dir;
      const float dec = gld[gi * 32 + d];
      float* op = a.out + OUT_STATE + ((size_t)(((seq * 2 + l) * 2 + dir) * 4 + h)) * 2048 + d * 64 + v0;
#pragma unroll
      for (int j = 0; j < 8; ++j) op[j] = dec * S[j] + glc[gi * 2048 + d * 64 + v0 + j];
    }
  }
  __syncthreads();
  if (w < 4) {
    const int ib = w >> 1, vb = w & 1, ii = 32 * ib + l31;
    f32x16 acc;
#pragma unroll
    for (int q = 0; q < 16; ++q) acc[q] = 0.f;
#pragma unroll
    for (int dir = 0; dir < 2; ++dir) {
      const float* bz = G.gb + dir * 2112;
#pragma unroll 4
      for (int kk = 0; kk < 16; ++kk) {
        const int d = 2 * kk + hh;
        const float av = G.qs[ii * 33 + d] * __expf(bz[ii * 33 + d]) * GLA_QS;
        const float bv = Ss[dir * 2080 + d * 65 + 32 * vb + l31];
        acc = __builtin_amdgcn_mfma_f32_32x32x2f32(av, bv, acc, 0, 0, 0);
      }
    }
    const float* od = (const float*)(a.ws + WS_OD);
    bf16_t* O = (bf16_t*)(a.ws + WS_O);
#pragma unroll
    for (int q = 0; q < 16; ++q) {
      const int row = R0 + 32 * ib + crow(q, hh);
      O[(size_t)row * 768 + 512 + h * 64 + 32 * vb + l31] = f2bf(acc[q] + od[(size_t)row * 256 + h * 64 + 32 * vb + l31]);
    }
  }
  __syncthreads();
}

DI void merge_phase(CArgs& a, int l, unsigned char* ldsb, int tid) {
  bf16_t* obs = (bf16_t*)ldsb;
  const bf16_t* O = (const bf16_t*)(a.ws + WS_O); const bf16_t* OBT = (const bf16_t*)(a.ws + WS_OBT); const bf16_t* U = (const bf16_t*)(a.ws + WS_ACT);
  bf16_t* cat = (bf16_t*)(a.ws + WS_XN);
  const float* mg = a.in[16] + l * 1024;
  const int w = tid >> 6, lane = tid & 63;
  for (int tile = BID(); tile < MT / 32; tile += gridDim.x) {
    const int t0 = tile * 32;
    { const int c = tid >> 1, half = tid & 1;
      const u32x4 x0 = *(const u32x4*)(OBT + (size_t)c * MT + t0 + 16 * half), x1 = *(const u32x4*)(OBT + (size_t)c * MT + t0 + 16 * half + 8);
      bf16_t* d = obs + (16 * half) * 264 + c;
      d[0] = (bf16_t)(x0.x & 0xffff); d[264] = (bf16_t)(x0.x >> 16); d[2 * 264] = (bf16_t)(x0.y & 0xffff); d[3 * 264] = (bf16_t)(x0.y >> 16);
      d[4 * 264] = (bf16_t)(x0.z & 0xffff); d[5 * 264] = (bf16_t)(x0.z >> 16); d[6 * 264] = (bf16_t)(x0.w & 0xffff); d[7 * 264] = (bf16_t)(x0.w >> 16);
      d[8 * 264] = (bf16_t)(x1.x & 0xffff); d[9 * 264] = (bf16_t)(x1.x >> 16); d[10 * 264] = (bf16_t)(x1.y & 0xffff); d[11 * 264] = (bf16_t)(x1.y >> 16);
      d[12 * 264] = (bf16_t)(x1.z & 0xffff); d[13 * 264] = (bf16_t)(x1.z >> 16); d[14 * 264] = (bf16_t)(x1.w & 0xffff); d[15 * 264] = (bf16_t)(x1.w >> 16); }
    __syncthreads();
#pragma unroll
    for (int k = 0; k < 4; ++k) {
      const int tl = 4 * w + k, row = t0 + tl;
      const u32x2 wa = *(const u32x2*)(O + (size_t)row * 768 + 4 * lane), wc = *(const u32x2*)(O + (size_t)row * 768 + 256 + 4 * lane), wd = *(const u32x2*)(O + (size_t)row * 768 + 512 + 4 * lane);
      const u32x2 wb = *(const u32x2*)(obs + tl * 264 + 4 * lane), wr = *(const u32x2*)(U + (size_t)row * UW + U_RD + 4 * lane);
      float xa[4] = {bflo(wa.x), bfhi(wa.x), bflo(wa.y), bfhi(wa.y)}, xb[4] = {bflo(wb.x), bfhi(wb.x), bflo(wb.y), bfhi(wb.y)};
      float xc[4] = {bflo(wc.x), bfhi(wc.x), bflo(wc.y), bfhi(wc.y)}, xd[4] = {bflo(wd.x), bfhi(wd.x), bflo(wd.y), bfhi(wd.y)};
      float rd[4] = {bflo(wr.x), bfhi(wr.x), bflo(wr.y), bfhi(wr.y)};
      float sa = xa[0] * xa[0] + xa[1] * xa[1] + xa[2] * xa[2] + xa[3] * xa[3];
      float sb = xb[0] * xb[0] + xb[1] * xb[1] + xb[2] * xb[2] + xb[3] * xb[3];
      float sc = xc[0] * xc[0] + xc[1] * xc[1] + xc[2] * xc[2] + xc[3] * xc[3];
      float sd = xd[0] * xd[0] + xd[1] * xd[1] + xd[2] * xd[2] + xd[3] * xd[3];
      sa = wave_sum(sa); sb = wave_sum(sb); sc = wave_sum(sc);
#pragma unroll
      for (int o = 8; o >= 1; o >>= 1) sd += __shfl_xor(sd, o, 64);
      const float ra = rsqrtf(sa * (1.f / 256.f) + EPSF), rb = rsqrtf(sb * (1.f / 256.f) + EPSF), rc = rsqrtf(sc * (1.f / 256.f) + EPSF), rdn = rsqrtf(sd * (1.f / 64.f) + EPSF);
      const f32x4 ga = *(const f32x4*)(mg + 4 * lane), gb = *(const f32x4*)(mg + 256 + 4 * lane), gc = *(const f32x4*)(mg + 512 + 4 * lane), gd = *(const f32x4*)(mg + 768 + 4 * lane);
      float ya[4], yb[4], yc[4], yd[4];
#pragma unroll
      for (int e = 0; e < 4; ++e) { ya[e] = xa[e] * ra * ga[e]; yb[e] = xb[e] * rb * gb[e]; yc[e] = xc[e] * rc * gc[e]; yd[e] = xd[e] * rdn * gd[e] * (rd[e] / (1.f + __expf(-rd[e]))); }
      bf16_t* cp = cat + (size_t)row * DM + 4 * lane;
      u32x2 o;
      o.x = cvtpk(ya[0], ya[1]); o.y = cvtpk(ya[2], ya[3]); *(u32x2*)(cp) = o;
      o.x = cvtpk(yb[0], yb[1]); o.y = cvtpk(yb[2], yb[3]); *(u32x2*)(cp + 256) = o;
      o.x = cvtpk(yc[0], yc[1]); o.y = cvtpk(yc[2], yc[3]); *(u32x2*)(cp + 512) = o;
      o.x = cvtpk(yd[0], yd[1]); o.y = cvtpk(yd[2], yd[3]); *(u32x2*)(cp + 768) = o;
    }
    __syncthreads();
  }
}

#ifdef NO_ATTN
#define ATTN(...) do{}while(0)
#else
#define ATTN attn_unit
#endif
#ifdef NO_GLAA
#define GLAA(...) do{}while(0)
#else
#define GLAA gla_a_unit
#endif
#ifdef NO_GLAB
#define GLAB(...) do{}while(0)
#else
#define GLAB gla_b_unit
#endif
#ifdef NO_HY
#define HYEN(...) do{}while(0)
#else
#define HYEN hyena_unit
#endif

DI int q_next(unsigned* ctr, unsigned char* ldsb, int tid) {
  volatile int* slot = (volatile int*)(ldsb + LDS_CTL_OFF);
  if (tid == 0) *slot = (int)__hip_atomic_fetch_add(ctr, 1u, __ATOMIC_RELAXED, __HIP_MEMORY_SCOPE_AGENT);
  __syncthreads();
  const int v = *slot;
  __syncthreads();
  return v;
}

#ifndef N_LAUNCH_PER_PHASE
#define N_LAUNCH_PER_PHASE 0
#endif
constexpr int NPHASE = 28;

__global__ void __launch_bounds__(512, 2) fwd_kernel(Args a_) {
  extern __shared__ __attribute__((aligned(16))) unsigned char lds[];
  cg::grid_group grid = cg::this_grid();
  const int ph_hi = a_.ph_hi;
  for (int ph = a_.ph_lo; ph < ph_hi; ++ph) {
    CArgs* ap = (CArgs*)__builtin_amdgcn_kernarg_segment_ptr();
    asm volatile("" : "+s"(ap));
    CArgs& a = *ap;
    int tid = threadIdx.x; asm volatile("" : "+v"(tid));
    int bid = blockIdx.x; asm volatile("" : "+s"(bid));
    unsigned char* ws = a.ws;
    float* mod = (float*)(ws + WS_MOD);
    bf16_t* XN = (bf16_t*)(ws + WS_XN); bf16_t* ACT = (bf16_t*)(ws + WS_ACT); float* H = (float*)(ws + WS_H);
    if (ph == 0) {

#ifndef NO_P0
      p0_convert(a, lds, tid);
      p0_modulation(a, lds, tid);
      p0_filters(a, lds, tid);
#endif

    } else if (ph == NPHASE - 1) {
      final_norm_phase(H, a.out, a.in[30], tid);
    } else {
      const int l = (ph - 1) / 13, s = (ph - 1) % 13;
      const float* mod_l = mod + (size_t)l * 3 * 9216;
      if (s == 0 || s == 3 || s == 10) {
        const int j = s == 0 ? 0 : (s == 3 ? 1 : 2);
        const bool first = (l == 0 && s == 0);
        norm_mod_phase(first ? a.in[0] : H, first ? a.in[1] : H + (size_t)MCTX * DM, XN, a.in[11] + (l * 3 + j) * 1024, mod_l, j, tid);
      } else if (s == 1 || s == 11) {
        const int f = s == 1 ? 0 : 1;
        pg8::Gemm g; g.A = XN; g.Bt = (const bf16_t*)(ws + WS_WFI) + (size_t)(l * 2 + f) * 5632 * 1024; g.M = MT; g.N = 5632; g.K = 1024;
        pg8::StaticOrder S; S.init(MT, 5632, gridDim.x, bid);
        EpiSwiglu E; E.act = ACT;

#ifndef NO_G1
pg8::gemm_phase<EpiSwiglu, pg8::StaticOrder, true, true>((PG8_LAS unsigned char*)lds, g, S, E);
#endif

      } else if (s == 2 || s == 9 || s == 12) {
        pg8::Gemm g; g.M = MT; g.N = 1024;
        EpiRes E; E.h = H; E.resA = H; E.resB = H;
        if (s == 9) { g.A = XN; g.Bt = (const bf16_t*)(ws + WS_WOUT) + (size_t)l * 1024 * 1024; g.K = 1024; E.gate = mod_l + 5 * 1024; E.coef = 1.f; }
        else { const int f = s == 2 ? 0 : 1; g.A = ACT; g.Bt = (const bf16_t*)(ws + WS_WFO) + (size_t)(l * 2 + f) * 1024 * 2816; g.K = 2816; E.gate = mod_l + (f == 0 ? 2 : 8) * 1024; E.coef = 0.5f;
          if (l == 0 && s == 2) { E.resA = a.in[0]; E.resB = a.in[1] - (size_t)MCTX * DM; } }
        pg8::StaticOrder S; S.init(MT, 1024, gridDim.x, bid);

#ifndef NO_G2
pg8::gemm_phase<EpiRes, pg8::StaticOrder, true, true>((PG8_LAS unsigned char*)lds, g, S, E);
#endif

      } else if (s == 4) {
        pg8::Gemm g; g.A = XN; g.Bt = (const bf16_t*)(ws + WS_WIN) + (size_t)l * NINP * 1024; g.M = MT; g.N = NINP; g.K = 1024;
        pg8::StaticOrder S; S.init(MT, NINP, gridDim.x, bid);
        EpiInproj E; E.U = ACT; E.HYT = (bf16_t*)(ws + WS_HYT); E.out = a.out; E.l = l;

#ifndef NO_G3
pg8::gemm_phase<EpiInproj, pg8::StaticOrder, true, true>((PG8_LAS unsigned char*)lds, g, S, E);
#endif

      } else if (s == 5) {
        post_proj_phase(ACT, a.out, a.in[18] + l * 128, l, tid);
      } else if (s == 6) {
        unsigned* ctr = (unsigned*)(ws + WS_CTL) + 64 * (l * 2 + 0);
        for (;;) {
          const int q = q_next(ctr, lds, tid);
          if (q >= 1472) break;
          if (q < 64) { ATTN(a, l, q, lds, tid); }
          else if (q < 704) { const int j = q - 64; GLAA(a, l, j < 128 ? 512 + j : j - 128, lds, tid); }
          else if (q < 1216) { const int j = q - 704; HYEN(a, l, 0, j & 255, j < 256 ? 1 : 0, lds, tid); }
          else { ATTN(a, l, 64 + (q - 1216), lds, tid); }
        }
      } else if (s == 7) {
        unsigned* ctr = (unsigned*)(ws + WS_CTL) + 64 * (l * 2 + 1);
        for (;;) {
          const int q = q_next(ctr, lds, tid);
          if (q >= 1152) break;
          if (q < 640) { GLAB(a, l, q < 128 ? 512 + q : q - 128, lds, tid); }
          else { const int j = q - 640; HYEN(a, l, 1, j & 255, j < 256 ? 1 : 0, lds, tid); }
        }
      } else if (s == 8) {

#ifndef NO_MERGE
merge_phase(a, l, lds, tid);
#endif

      }
    }
    if (ph + 1 < ph_hi) grid.sync();
  }
}

extern "C" void kernel_launch(void* const* d_in, const int* in_sizes, int n_in, void* d_out, int out_size, void* d_ws, size_t ws_size, hipStream_t stream) {
  static int grid = 0;
  if (grid == 0) {
    if (n_in != 31 || ws_size < WS_END) { fprintf(stderr, "kernel_launch: need 31 inputs and >= %zu bytes of workspace; got %d, %zu\n", (size_t)WS_END, n_in, ws_size); grid = -1; return; }
    int dev = 0, cus = 0, per_cu = 0;
    (void)hipGetDevice(&dev);
    (void)hipDeviceGetAttribute(&cus, hipDeviceAttributeMultiprocessorCount, dev);
    if (hipFuncSetAttribute((const void*)fwd_kernel, hipFuncAttributeMaxDynamicSharedMemorySize, LDS_BYTES) != hipSuccess) { fprintf(stderr, "kernel_launch: hipFuncSetAttribute failed\n"); grid = -1; return; }
    if (hipOccupancyMaxActiveBlocksPerMultiprocessor(&per_cu, (const void*)fwd_kernel, 512, LDS_BYTES) != hipSuccess || per_cu < 1) { fprintf(stderr, "kernel_launch: occupancy query says %d\n", per_cu); per_cu = 1; }
    (void)hipGetLastError();
    grid = cus * 1;
    if (grid <= 0) grid = 256;
  }
  if (grid < 0) return;
  (void)hipMemsetAsync((char*)d_ws + WS_CTL, 0, 4096, stream);
  Args a{};
  for (int i = 0; i < 31; ++i) a.in[i] = (const float*)d_in[i];
  a.out = (float*)d_out; a.ws = (unsigned char*)d_ws;
#if N_LAUNCH_PER_PHASE
  for (int ph = 0; ph < NPHASE; ++ph) { a.ph_lo = ph; a.ph_hi = ph + 1; hipLaunchKernelGGL(fwd_kernel, dim3(grid), dim3(512), LDS_BYTES, stream, a); }
#else
  a.ph_lo = 0; a.ph_hi = NPHASE;
  void* args[] = {&a};
  hipError_t e = hipLaunchCooperativeKernel((const void*)fwd_kernel, dim3(grid), dim3(512), args, LDS_BYTES, stream);
  if (e != hipSuccess) fprintf(stderr, "kernel_launch: cooperative launch failed: %s (grid %d)\n", hipGetErrorString(e), grid);
#endif
}
```

```cpp
#include <hip/hip_runtime.h>
#include <hip/hip_cooperative_groups.h>
#include <cstdio>
#include <cstdint>
namespace cg = cooperative_groups;

#define DI __device__ __forceinline__
#define LAS __attribute__((address_space(3)))
typedef unsigned short bf16_t;
typedef short bf16x8 __attribute__((ext_vector_type(8)));
typedef float f32x4 __attribute__((ext_vector_type(4)));
typedef float f32x16 __attribute__((ext_vector_type(16)));
typedef unsigned u32x4 __attribute__((ext_vector_type(4)));
typedef unsigned u32x2 __attribute__((ext_vector_type(2)));
typedef __bf16 bf16x2_t __attribute__((ext_vector_type(2)));
typedef float f32x2_t __attribute__((ext_vector_type(2)));

DI unsigned cvtpk(float lo, float hi) { f32x2_t v = {lo, hi}; bf16x2_t b = __builtin_convertvector(v, bf16x2_t); return __builtin_bit_cast(unsigned, b); }
DI float bf2f(bf16_t x) { return __uint_as_float(((unsigned)x) << 16); }
DI bf16_t f2bf(float x) { return (bf16_t)(cvtpk(x, 0.f) & 0xffffu); }
DI float bflo(unsigned w) { return __uint_as_float(w << 16); }
DI float bfhi(unsigned w) { return __uint_as_float(w & 0xffff0000u); }
DI float wave_sum(float v) {
#pragma unroll
  for (int o = 32; o >= 1; o >>= 1) v += __shfl_xor(v, o, 64);
  return v;
}
DI float siluf(float a) { return a * __builtin_amdgcn_rcpf(1.f + __expf(-a)); }
DI int crow(int r, int hi) { return (r & 3) + 8 * (r >> 2) + 4 * hi; }

constexpr int MT = 10240, MCTX = 8192, DM = 1024, DFF = 2816, NINP = 2816, NIN = 2592, UW = 1824;
constexpr int U_QA = 0, U_KA = 256, U_VA = 384, U_QC = 512, U_KC = 768, U_VC = 896, U_QD = 1024, U_KD = 1152, U_VD = 1280, U_GD = 1536, U_RD = 1568;
constexpr float EPSF = 1e-6f;
constexpr float QSCALE = 0.125f * 1.4426950408889634f;
constexpr size_t OUT_SWAK = 10485760, OUT_SWAV = 12582912, OUT_GQAK = 14680064, OUT_GQAV = 16777216, OUT_STATE = 18874368;
constexpr size_t WS_CTL = 0;
constexpr size_t WS_BAR = 4096;
constexpr size_t WS_WFI = 32768;
constexpr size_t WS_WFO = WS_WFI + (size_t)4 * 5632 * 1024 * 2;
constexpr size_t WS_WIN = WS_WFO + (size_t)4 * 1024 * 2816 * 2;
constexpr size_t WS_WOUT = WS_WIN + (size_t)2 * 2816 * 1024 * 2;
constexpr size_t WS_MOD = WS_WOUT + (size_t)2 * 1024 * 1024 * 2;
constexpr size_t WS_FILT = WS_MOD + (size_t)2 * 3 * 9216 * 4;
constexpr size_t WS_XN = WS_FILT + (size_t)2 * 2 * 256 * 2560 * 2;
constexpr size_t WS_ACT = WS_XN + (size_t)MT * 1024 * 2;
constexpr size_t WS_H = WS_ACT + (size_t)MT * 2816 * 2;
constexpr size_t WS_O = WS_H + (size_t)MT * 1024 * 4;
constexpr size_t WS_OBT = WS_O + (size_t)MT * 768 * 2;
constexpr size_t WS_HYT = WS_OBT + (size_t)256 * MT * 2;
constexpr size_t WS_Y1T = WS_HYT + (size_t)768 * MT * 2;
constexpr size_t WS_OD = WS_Y1T + (size_t)256 * MT * 2;
constexpr size_t WS_GLC = WS_OD + (size_t)MT * 256 * 4;
constexpr size_t WS_GLD = WS_GLC + (size_t)160 * 4 * 2 * 2048 * 4;
constexpr size_t WS_END = WS_GLD + (size_t)160 * 4 * 2 * 32 * 4;
constexpr int LDS_BYTES = 147456;
constexpr int LDS_CTL_OFF = LDS_BYTES - 64;

struct Args { const float* in[31]; float* out; unsigned char* ws; int ph_lo, ph_hi; };
typedef const __attribute__((address_space(4))) Args CArgs;


DI int BID() { int b = blockIdx.x; asm volatile("" : "+s"(b)); return b; }
namespace pg8 {
#define PG8_LAS __attribute__((address_space(3)))
typedef unsigned short bf16_t;
typedef short bf16x8 __attribute__((ext_vector_type(8)));
typedef float f32x4 __attribute__((ext_vector_type(4)));
typedef unsigned u32x4 __attribute__((ext_vector_type(4)));
constexpr int BM = 256, BK = 64, HALF = 128, HTB = HALF * BK * 2  , STAGE_BYTES = 8 * HTB, NXCD = 8, WGM = 8;

__host__ __device__ __forceinline__ int lds_byte(int r, int c) { const int st = (r >> 4) * 2 + (c >> 5), rr = r & 15, cc = c & 31, ob = rr * 64 + cc * 2; return st * 1024 + (ob ^ (((ob >> 9) & 1) << 5)); }
__host__ __device__ __forceinline__ void stage_rc(int b, int& R, int& C) { const int st = b / 1024, sb = b % 1024, swz = sb ^ (((sb >> 9) & 1) << 5); R = (st >> 1) * 16 + swz / 64; C = (st & 1) * 32 + (swz % 64) / 2; }
__host__ __device__ __forceinline__ int perm32(int rho) { const int n = rho >> 4, i = rho & 15; return 8 * (i >> 2) + 4 * n + (i & 3); }

struct Unit { int pm, pn; };
struct Gemm { const bf16_t* A; const bf16_t* Bt; int M, N, K; };

struct StaticOrder {
    int nM, nN, nwg, G, c;
    __host__ __device__ void init(int M, int N, int G_, int c_) { nM = M / BM; nN = N / BM; nwg = nM * nN; G = G_; c = c_; }
    __host__ __device__ bool next(int i, Unit& u) const {
        const long L = (long)i * G + c; if (L >= nwg) return false;
        int wgid = (int)L; { const int q = nwg / NXCD, r = nwg % NXCD, xcd = wgid % NXCD, off = wgid / NXCD; wgid = (xcd < r ? xcd * (q + 1) : r * (q + 1) + (xcd - r) * q) + off; }
        const int nig = WGM * nN, gid = wgid / nig, fm = gid * WGM, gsz = (nM - fm) < WGM ? (nM - fm) : WGM;
        u.pm = fm + ((wgid % nig) % gsz); u.pn = (wgid % nig) / gsz; return true;
    }
    __device__ __forceinline__ void a_ready(const Unit&) const {}
    __device__ __forceinline__ void done(const Unit&) const {}
};
template <class Epi, class Sched, bool ALIGN_EPI = false, bool SP2 = false>
__device__ __forceinline__ void gemm_phase(PG8_LAS unsigned char* lds, const Gemm g, const Sched& S, const Epi& E) {
    int tid_l = threadIdx.x; asm volatile("" : "+v"(tid_l));
    const int tid = tid_l, wid = __builtin_amdgcn_readfirstlane(tid >> 6), lane = tid & 63, wr = wid >> 2, wc = wid & 3, fr = lane & 15, fq = lane >> 4;
    const int K = g.K, nt = K / BK;
    unsigned voffA[2], voffB[2];
#pragma unroll
    for (int i = 0; i < 2; ++i) { int R, C; stage_rc(tid * 16 + i * 8192, R, C); const int Rb = Epi::PERM ? ((R & ~31) + perm32(R & 31)) : R;
        voffA[i] = (unsigned)(R * K + C) * 2u; voffB[i] = (unsigned)(Rb * K + C) * 2u; }
    const size_t kstep = (size_t)(BK * 2);
    const size_t hstep = (size_t)HALF * K * 2;
    const size_t tstep = 2 * hstep;
    const unsigned ldsw = (unsigned)wid * 1024u;
    const int aoff = lds_byte(wr * 64 + fr, fq * 8), boff = lds_byte(wc * 32 + fr, fq * 8);
#define PG8_SA(b, h) (((b) * 2 + (h)) * HTB)
#define PG8_SB(b, h) ((4 + (b) * 2 + (h)) * HTB)
#define PG8_STAGE(bufoff, gbase, voff) do { _Pragma("unroll") for (int _i = 0; _i < 2; ++_i) \
        __builtin_amdgcn_global_load_lds((const unsigned*)((const char*)(gbase) + (voff)[_i]), (PG8_LAS unsigned*)(lds + (bufoff) + ldsw + _i * 8192), 16, 0, 0); } while (0)
#define PG8_LDA(dst, b, h) do { _Pragma("unroll") for (int m = 0; m < 4; ++m) _Pragma("unroll") for (int k = 0; k < 2; ++k) dst[m][k] = *(const PG8_LAS bf16x8*)(lds + PG8_SA(b, h) + aoff + m * 2048 + k * 1024); } while (0)
#define PG8_LDB(dst, b, h) do { _Pragma("unroll") for (int n = 0; n < 2; ++n) _Pragma("unroll") for (int k = 0; k < 2; ++k) dst[n][k] = *(const PG8_LAS bf16x8*)(lds + PG8_SB(b, h) + boff + n * 2048 + k * 1024); } while (0)
#define PG8_MMA(ai, bj, At, Bt) do { __builtin_amdgcn_s_setprio(1); _Pragma("unroll") for (int m = 0; m < 4; ++m) _Pragma("unroll") for (int n = 0; n < 2; ++n) _Pragma("unroll") for (int k = 0; k < 2; ++k) \
        acc[ai][bj][m][n] = __builtin_amdgcn_mfma_f32_16x16x32_bf16(Bt[n][k], At[m][k], acc[ai][bj][m][n], 0, 0, 0); __builtin_amdgcn_s_setprio(0); } while (0)
#define PG8_WAIT_V(n) asm volatile("s_waitcnt vmcnt(" #n ")" ::: "memory")
#define PG8_WAIT_L(n) asm volatile("s_waitcnt lgkmcnt(" #n ")" ::: "memory")
#define PG8_BAR __builtin_amdgcn_s_barrier()
#define PG8_SCHED __builtin_amdgcn_sched_barrier(0)
    Unit cur, nxt; int ui = 0;
    if (!S.next(0, cur)) return;
    f32x4 acc[2][2][4][2];
#pragma unroll
    for (int a = 0; a < 2; ++a)
#pragma unroll
        for (int b = 0; b < 2; ++b)
#pragma unroll
            for (int m = 0; m < 4; ++m)
#pragma unroll
                for (int n = 0; n < 2; ++n) acc[a][b][m][n] = (f32x4){0.f, 0.f, 0.f, 0.f};
    bf16x8 At[4][2], B0[2][2], B1[2][2];
    const char* cA = (const char*)g.A + (size_t)cur.pm * tstep; const char* cB = (const char*)g.Bt + (size_t)cur.pn * tstep;
    S.a_ready(cur);
    if constexpr (SP2) {
        PG8_STAGE(PG8_SB(0, 0), cB, voffB); PG8_STAGE(PG8_SB(0, 1), cB + hstep, voffB); PG8_STAGE(PG8_SA(0, 0), cA, voffA); PG8_STAGE(PG8_SA(0, 1), cA + hstep, voffA);
        if (wr == 1) PG8_BAR;
        PG8_WAIT_V(2); PG8_BAR;
        PG8_STAGE(PG8_SB(1, 0), cB + kstep, voffB); PG8_STAGE(PG8_SA(1, 0), cA + kstep, voffA); PG8_STAGE(PG8_SB(1, 1), cB + hstep + kstep, voffB);
        PG8_WAIT_V(6); PG8_BAR;
    } else {
        PG8_STAGE(PG8_SB(0, 0), cB, voffB); PG8_STAGE(PG8_SA(0, 0), cA, voffA); PG8_STAGE(PG8_SB(0, 1), cB + hstep, voffB); PG8_STAGE(PG8_SA(0, 1), cA + hstep, voffA);
        if (wr == 1) PG8_BAR;
        PG8_WAIT_V(4); PG8_BAR;
        PG8_STAGE(PG8_SB(1, 0), cB + kstep, voffB); PG8_STAGE(PG8_SA(1, 0), cA + kstep, voffA); PG8_STAGE(PG8_SB(1, 1), cB + hstep + kstep, voffB);
        PG8_WAIT_V(6); PG8_BAR;
    }
    for (;;) {
        const bool has_next = S.next(ui + 1, nxt);
        const char* nA = has_next ? (const char*)g.A + (size_t)nxt.pm * tstep : cA; const char* nB = has_next ? (const char*)g.Bt + (size_t)nxt.pn * tstep : cB;
        for (int t = 0; t < nt; t += 2) {
            const bool last = (t == nt - 2);
            const char* a1 = cA + (size_t)(t + 1) * kstep;
            const char* a2 = last ? nA : cA + (size_t)(t + 2) * kstep; const char* b2 = last ? nB : cB + (size_t)(t + 2) * kstep;
            const char* a3 = a2 + kstep; const char* b3 = b2 + kstep;
            if (last && has_next) S.a_ready(nxt);
            if constexpr (SP2) {
            PG8_LDB(B0, 0, 0); PG8_LDB(B1, 0, 1); PG8_SCHED; PG8_LDA(At, 0, 0); PG8_STAGE(PG8_SA(1, 1), a1 + hstep, voffA);
            PG8_WAIT_V(8); PG8_WAIT_L(0); PG8_BAR; PG8_MMA(0, 0, At, B0); PG8_MMA(0, 1, At, B1); PG8_BAR; PG8_SCHED;
            PG8_LDA(At, 0, 1); PG8_STAGE(PG8_SB(0, 0), b2, voffB); PG8_STAGE(PG8_SB(0, 1), b2 + hstep, voffB); PG8_STAGE(PG8_SA(0, 0), a2, voffA);
            PG8_WAIT_V(8); PG8_WAIT_L(0); PG8_BAR; PG8_MMA(1, 0, At, B0); PG8_MMA(1, 1, At, B1); PG8_BAR; PG8_SCHED;
            PG8_LDB(B0, 1, 0); PG8_LDB(B1, 1, 1); PG8_SCHED; PG8_LDA(At, 1, 0); PG8_STAGE(PG8_SA(0, 1), a2 + hstep, voffA);
            PG8_WAIT_V(8); PG8_WAIT_L(0); PG8_BAR; PG8_MMA(0, 0, At, B0); PG8_MMA(0, 1, At, B1); PG8_BAR; PG8_SCHED;
            PG8_LDA(At, 1, 1); PG8_STAGE(PG8_SB(1, 0), b3, voffB); PG8_STAGE(PG8_SB(1, 1), b3 + hstep, voffB); PG8_STAGE(PG8_SA(1, 0), a3, voffA);
            PG8_WAIT_V(8); PG8_WAIT_L(0); PG8_BAR; PG8_MMA(1, 0, At, B0); PG8_MMA(1, 1, At, B1); PG8_BAR; PG8_SCHED;
            } else {
            PG8_LDB(B0, 0, 0); PG8_SCHED; PG8_LDA(At, 0, 0); PG8_STAGE(PG8_SA(1, 1), a1 + hstep, voffA);
            PG8_WAIT_L(8); PG8_BAR; PG8_WAIT_L(0); PG8_MMA(0, 0, At, B0); PG8_BAR; PG8_SCHED;
            PG8_LDB(B1, 0, 1); PG8_STAGE(PG8_SB(0, 0), b2, voffB);
            PG8_BAR; PG8_WAIT_L(0); PG8_MMA(0, 1, At, B1); PG8_BAR;
            PG8_LDA(At, 0, 1); PG8_STAGE(PG8_SA(0, 0), a2, voffA);
            PG8_BAR; PG8_WAIT_L(0); PG8_MMA(1, 0, At, B0); PG8_BAR; PG8_SCHED;
            PG8_STAGE(PG8_SB(0, 1), b2 + hstep, voffB);
            PG8_WAIT_V(6); PG8_BAR; PG8_MMA(1, 1, At, B1); PG8_BAR;
            PG8_LDB(B0, 1, 0); PG8_SCHED; PG8_LDA(At, 1, 0); PG8_STAGE(PG8_SA(0, 1), a2 + hstep, voffA);
            PG8_WAIT_L(8); PG8_BAR; PG8_WAIT_L(0); PG8_MMA(0, 0, At, B0); PG8_BAR; PG8_SCHED;
            PG8_LDB(B1, 1, 1); PG8_STAGE(PG8_SB(1, 0), b3, voffB);
            PG8_BAR; PG8_WAIT_L(0); PG8_MMA(0, 1, At, B1); PG8_BAR;
            PG8_LDA(At, 1, 1); PG8_STAGE(PG8_SA(1, 0), a3, voffA);
            PG8_BAR; PG8_WAIT_L(0); PG8_MMA(1, 0, At, B0); PG8_BAR; PG8_SCHED;
            PG8_STAGE(PG8_SB(1, 1), b3 + hstep, voffB);
            PG8_WAIT_V(6); PG8_BAR; PG8_MMA(1, 1, At, B1); PG8_BAR;
            }
        }
        if constexpr (ALIGN_EPI) { if (wr == 0) PG8_BAR; }
        if constexpr (!Epi::AFTER_DRAIN) { E(acc, cur, wr, wc, fr, fq); S.done(cur); }
        if (!has_next) break;
#pragma unroll
        for (int a = 0; a < 2; ++a)
#pragma unroll
            for (int b = 0; b < 2; ++b)
#pragma unroll
                for (int m = 0; m < 4; ++m)
#pragma unroll
                    for (int n = 0; n < 2; ++n) acc[a][b][m][n] = (f32x4){0.f, 0.f, 0.f, 0.f};
        cur = nxt; cA = nA; cB = nB; ++ui;
        if constexpr (ALIGN_EPI) { if (wr == 1) PG8_BAR; }
    }
    PG8_WAIT_V(0);
    if constexpr (!ALIGN_EPI) { if (wr == 0) PG8_BAR; }
    PG8_BAR;
    if constexpr (Epi::AFTER_DRAIN) { E.fused(acc, cur, wr, wc, fr, fq, lds, wid, lane); S.done(cur); }
#undef PG8_SA
#undef PG8_SB
#undef PG8_STAGE
#undef PG8_LDA
#undef PG8_LDB
#undef PG8_MMA
#undef PG8_WAIT_V
#undef PG8_WAIT_L
#undef PG8_BAR
#undef PG8_SCHED
}
}
#define XB_TMO      128
#define XB_XCNT(j)  (256  + 64 * (j))
#define XB_XSUB(j)  (1280 + 64 * (j))
#define XB_XGEN(j)  (2304 + 64 * (j))
#define XB_TOP      3328
#define XB_TOPGEN   3392
#define XCD_BAR_WORDS 3456
#define XB_SPIN_CAP (1u << 18)

__device__ __forceinline__ unsigned xb_ld(unsigned* p)              { return __hip_atomic_load(p, __ATOMIC_RELAXED, __HIP_MEMORY_SCOPE_AGENT); }
__device__ __forceinline__ unsigned xb_add(unsigned* p, unsigned v) { return __hip_atomic_fetch_add(p, v, __ATOMIC_RELAXED, __HIP_MEMORY_SCOPE_AGENT); }
__device__ __forceinline__ unsigned xb_xcc_id() { return (unsigned)__builtin_amdgcn_s_getreg((3 << 11) | 20) & 0xFu; }
#define XB_SPIN(cond, bar) do { unsigned _sp = 0; while (cond) { __builtin_amdgcn_s_sleep(1); \
    if ((++_sp & 255u) == 0u) { if (xb_ld(&(bar)[XB_TMO])) break; if (_sp > XB_SPIN_CAP) { atomicAdd(&(bar)[XB_TMO], 1u); break; } } } } while (0)

struct XcdBarrier {
    unsigned* bar; unsigned x;
    volatile LAS unsigned* st;
};

__device__ __forceinline__ XcdBarrier xcd_barrier_post(unsigned* bar, volatile LAS unsigned* st) {
    XcdBarrier b; b.bar = bar; b.x = xb_xcc_id(); b.st = st;
    if (threadIdx.x == 0) (void)xb_add(&bar[XB_XCNT(b.x)], 1u);
    return b;
}
__device__ __forceinline__ void xcd_barrier_complete(unsigned* bar, unsigned x, unsigned& nloc, unsigned& nx) {
    const unsigned G = gridDim.x * gridDim.y * gridDim.z;
    unsigned sum, cnt, mine, sp = 0u;
    for (;;) {
        sum = 0u; cnt = 0u; mine = 0u;
#pragma unroll
        for (unsigned j = 0; j < 16; ++j) { const unsigned c = xb_ld(&bar[XB_XCNT(j)]); sum += c; cnt += (c > 0u) ? 1u : 0u; mine = (j == x) ? c : mine; }
        if (sum == G) break;
        __builtin_amdgcn_s_sleep(1);
        if ((++sp & 255u) == 0u) { if (xb_ld(&bar[XB_TMO])) break; if (sp > XB_SPIN_CAP) { atomicAdd(&bar[XB_TMO], 1u); break; } }
    }
    nloc = mine > 0u ? mine : 1u; nx = cnt > 0u ? cnt : 1u;
}

__device__ __forceinline__ void xcd_barrier(const XcdBarrier& b) {
    asm volatile("s_waitcnt vmcnt(0)" ::: "memory");
    __syncthreads();
    if (threadIdx.x == 0) {
        unsigned* bar = b.bar;
        __builtin_amdgcn_s_waitcnt(0);
        unsigned nloc = b.st[0], nx = b.st[1];
        if (nloc == 0u) { xcd_barrier_complete(bar, b.x, nloc, nx); b.st[0] = nloc; b.st[1] = nx; }
        const unsigned old = xb_add(&bar[XB_XSUB(b.x)], 1u);
        const unsigned gen = old / nloc;
        if (old + 1u == (gen + 1u) * nloc) {
            __builtin_amdgcn_fence(__ATOMIC_RELEASE, "agent");
            asm volatile("s_waitcnt vmcnt(0)" ::: "memory");
            const unsigned og = xb_add(&bar[XB_TOP], 1u);
            const unsigned tg = og / nx;
            if (og + 1u == (tg + 1u) * nx) xb_add(&bar[XB_TOPGEN], 1u);
            else XB_SPIN(xb_ld(&bar[XB_TOPGEN]) == tg, bar);
            __builtin_amdgcn_fence(__ATOMIC_ACQUIRE, "agent");
            xb_add(&bar[XB_XGEN(b.x)], 1u);
            asm volatile("s_waitcnt vmcnt(0)" ::: "memory");
        } else {
            XB_SPIN(xb_ld(&bar[XB_XGEN(b.x)]) == gen, bar);
            __builtin_amdgcn_fence(__ATOMIC_ACQUIRE, "agent");
            asm volatile("s_waitcnt vmcnt(0)" ::: "memory");
        }
    }
    __syncthreads();
}

struct EpiSwiglu {
  static constexpr bool PERM = true, AFTER_DRAIN = false;
  bf16_t* act;
  DI void operator()(const f32x4 (&acc)[2][2][4][2], const pg8::Unit& u, int wr, int wc, int fr, int fq) const {
    const int row0 = u.pm * 256 + wr * 64 + fr, col0 = u.pn * 128 + wc * 32 + 8 * fq;
#pragma unroll
    for (int ai = 0; ai < 2; ++ai)
#pragma unroll
      for (int m = 0; m < 4; ++m) {
        bf16_t* rowp = act + (size_t)(row0 + ai * 128 + m * 16) * DFF + col0;
        const f32x4 a0 = acc[ai][0][m][0], a1 = acc[ai][0][m][1], b0 = acc[ai][1][m][0], b1 = acc[ai][1][m][1];
        u32x4 w;
        w.x = cvtpk(siluf(a0[0]) * b0[0], siluf(a0[1]) * b0[1]); w.y = cvtpk(siluf(a0[2]) * b0[2], siluf(a0[3]) * b0[3]);
        w.z = cvtpk(siluf(a1[0]) * b1[0], siluf(a1[1]) * b1[1]); w.w = cvtpk(siluf(a1[2]) * b1[2], siluf(a1[3]) * b1[3]);
        *(u32x4*)rowp = w;
      }
  }
};

struct EpiRes {
  static constexpr bool PERM = true, AFTER_DRAIN = false;
  float* h; const float* resA; const float* resB; const float* gate; float coef;
  DI void operator()(const f32x4 (&acc)[2][2][4][2], const pg8::Unit& u, int wr, int wc, int fr, int fq) const {
    const int g = u.pm < 32 ? 0 : (u.pm < 36 ? 1 : 2);
    const float* res = u.pm < 32 ? resA : resB;
    const int row0 = u.pm * 256 + wr * 64 + fr, col0 = u.pn * 256 + wc * 32 + 8 * fq;
    f32x4 gv[2][2];
#pragma unroll
    for (int bj = 0; bj < 2; ++bj)
#pragma unroll
      for (int n = 0; n < 2; ++n) gv[bj][n] = *(const f32x4*)(gate + (size_t)g * 9216 + col0 + bj * 128 + 4 * n) * coef;
#pragma unroll
    for (int ai = 0; ai < 2; ++ai)
#pragma unroll
      for (int m = 0; m < 4; ++m)
#pragma unroll
        for (int bj = 0; bj < 2; ++bj)
#pragma unroll
          for (int n = 0; n < 2; ++n) {
            const size_t idx = (size_t)(row0 + ai * 128 + m * 16) * DM + col0 + bj * 128 + 4 * n;
            const f32x4 r = *(const f32x4*)(res + idx);
            *(f32x4*)(h + idx) = r + gv[bj][n] * acc[ai][bj][m][n];
          }
  }
};

struct EpiInproj {
  static constexpr bool PERM = true, AFTER_DRAIN = false;
  bf16_t* U; bf16_t* HYT; float* out; int l;
  DI void operator()(const f32x4 (&acc)[2][2][4][2], const pg8::Unit& u, int wr, int wc, int fr, int fq) const {
    const int row0 = u.pm * 256 + wr * 64 + fr, cw = wc * 32 + 8 * fq;
    const int pn = u.pn;
    if (pn >= 2 && pn <= 4) {
#pragma unroll
      for (int ai = 0; ai < 2; ++ai)
#pragma unroll
        for (int m = 0; m < 4; ++m)
#pragma unroll
          for (int bj = 0; bj < 2; ++bj)
#pragma unroll
            for (int n = 0; n < 2; ++n)
#pragma unroll
              for (int e = 0; e < 4; ++e) {
                const int c = pn * 256 - 512 + bj * 128 + cw + 4 * n + e, row = row0 + ai * 128 + m * 16;
                HYT[(size_t)c * MT + row] = f2bf(acc[ai][bj][m][n][e]);
              }
    } else {
      const int ub = (pn < 2 ? pn * 256 : pn * 256 - 768) + cw;
#pragma unroll
      for (int ai = 0; ai < 2; ++ai)
#pragma unroll
        for (int m = 0; m < 4; ++m)
#pragma unroll
          for (int bj = 0; bj < 2; ++bj) {
            const int row = row0 + ai * 128 + m * 16;
            const bool ok = (pn < 10) || (bj == 0 && wc == 0);
            if (ok) {
              const f32x4 v0 = acc[ai][bj][m][0], v1 = acc[ai][bj][m][1];
              u32x4 w; w.x = cvtpk(v0[0], v0[1]); w.y = cvtpk(v0[2], v0[3]); w.z = cvtpk(v1[0], v1[1]); w.w = cvtpk(v1[2], v1[3]);
              *(u32x4*)(U + (size_t)row * UW + ub + bj * 128) = w;
              if (u.pm < 32 && (pn == 1 || (pn == 6 && bj == 1))) {
                const int b = row >> 8, t = row & 255;
                const size_t off = (pn == 1 ? (bj == 0 ? OUT_SWAK : OUT_SWAV) : OUT_GQAV) + ((size_t)(b * 512 + l * 256 + t)) * 128 + cw;
                *(f32x4*)(out + off) = v0; *(f32x4*)(out + off + 4) = v1;
              }
            }
          }
    }
  }
};

DI void tr_item(const float* __restrict__ W, int Nsrc, int K, bf16_t* __restrict__ WT, int n0, int sc0, int k0, float* tile, int tid) {
  const int c4 = tid & 15;
#pragma unroll
  for (int rr = 0; rr < 2; ++rr) {
    const int r = (tid >> 4) + 32 * rr, col = sc0 + 4 * c4;
    f32x4 v = {0.f, 0.f, 0.f, 0.f};
    if (col < Nsrc) v = *(const f32x4*)(W + (size_t)(k0 + r) * Nsrc + col);
    float* tp = tile + r * 65 + 4 * c4; tp[0] = v[0]; tp[1] = v[1]; tp[2] = v[2]; tp[3] = v[3];
  }
  __syncthreads();
  const int n = tid >> 3, kq = tid & 7;
  const float* sp = tile + (8 * kq) * 65 + n;
  u32x4 w; w.x = cvtpk(sp[0], sp[65]); w.y = cvtpk(sp[130], sp[195]); w.z = cvtpk(sp[260], sp[325]); w.w = cvtpk(sp[390], sp[455]);
  *(u32x4*)(WT + (size_t)(n0 + n) * K + k0 + 8 * kq) = w;
  __syncthreads();
}

DI void p0_convert(CArgs& a, unsigned char* ldsb, int tid) {
  float* tile = (float*)ldsb;
  bf16_t* WFI = (bf16_t*)(a.ws + WS_WFI); bf16_t* WFO = (bf16_t*)(a.ws + WS_WFO); bf16_t* WIN = (bf16_t*)(a.ws + WS_WIN); bf16_t* WOUT = (bf16_t*)(a.ws + WS_WOUT);
  for (int idx = BID(); idx < 10368; idx += gridDim.x) {
    if (idx < 5632) {
      const int mat = idx / 1408, rem = idx % 1408, nt = rem >> 4, kt = rem & 15, n0 = 64 * nt;
      const int pn = n0 >> 8, bj = (n0 >> 7) & 1, c = n0 & 127, sc0 = bj * 2816 + 128 * pn + c;
      tr_item(a.in[12] + (size_t)mat * 1024 * 5632, 5632, 1024, WFI + (size_t)mat * 5632 * 1024, n0, sc0, 64 * kt, tile, tid);
    } else if (idx < 8448) {
      const int q = idx - 5632, mat = q / 704, rem = q % 704, nt = rem / 44, kt = rem % 44;
      tr_item(a.in[13] + (size_t)mat * 2816 * 1024, 1024, 2816, WFO + (size_t)mat * 1024 * 2816, 64 * nt, 64 * nt, 64 * kt, tile, tid);
    } else if (idx < 9856) {
      const int q = idx - 8448, l = q / 704, rem = q % 704, nt = rem >> 4, kt = rem & 15;
      tr_item(a.in[14] + (size_t)l * 1024 * NIN, NIN, 1024, WIN + (size_t)l * NINP * 1024, 64 * nt, 64 * nt, 64 * kt, tile, tid);
    } else {
      const int q = idx - 9856, l = q >> 8, rem = q & 255, nt = rem >> 4, kt = rem & 15;
      tr_item(a.in[15] + (size_t)l * 1024 * 1024, 1024, 1024, WOUT + (size_t)l * 1024 * 1024, 64 * nt, 64 * nt, 64 * kt, tile, tid);
    }
  }
}

DI void p0_modulation(CArgs& a, unsigned char* ldsb, int tid) {
  float* sc = (float*)ldsb;
  float* red = sc + 3072;
  float* mod = (float*)(a.ws + WS_MOD);
  for (int i = tid; i < 3072; i += 512) { const int g = i >> 10, k = i & 1023; const float x = g == 0 ? a.in[8][k] : a.in[7][(g - 1) * 1024 + k]; sc[i] = x / (1.f + expf(-x)); }
  __syncthreads();
  for (int item = BID(); item < 288; item += gridDim.x) {
    const int l = item / 144, n0 = (item % 144) * 64, cg4 = tid & 15, kg = tid >> 4;
    const float* wp = a.in[9] + (size_t)l * 1024 * 9216 + (size_t)(kg * 32) * 9216 + n0 + 4 * cg4;
    f32x4 acc0 = {0, 0, 0, 0}, acc1 = {0, 0, 0, 0}, acc2 = {0, 0, 0, 0};
#pragma unroll 8
    for (int kk = 0; kk < 32; ++kk) {
      const f32x4 w = *(const f32x4*)(wp + (size_t)kk * 9216);
      const int k = kg * 32 + kk;
      acc0 += w * sc[k]; acc1 += w * sc[1024 + k]; acc2 += w * sc[2048 + k];
    }
    float* rp = red + kg * 192 + 4 * cg4;
#pragma unroll
    for (int e = 0; e < 4; ++e) { rp[e] = acc0[e]; rp[64 + e] = acc1[e]; rp[128 + e] = acc2[e]; }
    __syncthreads();
    if (tid < 192) {
      const int g = tid >> 6, n = tid & 63; float s = 0.f;
      for (int q = 0; q < 32; ++q) s += red[q * 192 + g * 64 + n];
      mod[(size_t)(l * 3 + g) * 9216 + n0 + n] = s + a.in[10][l * 9216 + n0 + n];
    }
    __syncthreads();
  }
}

DI void p0_filters(CArgs& a, unsigned char* ldsb, int tid) {
  float* zs = (float*)ldsb;
  float* h1 = zs + 512;
  float* h2 = h1 + 512;
  bf16_t* F = (bf16_t*)(a.ws + WS_FILT);
  const int w = tid >> 6, lane = tid & 63;
  for (int item = BID(); item < 320; item += gridDim.x) {
    const int l = item / 160, r = item % 160;
    const int L = r < 32 ? 256 : 1024, t = (r < 32 ? 8 * r : 8 * (r - 32)) + w, Loff = r < 32 ? 0 : 512;
    const float tt = (float)t / (float)(L - 1);
    const float wt = (6.283185307179586f / (float)L) * (float)t;
    if (lane < 33) {
      float z;
      if (lane == 0) z = tt;
      else { const int bi = (lane - 1) & 15; const float band = 1e-4f + (float)bi * ((15.f - 1e-4f) / 15.f); z = lane <= 16 ? cosf(band * wt) : -sinf(band * wt); }
      zs[w * 64 + lane] = z;
    }
    __syncthreads();
    { float s = a.in[22][l * 64 + lane];
      for (int i = 0; i < 33; ++i) s += zs[w * 64 + i] * a.in[21][(l * 33 + i) * 64 + lane];
      h1[w * 64 + lane] = sinf(a.in[26][(l * 2 + 0) * 64 + lane] * s); }
    __syncthreads();
    { float s = a.in[24][l * 64 + lane];
      for (int i = 0; i < 64; ++i) s += h1[w * 64 + i] * a.in[23][(l * 64 + i) * 64 + lane];
      h2[w * 64 + lane] = sinf(a.in[26][(l * 2 + 1) * 64 + lane] * s); }
    __syncthreads();
    for (int qq = 0; qq < 16; ++qq) {
      const int col = lane + 64 * qq;
      float s = 0.f;
      for (int i = 0; i < 64; ++i) s += h2[w * 64 + i] * a.in[25][(size_t)(l * 64 + i) * 1024 + col];
      const int dir = col >> 9, o = (col >> 8) & 1, ch = col & 255;
      const float d0 = -4.605170185988091f / 1.5f, d1 = -4.605170185988091f / 0.3f;
      const float delta = d0 + (float)ch * ((d1 - d0) / 255.f);
      s *= expf(-tt * fabsf(delta));
      bf16_t* fp = F + ((size_t)((l * 2 + o) * 256 + ch)) * 2560 + Loff;
      if (dir == 0) fp[L - t] = f2bf(s);
      else { if (t == 0) fp[0] = 0; else fp[L + t] = f2bf(s); }
    }
    __syncthreads();
  }
}

DI const float* xrow(const float* A, const float* B, int row) { return row < MCTX ? A + (size_t)row * DM : B + (size_t)(row - MCTX) * DM; }
DI int grp_of(int row) { return row < MCTX ? 0 : 1 + ((row - MCTX) >> 10); }

DI void norm_mod_phase(const float* srcA, const float* srcB, bf16_t* xn, const float* ng, const float* mod_l, int j, int tid) {
  const int w = tid >> 6, lane = tid & 63;
  for (int row = BID() * 8 + w; row < MT; row += gridDim.x * 8) {
    const float* x = xrow(srcA, srcB, row);
    const float* mg = mod_l + (size_t)grp_of(row) * 9216 + (3 * j) * 1024;
    f32x4 v[4]; float ss = 0.f;
#pragma unroll
    for (int q = 0; q < 4; ++q) { v[q] = *(const f32x4*)(x + 256 * q + 4 * lane); ss += v[q][0] * v[q][0] + v[q][1] * v[q][1] + v[q][2] * v[q][2] + v[q][3] * v[q][3]; }
    ss = wave_sum(ss);
    const float rstd = rsqrtf(ss * (1.f / 1024.f) + EPSF);
#pragma unroll
    for (int q = 0; q < 4; ++q) {
      const int k = 256 * q + 4 * lane;
      const f32x4 g = *(const f32x4*)(ng + k), sh = *(const f32x4*)(mg + k), sc = *(const f32x4*)(mg + 1024 + k);
      const f32x4 y = (v[q] * rstd * g) * (sc + 1.f) + sh;
      u32x2 o; o.x = cvtpk(y[0], y[1]); o.y = cvtpk(y[2], y[3]);
      *(u32x2*)(xn + (size_t)row * DM + k) = o;
    }
  }
}

DI void final_norm_phase(const float* h, float* out, const float* fg, int tid) {
  const int w = tid >> 6, lane = tid & 63;
  for (int row = BID() * 8 + w; row < MT; row += gridDim.x * 8) {
    const float* x = h + (size_t)row * DM;
    f32x4 v[4]; float ss = 0.f;
#pragma unroll
    for (int q = 0; q < 4; ++q) { v[q] = *(const f32x4*)(x + 256 * q + 4 * lane); ss += v[q][0] * v[q][0] + v[q][1] * v[q][1] + v[q][2] * v[q][2] + v[q][3] * v[q][3]; }
    ss = wave_sum(ss);
    const float rstd = rsqrtf(ss * (1.f / 1024.f) + EPSF);
#pragma unroll
    for (int q = 0; q < 4; ++q) { const int k = 256 * q + 4 * lane; *(f32x4*)(out + (size_t)row * DM + k) = v[q] * rstd * *(const f32x4*)(fg + k); }
  }
}

DI void post_proj_phase(bf16_t* U, float* out, const float* qkg, int l, int tid) {
  const int w = tid >> 6, lane = tid & 63;
  for (int row = BID() * 8 + w; row < MT; row += gridDim.x * 8) {
    const bool lat = row >= MCTX;
    float cs = 1.f, sn = 0.f;
    if (lat) {
      const int t = (row - MCTX) & 1023, i = lane & 31, f = i & 15;
      const float inv = exp2f(-(float)f * (13.287712379549449f / 16.f));
      const float ang = (float)(i < 16 ? (t >> 6) : (t & 63)) * inv;
      sincosf(ang, &sn, &cs);
    }
    bf16_t* up = U + (size_t)row * UW;
#pragma unroll
    for (int s = 0; s < 12; ++s) {
      const int base = (s < 4) ? U_QA + 64 * s : (s < 6) ? U_KA + 64 * (s - 4) : (s < 10) ? U_QC + 64 * (s - 6) : U_KC + 64 * (s - 10);
      const bool isq = (s < 4) || (s >= 6 && s < 10), nrm = s >= 6;
      float x = bf2f(up[base + lane]);
      if (nrm) { const float ss = wave_sum(x * x); x = x * rsqrtf(ss * (1.f / 64.f) + EPSF) * qkg[(s < 10 ? 0 : 64) + lane]; }
      if (lat) { const float p = __shfl_xor(x, 32, 64); x = lane < 32 ? x * cs - p * sn : x * cs + p * sn; }
      if (s >= 10 && !lat) { const int b = row >> 8, t = row & 255; out[OUT_GQAK + ((size_t)(b * 512 + l * 256 + t)) * 128 + (s - 10) * 64 + lane] = x; }
      if (isq) x *= QSCALE;
      up[base + lane] = f2bf(x);
    }
  }
}

struct KVRegs { u32x4 k, v; };
constexpr int KROW = 72;
constexpr int KVBUF = 64 * KROW * 2;

DI KVRegs attn_load(const bf16_t* __restrict__ U, int R0, int kcol, int vcol, int k0start, int nt0, const float* __restrict__ ck, const float* __restrict__ cv, int ti, int tid) {
  KVRegs r; const int key = tid >> 3, ds = tid & 7;
  if (ti < nt0) {
    const bf16_t* p = U + (size_t)(R0 + k0start + 64 * ti + key) * UW;
    r.k = *(const u32x4*)(p + kcol + 8 * ds); r.v = *(const u32x4*)(p + vcol + 8 * ds);
  } else {
    const size_t off = (size_t)(64 * (ti - nt0) + key) * 128 + 8 * ds;
    const f32x4 a0 = *(const f32x4*)(ck + off), a1 = *(const f32x4*)(ck + off + 4), b0 = *(const f32x4*)(cv + off), b1 = *(const f32x4*)(cv + off + 4);
    r.k.x = cvtpk(a0[0], a0[1]); r.k.y = cvtpk(a0[2], a0[3]); r.k.z = cvtpk(a1[0], a1[1]); r.k.w = cvtpk(a1[2], a1[3]);
    r.v.x = cvtpk(b0[0], b0[1]); r.v.y = cvtpk(b0[2], b0[3]); r.v.z = cvtpk(b1[0], b1[1]); r.v.w = cvtpk(b1[2], b1[3]);
  }
  return r;
}
DI void attn_write(unsigned char* kb, unsigned char* vb, const KVRegs& r, int tid) {
  const int key = tid >> 3, ds = tid & 7;
  *(u32x4*)(kb + (key * KROW + 8 * ds) * 2) = r.k;
  bf16_t* vt = (bf16_t*)vb + (8 * ds) * KROW + key;
  vt[0] = (bf16_t)(r.v.x & 0xffff); vt[KROW] = (bf16_t)(r.v.x >> 16); vt[2 * KROW] = (bf16_t)(r.v.y & 0xffff); vt[3 * KROW] = (bf16_t)(r.v.y >> 16);
  vt[4 * KROW] = (bf16_t)(r.v.z & 0xffff); vt[5 * KROW] = (bf16_t)(r.v.z >> 16); vt[6 * KROW] = (bf16_t)(r.v.w & 0xffff); vt[7 * KROW] = (bf16_t)(r.v.w >> 16);
}

DI void attn_unit(CArgs& a, int l, int uidx, unsigned char* ldsb, int tid) {
  const bf16_t* U = (const bf16_t*)(a.ws + WS_ACT);
  bf16_t* O = (bf16_t*)(a.ws + WS_O);
  int type, b, kvh, qb;
  if (uidx < 64) { type = uidx < 32 ? 3 : 2; const int j = uidx & 31; b = j >> 4; kvh = (j >> 3) & 1; qb = j & 7; }
  else { type = uidx < 192 ? 0 : 1; const int j = (uidx - 64) & 127; b = j >> 2; kvh = (j >> 1) & 1; qb = j & 1; }
  const bool lat = type >= 2, isA = (type == 0 || type == 2);
  const int R0 = lat ? MCTX + b * 1024 : b * 256;
  const int w = tid >> 6, lane = tid & 63, hh = lane >> 5, l31 = lane & 31, g = w >> 2, head = 2 * kvh + g;
  const int qcol = (isA ? U_QA : U_QC) + head * 64, kcol = (isA ? U_KA : U_KC) + kvh * 64, vcol = (isA ? U_VA : U_VC) + kvh * 64;
  int k0start = 0, nk0 = lat ? 1024 : 256;
  if (type == 2) { const int lo = qb > 0 ? (qb - 1) * 128 : 0, hi = qb < 7 ? (qb + 2) * 128 : 1024; k0start = lo; nk0 = hi - lo; }
  const int nt0 = nk0 >> 6, nt = nt0 + (lat ? 8 : 0);
  const float* ck = nullptr; const float* cv = nullptr;
  if (lat) { const size_t co = ((size_t)((b * 2 + l) * 512)) * 128 + kvh * 64; ck = a.in[isA ? 2 : 4] + co; cv = a.in[isA ? 3 : 5] + co; }
  const int qrow = R0 + qb * 128 + (w & 3) * 32 + l31;
  const int qpos = qb * 128 + (w & 3) * 32 + l31;
  bf16x8 qf[4];
#pragma unroll
  for (int ks = 0; ks < 4; ++ks) qf[ks] = *(const bf16x8*)(U + (size_t)qrow * UW + qcol + 16 * ks + 8 * hh);
  float m_run = -1e30f, l_run = 0.f;
  if (isA) { m_run = a.in[17][l * 4 + head] * 1.4426950408889634f; l_run = hh == 0 ? 1.f : 0.f; }
  f32x16 o0, o1;
#pragma unroll
  for (int i = 0; i < 16; ++i) { o0[i] = 0.f; o1[i] = 0.f; }
  KVRegs regs = attn_load(U, R0, kcol, vcol, k0start, nt0, ck, cv, 0, tid);
  attn_write(ldsb, ldsb + KVBUF, regs, tid);
  __syncthreads();
  for (int ti = 0; ti < nt; ++ti) {
    const int cur = ti & 1;
    if (ti + 1 < nt) regs = attn_load(U, R0, kcol, vcol, k0start, nt0, ck, cv, ti + 1, tid);
    const unsigned char* kb = cur ? ldsb + 2 * KVBUF : ldsb;
    const unsigned char* vb = kb + KVBUF;
    const bool domask = (type == 2) && (ti < nt0);
#pragma unroll
    for (int sub = 0; sub < 2; ++sub) {
      f32x16 s;
#pragma unroll
      for (int i = 0; i < 16; ++i) s[i] = 0.f;
#pragma unroll
      for (int ks = 0; ks < 4; ++ks) {
        const bf16x8 ka = *(const bf16x8*)(kb + ((32 * sub + l31) * KROW + 16 * ks + 8 * hh) * 2);
        s = __builtin_amdgcn_mfma_f32_32x32x16_bf16(ka, qf[ks], s, 0, 0, 0);
      }
      if (domask) {
        const int kp0 = k0start + 64 * ti + 32 * sub;
#pragma unroll
        for (int i = 0; i < 16; ++i) { const int d = qpos - (kp0 + crow(i, hh)); if (d > 128 || d < -128) s[i] = -1e30f; }
      }
      float mt = s[0];
#pragma unroll
      for (int i = 1; i < 16; ++i) mt = fmaxf(mt, s[i]);
      mt = fmaxf(mt, __shfl_xor(mt, 32, 64));
      const float mn = fmaxf(m_run, mt);
      const float alpha = __builtin_amdgcn_exp2f(m_run - mn);
      m_run = mn;
      float ps = 0.f;
#pragma unroll
      for (int i = 0; i < 16; ++i) { s[i] = __builtin_amdgcn_exp2f(s[i] - mn); ps += s[i]; }
      l_run = l_run * alpha + ps;
#pragma unroll
      for (int i = 0; i < 16; ++i) { o0[i] *= alpha; o1[i] *= alpha; }
#pragma unroll
      for (int st = 0; st < 2; ++st) {
        u32x4 pw; pw.x = cvtpk(s[8 * st], s[8 * st + 1]); pw.y = cvtpk(s[8 * st + 2], s[8 * st + 3]); pw.z = cvtpk(s[8 * st + 4], s[8 * st + 5]); pw.w = cvtpk(s[8 * st + 6], s[8 * st + 7]);
        const bf16x8 pf = __builtin_bit_cast(bf16x8, pw);
        const int kofs = 32 * sub + 16 * st + 4 * hh;
        {
          const u32x2 lo = *(const u32x2*)(vb + (l31 * KROW + kofs) * 2), hi = *(const u32x2*)(vb + (l31 * KROW + kofs + 8) * 2);
          u32x4 vw; vw.x = lo.x; vw.y = lo.y; vw.z = hi.x; vw.w = hi.y;
          o0 = __builtin_amdgcn_mfma_f32_32x32x16_bf16(__builtin_bit_cast(bf16x8, vw), pf, o0, 0, 0, 0);
        }
        {
          const u32x2 lo = *(const u32x2*)(vb + ((32 + l31) * KROW + kofs) * 2), hi = *(const u32x2*)(vb + ((32 + l31) * KROW + kofs + 8) * 2);
          u32x4 vw; vw.x = lo.x; vw.y = lo.y; vw.z = hi.x; vw.w = hi.y;
          o1 = __builtin_amdgcn_mfma_f32_32x32x16_bf16(__builtin_bit_cast(bf16x8, vw), pf, o1, 0, 0, 0);
        }
      }
    }
    if (ti + 1 < nt) { unsigned char* nb = cur ? ldsb : ldsb + 2 * KVBUF; attn_write(nb, nb + KVBUF, regs, tid); }
    __syncthreads();
  }
  const float lt = l_run + __shfl_xor(l_run, 32, 64);
  const float inv = 1.f / lt;
  bf16_t* ost = (bf16_t*)(ldsb + w * (32 * KROW * 2));
#pragma unroll
  for (int gq = 0; gq < 4; ++gq) {
    u32x2 p0, p1;
    p0.x = cvtpk(o0[4 * gq] * inv, o0[4 * gq + 1] * inv); p0.y = cvtpk(o0[4 * gq + 2] * inv, o0[4 * gq + 3] * inv);
    p1.x = cvtpk(o1[4 * gq] * inv, o1[4 * gq + 1] * inv); p1.y = cvtpk(o1[4 * gq + 2] * inv, o1[4 * gq + 3] * inv);
    *(u32x2*)(ost + l31 * KROW + 8 * gq + 4 * hh) = p0;
    *(u32x2*)(ost + l31 * KROW + 32 + 8 * gq + 4 * hh) = p1;
  }
  __syncthreads();
  {
    const int q = lane >> 1, half = lane & 1;
    const int orow = R0 + qb * 128 + (w & 3) * 32 + q;
    bf16_t* op = O + (size_t)orow * 768 + (isA ? 0 : 256) + head * 64 + 32 * half;
    const bf16_t* sp = ost + q * KROW + 32 * half;
#pragma unroll
    for (int e = 0; e < 4; ++e) *(u32x4*)(op + 8 * e) = *(const u32x4*)(sp + 8 * e);
  }
  __syncthreads();
}

DI void hyena_unit(CArgs& a, int l, int conv, int c, int type, unsigned char* ldsb, int tid) {
  const int L = type ? 1024 : 256, nseq = type ? 2 : 32, tokbase = type ? MCTX : 0, L2 = 2 * L, L3 = 3 * L, CPS = L2 + 8;
  bf16_t* cp = (bf16_t*)ldsb;
  bf16_t* up = (bf16_t*)(ldsb + 33024);
  bf16_t* gt = (bf16_t*)(ldsb + 33024 + 49152);
  float* red = (float*)(ldsb + 33024 + 49152 + 16384);
  const bf16_t* HYT = (const bf16_t*)(a.ws + WS_HYT);
  bf16_t* Y1T = (bf16_t*)(a.ws + WS_Y1T);
  bf16_t* OBT = (bf16_t*)(a.ws + WS_OBT);
  const bf16_t* Kr = (const bf16_t*)(a.ws + WS_FILT) + ((size_t)((l * 2 + conv) * 256 + c)) * 2560 + (type ? 512 : 0);
  for (int idx = tid; idx < 8 * L2; idx += 512) { const int r = idx / L2, y = idx - r * L2; cp[r * CPS + y] = (y + r < L2) ? Kr[y + r] : (bf16_t)0; }
  const float* cw = a.in[19] + l * 3 * 768; const float* cb = a.in[20] + l * 768;
  const int gc = (conv == 0 ? 256 : 512) + c;
  const float vw0 = cw[c], vw1 = cw[768 + c], vw2 = cw[1536 + c], vb = cb[c];
  const float gw0 = cw[gc], gw1 = cw[768 + gc], gw2 = cw[1536 + gc], gb = cb[gc];
  const int ntok = nseq * L;
  for (int idx = tid; idx < ntok; idx += 512) {
    const int s = idx / L, p = idx - s * L;
    const size_t tk = (size_t)tokbase + idx;
    const bf16_t* hg = HYT + (size_t)gc * MT + tk;
    const float g0 = p > 0 ? bf2f(hg[-1]) : 0.f, g1 = bf2f(hg[0]), g2 = p < L - 1 ? bf2f(hg[1]) : 0.f;
    gt[idx] = f2bf(gw0 * g0 + gw1 * g1 + gw2 * g2 + gb);
    float uv;
    if (conv == 0) {
      const bf16_t* hv = HYT + (size_t)c * MT + tk;
      const float v0 = p > 0 ? bf2f(hv[-1]) : 0.f, v1 = bf2f(hv[0]), v2 = p < L - 1 ? bf2f(hv[1]) : 0.f;
      uv = vw0 * v0 + vw1 * v1 + vw2 * v2 + vb;
    } else uv = bf2f(Y1T[(size_t)c * MT + tk]);
    up[s * L3 + L + p] = f2bf(uv);
    up[s * L3 + p] = 0; up[s * L3 + L2 + p] = 0;
  }
  __syncthreads();
  const int w = tid >> 6, lane = tid & 63, hh = lane >> 5, i = lane & 31, r = (8 - (i & 7)) & 7;
  int aa, sq, mlo, mhi;
  if (type == 0) { aa = i & 7; sq = 4 * w + (i >> 3); mlo = -7; mhi = 7; }
  else { aa = i; sq = w >> 2; mlo = -31 + 16 * (w & 3); mhi = mlo + 15 > 31 ? 31 : mlo + 15; }
  const bf16_t* useq = up + sq * L3;
  const bf16_t* cpr = cp + r * CPS;
  f32x16 acc;
#pragma unroll
  for (int q = 0; q < 16; ++q) acc[q] = 0.f;
  for (int m = mlo; m <= mhi; ++m) {
#pragma unroll
    for (int ks = 0; ks < 2; ++ks) {
      const int xi0 = L + 16 * ks + 8 * hh - i - 32 * m;
      const bf16x8 A = *(const bf16x8*)(cpr + (xi0 - r));
      const bf16x8 B = *(const bf16x8*)(useq + 32 * (aa - m) + 16 * ks + 8 * hh + L);
      acc = __builtin_amdgcn_mfma_f32_32x32x16_bf16(A, B, acc, 0, 0, 0);
    }
  }
  if (type == 1) {
#pragma unroll
    for (int q = 0; q < 16; ++q) red[w * 1024 + q * 64 + lane] = acc[q];
    __syncthreads();
    if ((w & 3) == 0) {
#pragma unroll
      for (int q = 0; q < 16; ++q) acc[q] += red[(w + 1) * 1024 + q * 64 + lane] + red[(w + 2) * 1024 + q * 64 + lane] + red[(w + 3) * 1024 + q * 64 + lane];
    }
  }
  if (type == 0 || (w & 3) == 0) {
    const float bias = a.in[27][(l * 2 + conv) * 256 + c];
    bf16_t* dst = (conv == 0 ? Y1T : OBT) + (size_t)c * MT + tokbase + sq * L;
#pragma unroll
    for (int gq = 0; gq < 4; ++gq) {
      float y[4];
#pragma unroll
      for (int e = 0; e < 4; ++e) {
        const int t = 32 * aa + 8 * gq + 4 * hh + e;
        y[e] = (acc[4 * gq + e] + bias * bf2f(useq[L + t])) * bf2f(gt[sq * L + t]);
      }
      u32x2 o; o.x = cvtpk(y[0], y[1]); o.y = cvtpk(y[2], y[3]);
      *(u32x2*)(dst + 32 * aa + 8 * gq + 4 * hh) = o;
    }
  }
  __syncthreads();
}

struct GlaLds { float *qs, *ks, *vs, *gls, *Ws, *bs, *gb, *A1, *A2; };
DI GlaLds gla_lds(unsigned char* ldsb) {
  GlaLds g; float* p = (float*)ldsb;
  g.qs = p; p += 64 * 33; g.ks = p; p += 64 * 33; g.vs = p; p += 64 * 65; g.gls = p; p += 64 * 32; g.Ws = p; p += 1024; g.bs = p; p += 64;
  g.gb = p; p += 2 * 64 * 33; g.A1 = p; p += 64 * 65; g.A2 = p; p += 64 * 65; return g;
}
DI int gla_row0(int seq, int cidx) { return (seq < 32 ? seq * 256 : MCTX + (seq - 32) * 1024) + 64 * cidx; }
DI int gla_gc(int seq, int n) { return (seq < 32 ? 4 * seq : 128 + 16 * (seq - 32)) + n; }

DI void gla_prep(CArgs& a, int l, int seq, int h, int cidx, const GlaLds& G, int tid) {
  const bf16_t* U = (const bf16_t*)(a.ws + WS_ACT);
  const int R0 = gla_row0(seq, cidx);
  { const int i = tid >> 3, d4 = (tid & 7) * 4; const bf16_t* rp = U + (size_t)(R0 + i) * UW;
    const u32x2 qv = *(const u32x2*)(rp + U_QD + h * 32 + d4), kv = *(const u32x2*)(rp + U_KD + h * 32 + d4);
    float* qd = G.qs + i * 33 + d4; qd[0] = bflo(qv.x); qd[1] = bfhi(qv.x); qd[2] = bflo(qv.y); qd[3] = bfhi(qv.y);
    float* kd = G.ks + i * 33 + d4; kd[0] = bflo(kv.x); kd[1] = bfhi(kv.x); kd[2] = bflo(kv.y); kd[3] = bfhi(kv.y);
    const int v8 = (tid & 7) * 8; const u32x4 vv = *(const u32x4*)(rp + U_VD + h * 64 + v8);
    float* vd = G.vs + i * 65 + v8; vd[0] = bflo(vv.x); vd[1] = bfhi(vv.x); vd[2] = bflo(vv.y); vd[3] = bfhi(vv.y); vd[4] = bflo(vv.z); vd[5] = bfhi(vv.z); vd[6] = bflo(vv.w); vd[7] = bfhi(vv.w);
    if (tid < 256) { const int i2 = tid >> 2, c8 = (tid & 3) * 8; const u32x4 gv = *(const u32x4*)(U + (size_t)(R0 + i2) * UW + U_GD + c8);
      float* gd = G.gls + i2 * 32 + c8; gd[0] = bflo(gv.x); gd[1] = bfhi(gv.x); gd[2] = bflo(gv.y); gd[3] = bfhi(gv.y); gd[4] = bflo(gv.z); gd[5] = bfhi(gv.z); gd[6] = bflo(gv.w); gd[7] = bfhi(gv.w); }
  }
  for (int e = tid; e < 1024; e += 512) { const int z = e >> 9, r = (e >> 5) & 15, d = e & 31; G.Ws[e] = a.in[28][(size_t)((l * 2 + z) * 16 + r) * 128 + h * 32 + d]; }
  if (tid < 64) G.bs[tid] = a.in[29][(l * 2 + (tid >> 5)) * 128 + h * 32 + (tid & 31)];
  for (int e = tid; e < 64 * 65; e += 512) { G.A1[e] = 0.f; G.A2[e] = 0.f; }
  __syncthreads();
#pragma unroll
  for (int e = 0; e < 8; ++e) {
    const int idx = tid * 8 + e, z = idx >> 11, i = (idx >> 5) & 63, d = idx & 31;
    float s = G.bs[z * 32 + d];
#pragma unroll
    for (int r = 0; r < 16; ++r) s += G.gls[i * 32 + z * 16 + r] * G.Ws[z * 512 + r * 32 + d];
    const float ls = fminf(s, 0.f) - log1pf(expf(-fabsf(s)));
    G.gb[z * 2112 + i * 33 + d] = ls * (1.f / 16.f);
  }
  __syncthreads();
  if (tid < 64) {
    const int z = tid >> 5, d = tid & 31; float run = 0.f;
    if (z == 0) { for (int i = 0; i < 64; ++i) { run += G.gb[i * 33 + d]; G.gb[i * 33 + d] = run; } }
    else { for (int i = 63; i >= 0; --i) { run += G.gb[2112 + i * 33 + d]; G.gb[2112 + i * 33 + d] = run; } }
  }
  __syncthreads();
}

constexpr float GLA_QS = 0.17677669529663687f;

DI void gla_a_unit(CArgs& a, int l, int uidx, unsigned char* ldsb, int tid) {
  int seq, h, cidx, nc;
  if (uidx < 512) { seq = uidx >> 4; h = (uidx >> 2) & 3; cidx = uidx & 3; nc = 4; } else { const int j = uidx - 512; seq = 32 + (j >> 6); h = (j >> 4) & 3; cidx = j & 15; nc = 16; }
  const GlaLds G = gla_lds(ldsb);
  gla_prep(a, l, seq, h, cidx, G, tid);
  const int w = tid >> 6, lane = tid & 63, hh = lane >> 5, l31 = lane & 31;
  const int R0 = gla_row0(seq, cidx);
  if (w < 6) {
    const int dir = w / 3, which = w % 3;
    const int ib = dir == 0 ? (which > 0) : (which == 2), jb = dir == 0 ? (which == 2) : (which > 0);
    const float* bz = G.gb + dir * 2112;
    f32x16 acc;
#pragma unroll
    for (int q = 0; q < 16; ++q) acc[q] = 0.f;
    const int ii = 32 * ib + l31, jj = 32 * jb + l31;
#pragma unroll 4
    for (int kk = 0; kk < 16; ++kk) {
      const int d = 2 * kk + hh;
      const float av = G.qs[ii * 33 + d] * __expf(bz[ii * 33 + d]) * GLA_QS;
      const float bv = G.ks[jj * 33 + d] * __expf(-bz[jj * 33 + d]);
      acc = __builtin_amdgcn_mfma_f32_32x32x2f32(av, bv, acc, 0, 0, 0);
    }
    float* Az = dir == 0 ? G.A1 : G.A2;
#pragma unroll
    for (int q = 0; q < 16; ++q) {
      const int i2 = 32 * ib + crow(q, hh);
      const bool keep = dir == 0 ? (jj <= i2) : (jj >= i2);
      Az[i2 * 65 + jj] = keep ? acc[q] : 0.f;
    }
  }
  __syncthreads();
  if (w < 4) {
    const int ib = w >> 1, vb = w & 1, ii = 32 * ib + l31;
    f32x16 acc;
#pragma unroll
    for (int q = 0; q < 16; ++q) acc[q] = 0.f;
#pragma unroll 4
    for (int kk = 0; kk < 32; ++kk) {
      const int j = 2 * kk + hh;
      const float av = G.A1[ii * 65 + j] + G.A2[ii * 65 + j];
      const float bv = G.vs[j * 65 + 32 * vb + l31];
      acc = __builtin_amdgcn_mfma_f32_32x32x2f32(av, bv, acc, 0, 0, 0);
    }
    float* od = (float*)(a.ws + WS_OD);
#pragma unroll
    for (int q = 0; q < 16; ++q) od[(size_t)(R0 + 32 * ib + crow(q, hh)) * 256 + h * 64 + 32 * vb + l31] = acc[q];
  } else {
    const int dir = (w - 4) >> 1, vb = w & 1;
    const float* bz = G.gb + dir * 2112;
    const float blast = dir == 0 ? bz[63 * 33 + l31] : bz[l31];
    f32x16 acc;
#pragma unroll
    for (int q = 0; q < 16; ++q) acc[q] = 0.f;
#pragma unroll 4
    for (int kk = 0; kk < 32; ++kk) {
      const int j = 2 * kk + hh;
      const float av = G.ks[j * 33 + l31] * __expf(blast - bz[j * 33 + l31]);
      const float bv = G.vs[j * 65 + 32 * vb + l31];
      acc = __builtin_amdgcn_mfma_f32_32x32x2f32(av, bv, acc, 0, 0, 0);
    }
    const int n = dir == 0 ? cidx : nc - 1 - cidx;
    const size_t gi = (size_t)(gla_gc(seq, n) * 4 + h) * 2 + dir;
    float* glc = (float*)(a.ws + WS_GLC) + gi * 2048;
#pragma unroll
    for (int q = 0; q < 16; ++q) glc[crow(q, hh) * 64 + 32 * vb + l31] = acc[q];
    if (vb == 0 && hh == 0) ((float*)(a.ws + WS_GLD))[gi * 32 + l31] = __expf(blast);
  }
  __syncthreads();
}

DI void gla_b_unit(CArgs& a, int l, int uidx, unsigned char* ldsb, int tid) {
  int seq, h, cidx, nc;
  if (uidx < 512) { seq = uidx >> 4; h = (uidx >> 2) & 3; cidx = uidx & 3; nc = 4; } else { const int j = uidx - 512; seq = 32 + (j >> 6); h = (j >> 4) & 3; cidx = j & 15; nc = 16; }
  const GlaLds G = gla_lds(ldsb);
  gla_prep(a, l, seq, h, cidx, G, tid);
  float* Ss = G.A1;
  const int w = tid >> 6, lane = tid & 63, hh = lane >> 5, l31 = lane & 31;
  const int R0 = gla_row0(seq, cidx);
  {
    const int dir = tid >> 8, e = tid & 255, d = e >> 3, v0 = (e & 7) * 8;
    float S[8];
    if (seq >= 32) { const float* sp = a.in[6] + ((size_t)((((seq - 32) * 2 + l) * 2 + dir) * 4 + h)) * 2048 + d * 64 + v0;
#pragma unroll
      for (int j = 0; j < 8; ++j) S[j] = sp[j]; }
    else {
#pragma unroll
      for (int j = 0; j < 8; ++j) S[j] = 0.f; }
    const int npos = dir == 0 ? cidx : nc - 1 - cidx;
    const float* glc = (const float*)(a.ws + WS_GLC); const float* gld = (const float*)(a.ws + WS_GLD);
    for (int n = 0; n < npos; ++n) {
      const size_t gi = (size_t)(gla_gc(seq, n) * 4 + h) * 2 + dir;
      const float dec = gld[gi * 32 + d];
      const f32x4 c0 = *(const f32x4*)(glc + gi * 2048 + d * 64 + v0), c1 = *(const f32x4*)(glc + gi * 2048 + d * 64 + v0 + 4);
#pragma unroll
      for (int j = 0; j < 4; ++j) { S[j] = dec * S[j] + c0[j]; S[4 + j] = dec * S[4 + j] + c1[j]; }
    }
#pragma unroll
    for (int j = 0; j < 8; ++j) Ss[dir * 2080 + d * 65 + v0 + j] = S[j];
    if (seq < 32 && npos == nc - 1) {
      const size_t gi = (size_t)(gla_gc(seq, npos) * 4 + h) * 2 + dir;
      const float dec = gld[gi * 32 + d];
      float* op = a.out + OUT_STATE + ((size_t)(((seq * 2 + l) * 2 + dir) * 4 + h)) * 2048 + d * 64 + v0;
#pragma unroll
      for (int j = 0; j < 8; ++j) op[j] = dec * S[j] + glc[gi * 2048 + d * 64 + v0 + j];
    }
  }
  __syncthreads();
  if (w < 4) {
    const int ib = w >> 1, vb = w & 1, ii = 32 * ib + l31;
    f32x16 acc;
#pragma unroll
    for (int q = 0; q < 16; ++q) acc[q] = 0.f;
#pragma unroll
    for (int dir = 0; dir < 2; ++dir) {
      const float* bz = G.gb + dir * 2112;
#pragma unroll 4
      for (int kk = 0; kk < 16; ++kk) {
        const int d = 2 * kk + hh;
        const float av = G.qs[ii * 33 + d] * __expf(bz[ii * 33 + d]) * GLA_QS;
        const float bv = Ss[dir * 2080 + d * 65 + 32 * vb + l31];
        acc = __builtin_amdgcn_mfma_f32_32x32x2f32(av, bv, acc, 0, 0, 0);
      }
    }
    const float* od = (const float*)(a.ws + WS_OD);
    bf16_t* O = (bf16_t*)(a.ws + WS_O);
#pragma unroll
    for (int q = 0; q < 16; ++q) {
      const int row = R0 + 32 * ib + crow(q, hh);
      O[(size_t)row * 768 + 512 + h * 64 + 32 * vb + l31] = f2bf(acc[q] + od[(size_t)row * 256 + h * 64 + 32 * vb + l31]);
    }
  }
  __syncthreads();
}

DI void merge_phase(CArgs& a, int l, unsigned char* ldsb, int tid) {
  bf16_t* obs = (bf16_t*)ldsb;
  const bf16_t* O = (const bf16_t*)(a.ws + WS_O); const bf16_t* OBT = (const bf16_t*)(a.ws + WS_OBT); const bf16_t* U = (const bf16_t*)(a.ws + WS_ACT);
  bf16_t* cat = (bf16_t*)(a.ws + WS_XN);
  const float* mg = a.in[16] + l * 1024;
  const int w = tid >> 6, lane = tid & 63;
  for (int tile = BID(); tile < MT / 32; tile += gridDim.x) {
    const int t0 = tile * 32;
    { const int c = tid >> 1, half = tid & 1;
      const u32x4 x0 = *(const u32x4*)(OBT + (size_t)c * MT + t0 + 16 * half), x1 = *(const u32x4*)(OBT + (size_t)c * MT + t0 + 16 * half + 8);
      bf16_t* d = obs + (16 * half) * 264 + c;
      d[0] = (bf16_t)(x0.x & 0xffff); d[264] = (bf16_t)(x0.x >> 16); d[2 * 264] = (bf16_t)(x0.y & 0xffff); d[3 * 264] = (bf16_t)(x0.y >> 16);
      d[4 * 264] = (bf16_t)(x0.z & 0xffff); d[5 * 264] = (bf16_t)(x0.z >> 16); d[6 * 264] = (bf16_t)(x0.w & 0xffff); d[7 * 264] = (bf16_t)(x0.w >> 16);
      d[8 * 264] = (bf16_t)(x1.x & 0xffff); d[9 * 264] = (bf16_t)(x1.x >> 16); d[10 * 264] = (bf16_t)(x1.y & 0xffff); d[11 * 264] = (bf16_t)(x1.y >> 16);
      d[12 * 264] = (bf16_t)(x1.z & 0xffff); d[13 * 264] = (bf16_t)(x1.z >> 16); d[14 * 264] = (bf16_t)(x1.w & 0xffff); d[15 * 264] = (bf16_t)(x1.w >> 16); }
    __syncthreads();
#pragma unroll
    for (int k = 0; k < 4; ++k) {
      const int tl = 4 * w + k, row = t0 + tl;
      const u32x2 wa = *(const u32x2*)(O + (size_t)row * 768 + 4 * lane), wc = *(const u32x2*)(O + (size_t)row * 768 + 256 + 4 * lane), wd = *(const u32x2*)(O + (size_t)row * 768 + 512 + 4 * lane);
      const u32x2 wb = *(const u32x2*)(obs + tl * 264 + 4 * lane), wr = *(const u32x2*)(U + (size_t)row * UW + U_RD + 4 * lane);
      float xa[4] = {bflo(wa.x), bfhi(wa.x), bflo(wa.y), bfhi(wa.y)}, xb[4] = {bflo(wb.x), bfhi(wb.x), bflo(wb.y), bfhi(wb.y)};
      float xc[4] = {bflo(wc.x), bfhi(wc.x), bflo(wc.y), bfhi(wc.y)}, xd[4] = {bflo(wd.x), bfhi(wd.x), bflo(wd.y), bfhi(wd.y)};
      float rd[4] = {bflo(wr.x), bfhi(wr.x), bflo(wr.y), bfhi(wr.y)};
      float sa = xa[0] * xa[0] + xa[1] * xa[1] + xa[2] * xa[2] + xa[3] * xa[3];
      float sb = xb[0] * xb[0] + xb[1] * xb[1] + xb[2] * xb[2] + xb[3] * xb[3];
      float sc = xc[0] * xc[0] + xc[1] * xc[1] + xc[2] * xc[2] + xc[3] * xc[3];
      float sd = xd[0] * xd[0] + xd[1] * xd[1] + xd[2] * xd[2] + xd[3] * xd[3];
      sa = wave_sum(sa); sb = wave_sum(sb); sc = wave_sum(sc);
#pragma unroll
      for (int o = 8; o >= 1; o >>= 1) sd += __shfl_xor(sd, o, 64);
      const float ra = rsqrtf(sa * (1.f / 256.f) + EPSF), rb = rsqrtf(sb * (1.f / 256.f) + EPSF), rc = rsqrtf(sc * (1.f / 256.f) + EPSF), rdn = rsqrtf(sd * (1.f / 64.f) + EPSF);
      const f32x4 ga = *(const f32x4*)(mg + 4 * lane), gb = *(const f32x4*)(mg + 256 + 4 * lane), gc = *(const f32x4*)(mg + 512 + 4 * lane), gd = *(const f32x4*)(mg + 768 + 4 * lane);
      float ya[4], yb[4], yc[4], yd[4];
#pragma unroll
      for (int e = 0; e < 4; ++e) { ya[e] = xa[e] * ra * ga[e]; yb[e] = xb[e] * rb * gb[e]; yc[e] = xc[e] * rc * gc[e]; yd[e] = xd[e] * rdn * gd[e] * (rd[e] / (1.f + __expf(-rd[e]))); }
      bf16_t* cp = cat + (size_t)row * DM + 4 * lane;
      u32x2 o;
      o.x = cvtpk(ya[0], ya[1]); o.y = cvtpk(ya[2], ya[3]); *(u32x2*)(cp) = o;
      o.x = cvtpk(yb[0], yb[1]); o.y = cvtpk(yb[2], yb[3]); *(u32x2*)(cp + 256) = o;
      o.x = cvtpk(yc[0], yc[1]); o.y = cvtpk(yc[2], yc[3]); *(u32x2*)(cp + 512) = o;
      o.x = cvtpk(yd[0], yd[1]); o.y = cvtpk(yd[2], yd[3]); *(u32x2*)(cp + 768) = o;
    }
    __syncthreads();
  }
}

#ifndef REP_G1
#define REP_G1 1
#endif
#ifndef REP_G2
#define REP_G2 1
#endif
#ifndef REP_G3
#define REP_G3 1
#endif
#ifndef REP_N
#define REP_N 1
#endif
#ifndef REP_M1
#define REP_M1 1
#endif
#ifndef REP_M2
#define REP_M2 1
#endif
#ifndef REP_MG
#define REP_MG 1
#endif
#ifndef REP_P0
#define REP_P0 1
#endif
#ifndef REP_SYNC
#define REP_SYNC 1
#endif

#ifdef NO_ATTN
#define ATTN(...) do{}while(0)
#else
#define ATTN attn_unit
#endif
#ifdef NO_GLAA
#define GLAA(...) do{}while(0)
#else
#define GLAA gla_a_unit
#endif
#ifdef NO_GLAB
#define GLAB(...) do{}while(0)
#else
#define GLAB gla_b_unit
#endif
#ifdef NO_HY
#define HYEN(...) do{}while(0)
#else
#define HYEN hyena_unit
#endif

DI int q_next(unsigned* ctr, unsigned char* ldsb, int tid) {
  volatile int* slot = (volatile int*)(ldsb + LDS_CTL_OFF);
  if (tid == 0) *slot = (int)__hip_atomic_fetch_add(ctr, 1u, __ATOMIC_RELAXED, __HIP_MEMORY_SCOPE_AGENT);
  __syncthreads();
  const int v = *slot;
  __syncthreads();
  return v;
}

#ifndef N_LAUNCH_PER_PHASE
#define N_LAUNCH_PER_PHASE 0
#endif
constexpr int NPHASE = 28;

__global__ void __launch_bounds__(512, 2) fwd_kernel(Args a_) {
  extern __shared__ __attribute__((aligned(16))) unsigned char lds[];
  cg::grid_group grid = cg::this_grid();
  if (threadIdx.x < 16) ((volatile LAS unsigned*)((LAS unsigned char*)lds + LDS_CTL_OFF))[threadIdx.x] = 0u;
  __syncthreads();
  XcdBarrier xbar = xcd_barrier_post((unsigned*)(a_.ws + WS_BAR), (volatile LAS unsigned*)((LAS unsigned char*)lds + LDS_CTL_OFF + 16));
  const int ph_hi = a_.ph_hi;
  for (int ph = a_.ph_lo; ph < ph_hi; ++ph) {
    CArgs* ap = (CArgs*)__builtin_amdgcn_kernarg_segment_ptr();
    asm volatile("" : "+s"(ap));
    CArgs& a = *ap;
    int tid = threadIdx.x; asm volatile("" : "+v"(tid));
    int bid = blockIdx.x; asm volatile("" : "+s"(bid));
    unsigned char* ws = a.ws;
    float* mod = (float*)(ws + WS_MOD);
    bf16_t* XN = (bf16_t*)(ws + WS_XN); bf16_t* ACT = (bf16_t*)(ws + WS_ACT); float* H = (float*)(ws + WS_H);
    if (ph == 0) {

#ifndef NO_P0
      for (int rep = 0; rep < REP_P0; ++rep) {
      p0_convert(a, lds, tid);
      p0_modulation(a, lds, tid);
      p0_filters(a, lds, tid);
      }
#endif

    } else if (ph == NPHASE - 1) {
      final_norm_phase(H, a.out, a.in[30], tid);
    } else {
      const int l = (ph - 1) / 13, s = (ph - 1) % 13;
      const float* mod_l = mod + (size_t)l * 3 * 9216;
      if (s == 0 || s == 3 || s == 10) {
        const int j = s == 0 ? 0 : (s == 3 ? 1 : 2);
        const bool first = (l == 0 && s == 0);
        for (int rep = 0; rep < REP_N; ++rep) norm_mod_phase(first ? a.in[0] : H, first ? a.in[1] : H + (size_t)MCTX * DM, XN, a.in[11] + (l * 3 + j) * 1024, mod_l, j, tid);
      } else if (s == 1 || s == 11) {
        const int f = s == 1 ? 0 : 1;
        pg8::Gemm g; g.A = XN; g.Bt = (const bf16_t*)(ws + WS_WFI) + (size_t)(l * 2 + f) * 5632 * 1024; g.M = MT; g.N = 5632; g.K = 1024;
        pg8::StaticOrder S; S.init(MT, 5632, gridDim.x, bid);
        EpiSwiglu E; E.act = ACT;

#ifndef NO_G1
for (int rep = 0; rep < REP_G1; ++rep) pg8::gemm_phase<EpiSwiglu, pg8::StaticOrder, true, true>((PG8_LAS unsigned char*)lds, g, S, E);
#endif

      } else if (s == 2 || s == 9 || s == 12) {
        pg8::Gemm g; g.M = MT; g.N = 1024;
        EpiRes E; E.h = H; E.resA = H; E.resB = H;
        if (s == 9) { g.A = XN; g.Bt = (const bf16_t*)(ws + WS_WOUT) + (size_t)l * 1024 * 1024; g.K = 1024; E.gate = mod_l + 5 * 1024; E.coef = 1.f; }
        else { const int f = s == 2 ? 0 : 1; g.A = ACT; g.Bt = (const bf16_t*)(ws + WS_WFO) + (size_t)(l * 2 + f) * 1024 * 2816; g.K = 2816; E.gate = mod_l + (f == 0 ? 2 : 8) * 1024; E.coef = 0.5f;
          if (l == 0 && s == 2) { E.resA = a.in[0]; E.resB = a.in[1] - (size_t)MCTX * DM; } }
        pg8::StaticOrder S; S.init(MT, 1024, gridDim.x, bid);

#ifndef NO_G2
for (int rep = 0; rep < REP_G2; ++rep) { E.h = rep + 1 < REP_G2 ? (float*)(ws + WS_O) : H; pg8::gemm_phase<EpiRes, pg8::StaticOrder, true, true>((PG8_LAS unsigned char*)lds, g, S, E); }
#endif

      } else if (s == 4) {
        pg8::Gemm g; g.A = XN; g.Bt = (const bf16_t*)(ws + WS_WIN) + (size_t)l * NINP * 1024; g.M = MT; g.N = NINP; g.K = 1024;
        pg8::StaticOrder S; S.init(MT, NINP, gridDim.x, bid);
        EpiInproj E; E.U = ACT; E.HYT = (bf16_t*)(ws + WS_HYT); E.out = a.out; E.l = l;

#ifndef NO_G3
for (int rep = 0; rep < REP_G3; ++rep) pg8::gemm_phase<EpiInproj, pg8::StaticOrder, true, true>((PG8_LAS unsigned char*)lds, g, S, E);
#endif

      } else if (s == 5) {
        post_proj_phase(ACT, a.out, a.in[18] + l * 128, l, tid);
      } else if (s == 6) {
        for (int rep = 0; rep < REP_M1; ++rep) {
        unsigned* ctr = (unsigned*)(ws + WS_CTL) + 64 * (l * 2 + 0) + 16 * rep;
        for (;;) {
          const int q = q_next(ctr, lds, tid);
          if (q >= 1472) break;
          if (q < 64) { ATTN(a, l, q, lds, tid); }
          else if (q < 704) { const int j = q - 64; GLAA(a, l, j < 128 ? 512 + j : j - 128, lds, tid); }
          else if (q < 1216) { const int j = q - 704; HYEN(a, l, 0, j & 255, j < 256 ? 1 : 0, lds, tid); }
          else { ATTN(a, l, 64 + (q - 1216), lds, tid); }
        }
        }
      } else if (s == 7) {
        for (int rep = 0; rep < REP_M2; ++rep) {
        unsigned* ctr = (unsigned*)(ws + WS_CTL) + 64 * (l * 2 + 1) + 16 * rep;
        for (;;) {
          const int q = q_next(ctr, lds, tid);
          if (q >= 1152) break;
          if (q < 640) { GLAB(a, l, q < 128 ? 512 + q : q - 128, lds, tid); }
          else { const int j = q - 640; HYEN(a, l, 1, j & 255, j < 256 ? 1 : 0, lds, tid); }
        }
        }
      } else if (s == 8) {

#ifndef NO_MERGE
for (int rep = 0; rep < REP_MG; ++rep) merge_phase(a, l, lds, tid);
#endif

      }
    }
    if (ph + 1 < ph_hi) { for (int rep = 0; rep < REP_SYNC; ++rep) { if (ph == 0) grid.sync(); else xcd_barrier(xbar); } }
  }
}

extern "C" void kernel_launch(void* const* d_in, const int* in_sizes, int n_in, void* d_out, int out_size, void* d_ws, size_t ws_size, hipStream_t stream) {
  static int grid = 0;
  if (grid == 0) {
    if (n_in != 31 || ws_size < WS_END) { fprintf(stderr, "kernel_launch: need 31 inputs and >= %zu bytes of workspace; got %d, %zu\n", (size_t)WS_END, n_in, ws_size); grid = -1; return; }
    int dev = 0, cus = 0, per_cu = 0;
    (void)hipGetDevice(&dev);
    (void)hipDeviceGetAttribute(&cus, hipDeviceAttributeMultiprocessorCount, dev);
    if (hipFuncSetAttribute((const void*)fwd_kernel, hipFuncAttributeMaxDynamicSharedMemorySize, LDS_BYTES) != hipSuccess) { fprintf(stderr, "kernel_launch: hipFuncSetAttribute failed\n"); grid = -1; return; }
    if (hipOccupancyMaxActiveBlocksPerMultiprocessor(&per_cu, (const void*)fwd_kernel, 512, LDS_BYTES) != hipSuccess || per_cu < 1) { fprintf(stderr, "kernel_launch: occupancy query says %d\n", per_cu); per_cu = 1; }
    (void)hipGetLastError();
    grid = cus * 1;
    if (grid <= 0) grid = 256;
  }
  if (grid < 0) return;
  (void)hipMemsetAsync((char*)d_ws + WS_CTL, 0, 32768, stream);
  Args a{};
  for (int i = 0; i < 31; ++i) a.in[i] = (const float*)d_in[i];
  a.out = (float*)d_out; a.ws = (unsigned char*)d_ws;
#if N_LAUNCH_PER_PHASE
  for (int ph = 0; ph < NPHASE; ++ph) { a.ph_lo = ph; a.ph_hi = ph + 1; hipLaunchKernelGGL(fwd_kernel, dim3(grid), dim3(512), LDS_BYTES, stream, a); }
#else
  a.ph_lo = 0; a.ph_hi = NPHASE;
  void* args[] = {&a};
  hipError_t e = hipLaunchCooperativeKernel((const void*)fwd_kernel, dim3(grid), dim3(512), args, LDS_BYTES, stream);
  if (e != hipSuccess) fprintf(stderr, "kernel_launch: cooperative launch failed: %s (grid %d)\n", hipGetErrorString(e), grid);
#endif
}
```

```cpp
#include <hip/hip_runtime.h>
#include <hip/hip_cooperative_groups.h>
#include <cstdio>
#include <cstdint>
namespace cg = cooperative_groups;

#define DI __device__ __forceinline__
#define LAS __attribute__((address_space(3)))
typedef unsigned short bf16_t;
typedef short bf16x8 __attribute__((ext_vector_type(8)));
typedef float f32x4 __attribute__((ext_vector_type(4)));
typedef float f32x16 __attribute__((ext_vector_type(16)));
typedef unsigned u32x4 __attribute__((ext_vector_type(4)));
typedef unsigned u32x2 __attribute__((ext_vector_type(2)));
typedef __bf16 bf16x2_t __attribute__((ext_vector_type(2)));
typedef float f32x2_t __attribute__((ext_vector_type(2)));

DI unsigned cvtpk(float lo, float hi) { f32x2_t v = {lo, hi}; bf16x2_t b = __builtin_convertvector(v, bf16x2_t); return __builtin_bit_cast(unsigned, b); }
DI float bf2f(bf16_t x) { return __uint_as_float(((unsigned)x) << 16); }
DI bf16_t f2bf(float x) { return (bf16_t)(cvtpk(x, 0.f) & 0xffffu); }
DI float bflo(unsigned w) { return __uint_as_float(w << 16); }
DI float bfhi(unsigned w) { return __uint_as_float(w & 0xffff0000u); }
DI float wave_sum(float v) {
#pragma unroll
  for (int o = 32; o >= 1; o >>= 1) v += __shfl_xor(v, o, 64);
  return v;
}
DI float siluf(float a) { return a * __builtin_amdgcn_rcpf(1.f + __expf(-a)); }
DI int crow(int r, int hi) { return (r & 3) + 8 * (r >> 2) + 4 * hi; }

constexpr int MT = 10240, MCTX = 8192, DM = 1024, DFF = 2816, NINP = 2816, NIN = 2592, UW = 1824;
constexpr int U_QA = 0, U_KA = 256, U_VA = 384, U_QC = 512, U_KC = 768, U_VC = 896, U_QD = 1024, U_KD = 1152, U_VD = 1280, U_GD = 1536, U_RD = 1568;
constexpr float EPSF = 1e-6f;
constexpr float QSCALE = 0.125f * 1.4426950408889634f;
constexpr size_t OUT_SWAK = 10485760, OUT_SWAV = 12582912, OUT_GQAK = 14680064, OUT_GQAV = 16777216, OUT_STATE = 18874368;
constexpr size_t WS_CTL = 0;
constexpr size_t WS_BAR = 4096;
constexpr size_t WS_WFI = 32768;
constexpr size_t WS_WFO = WS_WFI + (size_t)4 * 5632 * 1024 * 2;
constexpr size_t WS_WIN = WS_WFO + (size_t)4 * 1024 * 2816 * 2;
constexpr size_t WS_WOUT = WS_WIN + (size_t)2 * 2816 * 1024 * 2;
constexpr size_t WS_MOD = WS_WOUT + (size_t)2 * 1024 * 1024 * 2;
constexpr size_t WS_FILT = WS_MOD + (size_t)2 * 3 * 9216 * 4;
constexpr size_t WS_XN = WS_FILT + (size_t)2 * 2 * 256 * 2560 * 2;
constexpr size_t WS_ACT = WS_XN + (size_t)MT * 1024 * 2;
constexpr size_t WS_H = WS_ACT + (size_t)MT * 2816 * 2;
constexpr size_t WS_O = WS_H + (size_t)MT * 1024 * 4;
constexpr size_t WS_OBT = WS_O + (size_t)MT * 768 * 2;
constexpr size_t WS_HYT = WS_OBT + (size_t)256 * MT * 2;
constexpr size_t WS_Y1T = WS_HYT + (size_t)768 * MT * 2;
constexpr size_t WS_OD = WS_Y1T + (size_t)256 * MT * 2;
constexpr size_t WS_GLC = WS_OD + (size_t)MT * 256 * 4;
constexpr size_t WS_GLD = WS_GLC + (size_t)160 * 4 * 2 * 2048 * 4;
constexpr size_t WS_MODP = WS_GLD + (size_t)160 * 4 * 2 * 32 * 4;
constexpr size_t WS_END = WS_MODP + (size_t)4 * 55296 * 4;
constexpr int LDS_BYTES = 147456;
constexpr int LDS_CTL_OFF = LDS_BYTES - 64;

struct Args { const float* in[31]; float* out; unsigned char* ws; int ph_lo, ph_hi; };
typedef const __attribute__((address_space(4))) Args CArgs;


DI int BID() { int b = blockIdx.x; asm volatile("" : "+s"(b)); return b; }
namespace pg8 {
#define PG8_LAS __attribute__((address_space(3)))
typedef unsigned short bf16_t;
typedef short bf16x8 __attribute__((ext_vector_type(8)));
typedef float f32x4 __attribute__((ext_vector_type(4)));
typedef unsigned u32x4 __attribute__((ext_vector_type(4)));
constexpr int BM = 256, BK = 64, HALF = 128, HTB = HALF * BK * 2  , STAGE_BYTES = 8 * HTB, NXCD = 8, WGM = 8;

__host__ __device__ __forceinline__ int lds_byte(int r, int c) { const int st = (r >> 4) * 2 + (c >> 5), rr = r & 15, cc = c & 31, ob = rr * 64 + cc * 2; return st * 1024 + (ob ^ (((ob >> 9) & 1) << 5)); }
__host__ __device__ __forceinline__ void stage_rc(int b, int& R, int& C) { const int st = b / 1024, sb = b % 1024, swz = sb ^ (((sb >> 9) & 1) << 5); R = (st >> 1) * 16 + swz / 64; C = (st & 1) * 32 + (swz % 64) / 2; }
__host__ __device__ __forceinline__ int perm32(int rho) { const int n = rho >> 4, i = rho & 15; return 8 * (i >> 2) + 4 * n + (i & 3); }

struct Unit { int pm, pn; };
struct Gemm { const bf16_t* A; const bf16_t* Bt; int M, N, K; };

struct StaticOrder {
    int nM, nN, nwg, G, c;
    __host__ __device__ void init(int M, int N, int G_, int c_) { nM = M / BM; nN = N / BM; nwg = nM * nN; G = G_; c = c_; }
    __host__ __device__ bool next(int i, Unit& u) const {
        const long L = (long)i * G + c; if (L >= nwg) return false;
        int wgid = (int)L; { const int q = nwg / NXCD, r = nwg % NXCD, xcd = wgid % NXCD, off = wgid / NXCD; wgid = (xcd < r ? xcd * (q + 1) : r * (q + 1) + (xcd - r) * q) + off; }
        const int nig = WGM * nN, gid = wgid / nig, fm = gid * WGM, gsz = (nM - fm) < WGM ? (nM - fm) : WGM;
        u.pm = fm + ((wgid % nig) % gsz); u.pn = (wgid % nig) / gsz; return true;
    }
    __device__ __forceinline__ void a_ready(const Unit&) const {}
    __device__ __forceinline__ void done(const Unit&) const {}
};
template <class Epi, class Sched, bool ALIGN_EPI = false, bool SP2 = false>
__device__ __forceinline__ void gemm_phase(PG8_LAS unsigned char* lds, const Gemm g, const Sched& S, const Epi& E) {
    int tid_l = threadIdx.x; asm volatile("" : "+v"(tid_l));
    const int tid = tid_l, wid = __builtin_amdgcn_readfirstlane(tid >> 6), lane = tid & 63, wr = wid >> 2, wc = wid & 3, fr = lane & 15, fq = lane >> 4;
    const int K = g.K, nt = K / BK;
    unsigned voffA[2], voffB[2];
#pragma unroll
    for (int i = 0; i < 2; ++i) { int R, C; stage_rc(tid * 16 + i * 8192, R, C); const int Rb = Epi::PERM ? ((R & ~31) + perm32(R & 31)) : R;
        voffA[i] = (unsigned)(R * K + C) * 2u; voffB[i] = (unsigned)(Rb * K + C) * 2u; }
    const size_t kstep = (size_t)(BK * 2);
    const size_t hstep = (size_t)HALF * K * 2;
    const size_t tstep = 2 * hstep;
    const unsigned ldsw = (unsigned)wid * 1024u;
    const int aoff = lds_byte(wr * 64 + fr, fq * 8), boff = lds_byte(wc * 32 + fr, fq * 8);
#define PG8_SA(b, h) (((b) * 2 + (h)) * HTB)
#define PG8_SB(b, h) ((4 + (b) * 2 + (h)) * HTB)
#define PG8_STAGE(bufoff, gbase, voff) do { _Pragma("unroll") for (int _i = 0; _i < 2; ++_i) \
        __builtin_amdgcn_global_load_lds((const unsigned*)((const char*)(gbase) + (voff)[_i]), (PG8_LAS unsigned*)(lds + (bufoff) + ldsw + _i * 8192), 16, 0, 0); } while (0)
#define PG8_LDA(dst, b, h) do { _Pragma("unroll") for (int m = 0; m < 4; ++m) _Pragma("unroll") for (int k = 0; k < 2; ++k) dst[m][k] = *(const PG8_LAS bf16x8*)(lds + PG8_SA(b, h) + aoff + m * 2048 + k * 1024); } while (0)
#define PG8_LDB(dst, b, h) do { _Pragma("unroll") for (int n = 0; n < 2; ++n) _Pragma("unroll") for (int k = 0; k < 2; ++k) dst[n][k] = *(const PG8_LAS bf16x8*)(lds + PG8_SB(b, h) + boff + n * 2048 + k * 1024); } while (0)
#define PG8_MMA(ai, bj, At, Bt) do { __builtin_amdgcn_s_setprio(1); _Pragma("unroll") for (int m = 0; m < 4; ++m) _Pragma("unroll") for (int n = 0; n < 2; ++n) _Pragma("unroll") for (int k = 0; k < 2; ++k) \
        acc[ai][bj][m][n] = __builtin_amdgcn_mfma_f32_16x16x32_bf16(Bt[n][k], At[m][k], acc[ai][bj][m][n], 0, 0, 0); __builtin_amdgcn_s_setprio(0); } while (0)
#define PG8_WAIT_V(n) asm volatile("s_waitcnt vmcnt(" #n ")" ::: "memory")
#define PG8_WAIT_L(n) asm volatile("s_waitcnt lgkmcnt(" #n ")" ::: "memory")
#define PG8_BAR __builtin_amdgcn_s_barrier()
#define PG8_SCHED __builtin_amdgcn_sched_barrier(0)
    Unit cur, nxt; int ui = 0;
    if (!S.next(0, cur)) return;
    f32x4 acc[2][2][4][2];
#pragma unroll
    for (int a = 0; a < 2; ++a)
#pragma unroll
        for (int b = 0; b < 2; ++b)
#pragma unroll
            for (int m = 0; m < 4; ++m)
#pragma unroll
                for (int n = 0; n < 2; ++n) acc[a][b][m][n] = (f32x4){0.f, 0.f, 0.f, 0.f};
    bf16x8 At[4][2], B0[2][2], B1[2][2];
    const char* cA = (const char*)g.A + (size_t)cur.pm * tstep; const char* cB = (const char*)g.Bt + (size_t)cur.pn * tstep;
    S.a_ready(cur);
    if constexpr (SP2) {
        PG8_STAGE(PG8_SB(0, 0), cB, voffB); PG8_STAGE(PG8_SB(0, 1), cB + hstep, voffB); PG8_STAGE(PG8_SA(0, 0), cA, voffA); PG8_STAGE(PG8_SA(0, 1), cA + hstep, voffA);
        if (wr == 1) PG8_BAR;
        PG8_WAIT_V(2); PG8_BAR;
        PG8_STAGE(PG8_SB(1, 0), cB + kstep, voffB); PG8_STAGE(PG8_SA(1, 0), cA + kstep, voffA); PG8_STAGE(PG8_SB(1, 1), cB + hstep + kstep, voffB);
        PG8_WAIT_V(6); PG8_BAR;
    } else {
        PG8_STAGE(PG8_SB(0, 0), cB, voffB); PG8_STAGE(PG8_SA(0, 0), cA, voffA); PG8_STAGE(PG8_SB(0, 1), cB + hstep, voffB); PG8_STAGE(PG8_SA(0, 1), cA + hstep, voffA);
        if (wr == 1) PG8_BAR;
        PG8_WAIT_V(4); PG8_BAR;
        PG8_STAGE(PG8_SB(1, 0), cB + kstep, voffB); PG8_STAGE(PG8_SA(1, 0), cA + kstep, voffA); PG8_STAGE(PG8_SB(1, 1), cB + hstep + kstep, voffB);
        PG8_WAIT_V(6); PG8_BAR;
    }
    for (;;) {
        const bool has_next = S.next(ui + 1, nxt);
        const char* nA = has_next ? (const char*)g.A + (size_t)nxt.pm * tstep : cA; const char* nB = has_next ? (const char*)g.Bt + (size_t)nxt.pn * tstep : cB;
        for (int t = 0; t < nt; t += 2) {
            const bool last = (t == nt - 2);
            const char* a1 = cA + (size_t)(t + 1) * kstep;
            const char* a2 = last ? nA : cA + (size_t)(t + 2) * kstep; const char* b2 = last ? nB : cB + (size_t)(t + 2) * kstep;
            const char* a3 = a2 + kstep; const char* b3 = b2 + kstep;
            if (last && has_next) S.a_ready(nxt);
            if constexpr (SP2) {
            PG8_LDB(B0, 0, 0); PG8_LDB(B1, 0, 1); PG8_SCHED; PG8_LDA(At, 0, 0); PG8_STAGE(PG8_SA(1, 1), a1 + hstep, voffA);
            PG8_WAIT_V(8); PG8_WAIT_L(0); PG8_BAR; PG8_MMA(0, 0, At, B0); PG8_MMA(0, 1, At, B1); PG8_BAR; PG8_SCHED;
            PG8_LDA(At, 0, 1); PG8_STAGE(PG8_SB(0, 0), b2, voffB); PG8_STAGE(PG8_SB(0, 1), b2 + hstep, voffB); PG8_STAGE(PG8_SA(0, 0), a2, voffA);
            PG8_WAIT_V(8); PG8_WAIT_L(0); PG8_BAR; PG8_MMA(1, 0, At, B0); PG8_MMA(1, 1, At, B1); PG8_BAR; PG8_SCHED;
            PG8_LDB(B0, 1, 0); PG8_LDB(B1, 1, 1); PG8_SCHED; PG8_LDA(At, 1, 0); PG8_STAGE(PG8_SA(0, 1), a2 + hstep, voffA);
            PG8_WAIT_V(8); PG8_WAIT_L(0); PG8_BAR; PG8_MMA(0, 0, At, B0); PG8_MMA(0, 1, At, B1); PG8_BAR; PG8_SCHED;
            PG8_LDA(At, 1, 1); PG8_STAGE(PG8_SB(1, 0), b3, voffB); PG8_STAGE(PG8_SB(1, 1), b3 + hstep, voffB); PG8_STAGE(PG8_SA(1, 0), a3, voffA);
            PG8_WAIT_V(8); PG8_WAIT_L(0); PG8_BAR; PG8_MMA(1, 0, At, B0); PG8_MMA(1, 1, At, B1); PG8_BAR; PG8_SCHED;
            } else {
            PG8_LDB(B0, 0, 0); PG8_SCHED; PG8_LDA(At, 0, 0); PG8_STAGE(PG8_SA(1, 1), a1 + hstep, voffA);
            PG8_WAIT_L(8); PG8_BAR; PG8_WAIT_L(0); PG8_MMA(0, 0, At, B0); PG8_BAR; PG8_SCHED;
            PG8_LDB(B1, 0, 1); PG8_STAGE(PG8_SB(0, 0), b2, voffB);
            PG8_BAR; PG8_WAIT_L(0); PG8_MMA(0, 1, At, B1); PG8_BAR;
            PG8_LDA(At, 0, 1); PG8_STAGE(PG8_SA(0, 0), a2, voffA);
            PG8_BAR; PG8_WAIT_L(0); PG8_MMA(1, 0, At, B0); PG8_BAR; PG8_SCHED;
            PG8_STAGE(PG8_SB(0, 1), b2 + hstep, voffB);
            PG8_WAIT_V(6); PG8_BAR; PG8_MMA(1, 1, At, B1); PG8_BAR;
            PG8_LDB(B0, 1, 0); PG8_SCHED; PG8_LDA(At, 1, 0); PG8_STAGE(PG8_SA(0, 1), a2 + hstep, voffA);
            PG8_WAIT_L(8); PG8_BAR; PG8_WAIT_L(0); PG8_MMA(0, 0, At, B0); PG8_BAR; PG8_SCHED;
            PG8_LDB(B1, 1, 1); PG8_STAGE(PG8_SB(1, 0), b3, voffB);
            PG8_BAR; PG8_WAIT_L(0); PG8_MMA(0, 1, At, B1); PG8_BAR;
            PG8_LDA(At, 1, 1); PG8_STAGE(PG8_SA(1, 0), a3, voffA);
            PG8_BAR; PG8_WAIT_L(0); PG8_MMA(1, 0, At, B0); PG8_BAR; PG8_SCHED;
            PG8_STAGE(PG8_SB(1, 1), b3 + hstep, voffB);
            PG8_WAIT_V(6); PG8_BAR; PG8_MMA(1, 1, At, B1); PG8_BAR;
            }
        }
        if constexpr (ALIGN_EPI) { if (wr == 0) PG8_BAR; }
        if constexpr (!Epi::AFTER_DRAIN) { E(acc, cur, wr, wc, fr, fq); S.done(cur); }
        if (!has_next) break;
#pragma unroll
        for (int a = 0; a < 2; ++a)
#pragma unroll
            for (int b = 0; b < 2; ++b)
#pragma unroll
                for (int m = 0; m < 4; ++m)
#pragma unroll
                    for (int n = 0; n < 2; ++n) acc[a][b][m][n] = (f32x4){0.f, 0.f, 0.f, 0.f};
        cur = nxt; cA = nA; cB = nB; ++ui;
        if constexpr (ALIGN_EPI) { if (wr == 1) PG8_BAR; }
    }
    PG8_WAIT_V(0);
    if constexpr (!ALIGN_EPI) { if (wr == 0) PG8_BAR; }
    PG8_BAR;
    if constexpr (Epi::AFTER_DRAIN) { E.fused(acc, cur, wr, wc, fr, fq, lds, wid, lane); S.done(cur); }
#undef PG8_SA
#undef PG8_SB
#undef PG8_STAGE
#undef PG8_LDA
#undef PG8_LDB
#undef PG8_MMA
#undef PG8_WAIT_V
#undef PG8_WAIT_L
#undef PG8_BAR
#undef PG8_SCHED
}
}
#define XB_TMO      128
#define XB_XCNT(j)  (256  + 64 * (j))
#define XB_XSUB(j)  (1280 + 64 * (j))
#define XB_XGEN(j)  (2304 + 64 * (j))
#define XB_TOP      3328
#define XB_TOPGEN   3392
#define XCD_BAR_WORDS 3456
#define XB_SPIN_CAP (1u << 18)

__device__ __forceinline__ unsigned xb_ld(unsigned* p)              { return __hip_atomic_load(p, __ATOMIC_RELAXED, __HIP_MEMORY_SCOPE_AGENT); }
__device__ __forceinline__ unsigned xb_add(unsigned* p, unsigned v) { return __hip_atomic_fetch_add(p, v, __ATOMIC_RELAXED, __HIP_MEMORY_SCOPE_AGENT); }
__device__ __forceinline__ unsigned xb_xcc_id() { return (unsigned)__builtin_amdgcn_s_getreg((3 << 11) | 20) & 0xFu; }
#define XB_SPIN(cond, bar) do { unsigned _sp = 0; while (cond) { __builtin_amdgcn_s_sleep(1); \
    if ((++_sp & 255u) == 0u) { if (xb_ld(&(bar)[XB_TMO])) break; if (_sp > XB_SPIN_CAP) { atomicAdd(&(bar)[XB_TMO], 1u); break; } } } } while (0)

struct XcdBarrier {
    unsigned* bar; unsigned x;
    volatile LAS unsigned* st;
};

__device__ __forceinline__ XcdBarrier xcd_barrier_post(unsigned* bar, volatile LAS unsigned* st) {
    XcdBarrier b; b.bar = bar; b.x = xb_xcc_id(); b.st = st;
    if (threadIdx.x == 0) (void)xb_add(&bar[XB_XCNT(b.x)], 1u);
    return b;
}
__device__ __forceinline__ void xcd_barrier_complete(unsigned* bar, unsigned x, unsigned& nloc, unsigned& nx) {
    const unsigned G = gridDim.x * gridDim.y * gridDim.z;
    unsigned sum, cnt, mine, sp = 0u;
    for (;;) {
        sum = 0u; cnt = 0u; mine = 0u;
#pragma unroll
        for (unsigned j = 0; j < 16; ++j) { const unsigned c = xb_ld(&bar[XB_XCNT(j)]); sum += c; cnt += (c > 0u) ? 1u : 0u; mine = (j == x) ? c : mine; }
        if (sum == G) break;
        __builtin_amdgcn_s_sleep(1);
        if ((++sp & 255u) == 0u) { if (xb_ld(&bar[XB_TMO])) break; if (sp > XB_SPIN_CAP) { atomicAdd(&bar[XB_TMO], 1u); break; } }
    }
    nloc = mine > 0u ? mine : 1u; nx = cnt > 0u ? cnt : 1u;
}

__device__ __forceinline__ void xcd_barrier(const XcdBarrier& b) {
    asm volatile("s_waitcnt vmcnt(0)" ::: "memory");
    __syncthreads();
    if (threadIdx.x == 0) {
        unsigned* bar = b.bar;
        __builtin_amdgcn_s_waitcnt(0);
        unsigned nloc = b.st[0], nx = b.st[1];
        if (nloc == 0u) { xcd_barrier_complete(bar, b.x, nloc, nx); b.st[0] = nloc; b.st[1] = nx; }
        const unsigned old = xb_add(&bar[XB_XSUB(b.x)], 1u);
        const unsigned gen = old / nloc;
        if (old + 1u == (gen + 1u) * nloc) {
            __builtin_amdgcn_fence(__ATOMIC_RELEASE, "agent");
            asm volatile("s_waitcnt vmcnt(0)" ::: "memory");
            const unsigned og = xb_add(&bar[XB_TOP], 1u);
            const unsigned tg = og / nx;
            if (og + 1u == (tg + 1u) * nx) xb_add(&bar[XB_TOPGEN], 1u);
            else XB_SPIN(xb_ld(&bar[XB_TOPGEN]) == tg, bar);
            __builtin_amdgcn_fence(__ATOMIC_ACQUIRE, "agent");
            xb_add(&bar[XB_XGEN(b.x)], 1u);
            asm volatile("s_waitcnt vmcnt(0)" ::: "memory");
        } else {
            XB_SPIN(xb_ld(&bar[XB_XGEN(b.x)]) == gen, bar);
            __builtin_amdgcn_fence(__ATOMIC_ACQUIRE, "agent");
            asm volatile("s_waitcnt vmcnt(0)" ::: "memory");
        }
    }
    __syncthreads();
}

struct EpiSwiglu {
  static constexpr bool PERM = true, AFTER_DRAIN = false;
  bf16_t* act;
  DI void operator()(const f32x4 (&acc)[2][2][4][2], const pg8::Unit& u, int wr, int wc, int fr, int fq) const {
    const int row0 = u.pm * 256 + wr * 64 + fr, col0 = u.pn * 128 + wc * 32 + 8 * fq;
#pragma unroll
    for (int ai = 0; ai < 2; ++ai)
#pragma unroll
      for (int m = 0; m < 4; ++m) {
        bf16_t* rowp = act + (size_t)(row0 + ai * 128 + m * 16) * DFF + col0;
        const f32x4 a0 = acc[ai][0][m][0], a1 = acc[ai][0][m][1], b0 = acc[ai][1][m][0], b1 = acc[ai][1][m][1];
        u32x4 w;
        w.x = cvtpk(siluf(a0[0]) * b0[0], siluf(a0[1]) * b0[1]); w.y = cvtpk(siluf(a0[2]) * b0[2], siluf(a0[3]) * b0[3]);
        w.z = cvtpk(siluf(a1[0]) * b1[0], siluf(a1[1]) * b1[1]); w.w = cvtpk(siluf(a1[2]) * b1[2], siluf(a1[3]) * b1[3]);
        *(u32x4*)rowp = w;
      }
  }
};

struct EpiRes {
  static constexpr bool PERM = true, AFTER_DRAIN = false;
  float* h; const float* resA; const float* resB; const float* gate; float coef;
  DI void operator()(const f32x4 (&acc)[2][2][4][2], const pg8::Unit& u, int wr, int wc, int fr, int fq) const {
    const int g = u.pm < 32 ? 0 : (u.pm < 36 ? 1 : 2);
    const float* res = u.pm < 32 ? resA : resB;
    const int row0 = u.pm * 256 + wr * 64 + fr, col0 = u.pn * 256 + wc * 32 + 8 * fq;
    f32x4 gv[2][2];
#pragma unroll
    for (int bj = 0; bj < 2; ++bj)
#pragma unroll
      for (int n = 0; n < 2; ++n) gv[bj][n] = *(const f32x4*)(gate + (size_t)g * 9216 + col0 + bj * 128 + 4 * n) * coef;
#pragma unroll
    for (int ai = 0; ai < 2; ++ai)
#pragma unroll
      for (int m = 0; m < 4; ++m)
#pragma unroll
        for (int bj = 0; bj < 2; ++bj)
#pragma unroll
          for (int n = 0; n < 2; ++n) {
            const size_t idx = (size_t)(row0 + ai * 128 + m * 16) * DM + col0 + bj * 128 + 4 * n;
            const f32x4 r = *(const f32x4*)(res + idx);
            *(f32x4*)(h + idx) = r + gv[bj][n] * acc[ai][bj][m][n];
          }
  }
};

struct EpiInproj {
  static constexpr bool PERM = true, AFTER_DRAIN = false;
  bf16_t* U; bf16_t* HYT; float* out; int l;
  DI void operator()(const f32x4 (&acc)[2][2][4][2], const pg8::Unit& u, int wr, int wc, int fr, int fq) const {
    const int row0 = u.pm * 256 + wr * 64 + fr, cw = wc * 32 + 8 * fq;
    const int pn = u.pn;
    if (pn >= 2 && pn <= 4) {
#pragma unroll
      for (int ai = 0; ai < 2; ++ai)
#pragma unroll
        for (int m = 0; m < 4; ++m)
#pragma unroll
          for (int bj = 0; bj < 2; ++bj)
#pragma unroll
            for (int n = 0; n < 2; ++n)
#pragma unroll
              for (int e = 0; e < 4; ++e) {
                const int c = pn * 256 - 512 + bj * 128 + cw + 4 * n + e, row = row0 + ai * 128 + m * 16;
                HYT[(size_t)c * MT + row] = f2bf(acc[ai][bj][m][n][e]);
              }
    } else {
      const int ub = (pn < 2 ? pn * 256 : pn * 256 - 768) + cw;
#pragma unroll
      for (int ai = 0; ai < 2; ++ai)
#pragma unroll
        for (int m = 0; m < 4; ++m)
#pragma unroll
          for (int bj = 0; bj < 2; ++bj) {
            const int row = row0 + ai * 128 + m * 16;
            const bool ok = (pn < 10) || (bj == 0 && wc == 0);
            if (ok) {
              const f32x4 v0 = acc[ai][bj][m][0], v1 = acc[ai][bj][m][1];
              u32x4 w; w.x = cvtpk(v0[0], v0[1]); w.y = cvtpk(v0[2], v0[3]); w.z = cvtpk(v1[0], v1[1]); w.w = cvtpk(v1[2], v1[3]);
              *(u32x4*)(U + (size_t)row * UW + ub + bj * 128) = w;
              if (u.pm < 32 && (pn == 1 || (pn == 6 && bj == 1))) {
                const int b = row >> 8, t = row & 255;
                const size_t off = (pn == 1 ? (bj == 0 ? OUT_SWAK : OUT_SWAV) : OUT_GQAV) + ((size_t)(b * 512 + l * 256 + t)) * 128 + cw;
                *(f32x4*)(out + off) = v0; *(f32x4*)(out + off + 4) = v1;
              }
            }
          }
    }
  }
};

DI void tr_item(const float* __restrict__ W, int Nsrc, int K, bf16_t* __restrict__ WT, int n0, int sca, int scb, int k0, float* tile, int tid) {
  const int c4 = tid & 63, col = ((c4 >> 5) ? scb : sca) + 4 * (c4 & 31);
  f32x4 v[8];
#pragma unroll
  for (int rr = 0; rr < 8; ++rr) {
    const int r = (tid >> 6) + 8 * rr;
    v[rr] = (f32x4){0.f, 0.f, 0.f, 0.f};
    if (col < Nsrc) v[rr] = __builtin_nontemporal_load((const f32x4*)(W + (size_t)(k0 + r) * Nsrc + col));
  }
#pragma unroll
  for (int rr = 0; rr < 8; ++rr) {
    const int r = (tid >> 6) + 8 * rr;
    float* tp = tile + r * 257 + 4 * c4; tp[0] = v[rr][0]; tp[1] = v[rr][1]; tp[2] = v[rr][2]; tp[3] = v[rr][3];
  }
  __syncthreads();
  const int n = tid >> 1, kh = tid & 1;
#pragma unroll
  for (int q = 0; q < 4; ++q) {
    const float* sp = tile + (32 * kh + 8 * q) * 257 + n;
    u32x4 w; w.x = cvtpk(sp[0], sp[257]); w.y = cvtpk(sp[514], sp[771]); w.z = cvtpk(sp[1028], sp[1285]); w.w = cvtpk(sp[1542], sp[1799]);
    *(u32x4*)(WT + (size_t)(n0 + n) * K + k0 + 32 * kh + 8 * q) = w;
  }
  __syncthreads();
}

DI void p0_convert(CArgs& a, unsigned char* ldsb, int tid) {
  float* tile = (float*)ldsb;
  bf16_t* WFI = (bf16_t*)(a.ws + WS_WFI); bf16_t* WFO = (bf16_t*)(a.ws + WS_WFO); bf16_t* WIN = (bf16_t*)(a.ws + WS_WIN); bf16_t* WOUT = (bf16_t*)(a.ws + WS_WOUT);
  for (int idx = BID(); idx < 2592; idx += gridDim.x) {
    if (idx < 1408) {
      const int mat = idx / 352, rem = idx % 352, pn = rem >> 4, kt = rem & 15;
      tr_item(a.in[12] + (size_t)mat * 1024 * 5632, 5632, 1024, WFI + (size_t)mat * 5632 * 1024, 256 * pn, 128 * pn, 2816 + 128 * pn, 64 * kt, tile, tid);
    } else if (idx < 2112) {
      const int q = idx - 1408, mat = q / 176, rem = q % 176, nt = rem / 44, kt = rem % 44;
      tr_item(a.in[13] + (size_t)mat * 2816 * 1024, 1024, 2816, WFO + (size_t)mat * 1024 * 2816, 256 * nt, 256 * nt, 256 * nt + 128, 64 * kt, tile, tid);
    } else if (idx < 2464) {
      const int q = idx - 2112, l = q / 176, rem = q % 176, nt = rem >> 4, kt = rem & 15;
      tr_item(a.in[14] + (size_t)l * 1024 * NIN, NIN, 1024, WIN + (size_t)l * NINP * 1024, 256 * nt, 256 * nt, 256 * nt + 128, 64 * kt, tile, tid);
    } else {
      const int q = idx - 2464, l = q >> 6, rem = q & 63, nt = rem >> 4, kt = rem & 15;
      tr_item(a.in[15] + (size_t)l * 1024 * 1024, 1024, 1024, WOUT + (size_t)l * 1024 * 1024, 256 * nt, 256 * nt, 256 * nt + 128, 64 * kt, tile, tid);
    }
  }
}

DI void p0_modulation(CArgs& a, unsigned char* ldsb, int tid) {
  float* sc = (float*)ldsb;
  float* red = sc + 3072;
  float* modp = (float*)(a.ws + WS_MODP);
  for (int i = tid; i < 3072; i += 512) { const int g = i >> 10, k = i & 1023; const float x = g == 0 ? a.in[8][k] : a.in[7][(g - 1) * 1024 + k]; sc[i] = x / (1.f + expf(-x)); }
  __syncthreads();
  for (int item = BID(); item < 288; item += gridDim.x) {
    const int l = item / 144, rem = item % 144, nt = rem >> 2, kq = rem & 3, n0 = nt * 256, c4 = tid & 63, kg = tid >> 6;
    const int kbase = kq * 256 + kg * 32;
    const float* wp = a.in[9] + (size_t)l * 1024 * 9216 + (size_t)kbase * 9216 + n0 + 4 * c4;
    f32x4 acc0 = {0, 0, 0, 0}, acc1 = {0, 0, 0, 0}, acc2 = {0, 0, 0, 0};
#pragma unroll 8
    for (int kk = 0; kk < 32; ++kk) {
      const f32x4 w = __builtin_nontemporal_load((const f32x4*)(wp + (size_t)kk * 9216));
      const int k = kbase + kk;
      acc0 += w * sc[k]; acc1 += w * sc[1024 + k]; acc2 += w * sc[2048 + k];
    }
    float* rp = red + kg * 768 + 4 * c4;
#pragma unroll
    for (int e = 0; e < 4; ++e) { rp[e] = acc0[e]; rp[256 + e] = acc1[e]; rp[512 + e] = acc2[e]; }
    __syncthreads();
    for (int o = tid; o < 768; o += 512) {
      const int g = o >> 8, n = o & 255; float s = 0.f;
#pragma unroll
      for (int q = 0; q < 8; ++q) s += red[q * 768 + o];
      modp[(size_t)kq * 55296 + (size_t)(l * 3 + g) * 9216 + n0 + n] = s;
    }
    __syncthreads();
  }
}
DI void mod_finalize(CArgs& a, int tid) {
  const float* modp = (const float*)(a.ws + WS_MODP); float* mod = (float*)(a.ws + WS_MOD);
  for (int idx = BID() * 512 + tid; idx < 55296; idx += gridDim.x * 512) {
    const int l = idx / 27648, n = idx % 9216;
    mod[idx] = modp[idx] + modp[55296 + idx] + modp[2 * 55296 + idx] + modp[3 * 55296 + idx] + a.in[10][l * 9216 + n];
  }
}

DI void p0_filters(CArgs& a, unsigned char* ldsb, int tid) {
  float* zs = (float*)ldsb;
  float* h1 = zs + 512;
  float* h2 = h1 + 512;
  bf16_t* F = (bf16_t*)(a.ws + WS_FILT);
  const int w = tid >> 6, lane = tid & 63;
  for (int item = BID(); item < 320; item += gridDim.x) {
    const int l = item / 160, r = item % 160;
    const int L = r < 32 ? 256 : 1024, t = (r < 32 ? 8 * r : 8 * (r - 32)) + w, Loff = r < 32 ? 0 : 512;
    const float tt = (float)t / (float)(L - 1);
    const float wt = (6.283185307179586f / (float)L) * (float)t;
    if (lane < 33) {
      float z;
      if (lane == 0) z = tt;
      else { const int bi = (lane - 1) & 15; const float band = 1e-4f + (float)bi * ((15.f - 1e-4f) / 15.f); z = lane <= 16 ? cosf(band * wt) : -sinf(band * wt); }
      zs[w * 64 + lane] = z;
    }
    __syncthreads();
    { float s = a.in[22][l * 64 + lane];
      for (int i = 0; i < 33; ++i) s += zs[w * 64 + i] * a.in[21][(l * 33 + i) * 64 + lane];
      h1[w * 64 + lane] = sinf(a.in[26][(l * 2 + 0) * 64 + lane] * s); }
    __syncthreads();
    { float s = a.in[24][l * 64 + lane];
      for (int i = 0; i < 64; ++i) s += h1[w * 64 + i] * a.in[23][(l * 64 + i) * 64 + lane];
      h2[w * 64 + lane] = sinf(a.in[26][(l * 2 + 1) * 64 + lane] * s); }
    __syncthreads();
    for (int qq = 0; qq < 16; ++qq) {
      const int col = lane + 64 * qq;
      float s = 0.f;
      for (int i = 0; i < 64; ++i) s += h2[w * 64 + i] * a.in[25][(size_t)(l * 64 + i) * 1024 + col];
      const int dir = col >> 9, o = (col >> 8) & 1, ch = col & 255;
      const float d0 = -4.605170185988091f / 1.5f, d1 = -4.605170185988091f / 0.3f;
      const float delta = d0 + (float)ch * ((d1 - d0) / 255.f);
      s *= expf(-tt * fabsf(delta));
      bf16_t* fp = F + ((size_t)((l * 2 + o) * 256 + ch)) * 2560 + Loff;
      if (dir == 0) fp[L - t] = f2bf(s);
      else { if (t == 0) fp[0] = 0; else fp[L + t] = f2bf(s); }
    }
    __syncthreads();
  }
}

DI const float* xrow(const float* A, const float* B, int row) { return row < MCTX ? A + (size_t)row * DM : B + (size_t)(row - MCTX) * DM; }
DI int grp_of(int row) { return row < MCTX ? 0 : 1 + ((row - MCTX) >> 10); }

constexpr int RB = 5;
DI void norm_mod_phase(const float* srcA, const float* srcB, bf16_t* xn, const float* ng, const float* mod_l, int j, int tid, const float* modp, const float* bmod) {
  const int w = tid >> 6, lane = tid & 63, stride = gridDim.x * 8;
  for (int base = BID() * 8 + w; base < MT; base += stride * RB) {
    f32x4 v[RB][4];
#pragma unroll
    for (int r = 0; r < RB; ++r) {
      const int row = base + r * stride;
      if (row < MT) { const float* x = xrow(srcA, srcB, row);
#pragma unroll
        for (int q = 0; q < 4; ++q) v[r][q] = *(const f32x4*)(x + 256 * q + 4 * lane); }
      else {
#pragma unroll
        for (int q = 0; q < 4; ++q) v[r][q] = (f32x4){0.f, 0.f, 0.f, 0.f}; }
    }
#pragma unroll
    for (int r = 0; r < RB; ++r) {
      const int row = base + r * stride;
      float ss = 0.f;
#pragma unroll
      for (int q = 0; q < 4; ++q) ss += v[r][q][0] * v[r][q][0] + v[r][q][1] * v[r][q][1] + v[r][q][2] * v[r][q][2] + v[r][q][3] * v[r][q][3];
      ss = wave_sum(ss);
      const float rstd = rsqrtf(ss * (1.f / 1024.f) + EPSF);
      if (row < MT) {
        const float* mg = mod_l + (size_t)grp_of(row) * 9216 + (3 * j) * 1024;
#pragma unroll
        for (int q = 0; q < 4; ++q) {
          const int k = 256 * q + 4 * lane;
          const f32x4 g = *(const f32x4*)(ng + k);
          f32x4 sh, sc;
          if (modp) {
            const size_t o = (size_t)grp_of(row) * 9216 + (3 * j) * 1024 + k;
            sh = *(const f32x4*)(modp + o) + *(const f32x4*)(modp + 55296 + o) + *(const f32x4*)(modp + 2 * 55296 + o) + *(const f32x4*)(modp + 3 * 55296 + o) + *(const f32x4*)(bmod + (3 * j) * 1024 + k);
            sc = *(const f32x4*)(modp + o + 1024) + *(const f32x4*)(modp + 55296 + o + 1024) + *(const f32x4*)(modp + 2 * 55296 + o + 1024) + *(const f32x4*)(modp + 3 * 55296 + o + 1024) + *(const f32x4*)(bmod + (3 * j) * 1024 + 1024 + k);
          } else { sh = *(const f32x4*)(mg + k); sc = *(const f32x4*)(mg + 1024 + k); }
          const f32x4 y = (v[r][q] * rstd * g) * (sc + 1.f) + sh;
          u32x2 o; o.x = cvtpk(y[0], y[1]); o.y = cvtpk(y[2], y[3]);
          *(u32x2*)(xn + (size_t)row * DM + k) = o;
        }
      }
    }
  }
}

DI void final_norm_phase(const float* h, float* out, const float* fg, int tid) {
  const int w = tid >> 6, lane = tid & 63, stride = gridDim.x * 8;
  for (int base = BID() * 8 + w; base < MT; base += stride * RB) {
    f32x4 v[RB][4];
#pragma unroll
    for (int r = 0; r < RB; ++r) {
      const int row = base + r * stride;
      if (row < MT) {
#pragma unroll
        for (int q = 0; q < 4; ++q) v[r][q] = *(const f32x4*)(h + (size_t)row * DM + 256 * q + 4 * lane); }
      else {
#pragma unroll
        for (int q = 0; q < 4; ++q) v[r][q] = (f32x4){0.f, 0.f, 0.f, 0.f}; }
    }
#pragma unroll
    for (int r = 0; r < RB; ++r) {
      const int row = base + r * stride;
      float ss = 0.f;
#pragma unroll
      for (int q = 0; q < 4; ++q) ss += v[r][q][0] * v[r][q][0] + v[r][q][1] * v[r][q][1] + v[r][q][2] * v[r][q][2] + v[r][q][3] * v[r][q][3];
      ss = wave_sum(ss);
      const float rstd = rsqrtf(ss * (1.f / 1024.f) + EPSF);
      if (row < MT) {
#pragma unroll
        for (int q = 0; q < 4; ++q) { const int k = 256 * q + 4 * lane; *(f32x4*)(out + (size_t)row * DM + k) = v[r][q] * rstd * *(const f32x4*)(fg + k); }
      }
    }
  }
}

DI int pp_base(int s) { return (s < 4) ? U_QA + 64 * s : (s < 6) ? U_KA + 64 * (s - 4) : (s < 10) ? U_QC + 64 * (s - 6) : U_KC + 64 * (s - 10); }
DI void post_proj_phase(bf16_t* U, bf16_t* Ud, float* out, const float* qkg, int l, int tid) {
  const int w = tid >> 6, lane = tid & 63, stride = gridDim.x * 8;
  const float g0 = qkg[lane], g1 = qkg[64 + lane];
  for (int base = BID() * 8 + w; base < MT; base += stride * RB) {
    float xv[RB][12];
#pragma unroll
    for (int r = 0; r < RB; ++r) {
      const int row = base + r * stride;
#pragma unroll
      for (int s = 0; s < 12; ++s) xv[r][s] = row < MT ? bf2f(U[(size_t)row * UW + pp_base(s) + lane]) : 0.f;
    }
#pragma unroll
    for (int r = 0; r < RB; ++r) {
      const int row = base + r * stride;
      const bool lat = row >= MCTX;
      float cs = 1.f, sn = 0.f;
      if (lat) {
        const int t = (row - MCTX) & 1023, i = lane & 31, f = i & 15;
        const float inv = exp2f(-(float)f * (13.287712379549449f / 16.f));
        const float ang = (float)(i < 16 ? (t >> 6) : (t & 63)) * inv;
        sincosf(ang, &sn, &cs);
      }
#pragma unroll
      for (int s = 0; s < 12; ++s) {
        const bool isq = (s < 4) || (s >= 6 && s < 10), nrm = s >= 6;
        float x = xv[r][s];
        if (nrm) { const float ss = wave_sum(x * x); x = x * rsqrtf(ss * (1.f / 64.f) + EPSF) * (s < 10 ? g0 : g1); }
        if (lat) { const float p = __shfl_xor(x, 32, 64); x = lane < 32 ? x * cs - p * sn : x * cs + p * sn; }
        if (row < MT) {
          if (s >= 10 && !lat) { const int b = row >> 8, t = row & 255; out[OUT_GQAK + ((size_t)(b * 512 + l * 256 + t)) * 128 + (s - 10) * 64 + lane] = x; }
          if (isq) x *= QSCALE;
          if (Ud) Ud[(size_t)row * UW + pp_base(s) + lane] = f2bf(x);
        }
      }
    }
  }
}

struct KVRegs { u32x4 k, v; };
constexpr int KROW = 72;
constexpr int KVBUF = 64 * KROW * 2;

DI KVRegs attn_load(const bf16_t* __restrict__ U, int R0, int kcol, int vcol, int k0start, int nt0, const float* __restrict__ ck, const float* __restrict__ cv, int ti, int tid) {
  KVRegs r; const int key = tid >> 3, ds = tid & 7;
  if (ti < nt0) {
    const bf16_t* p = U + (size_t)(R0 + k0start + 64 * ti + key) * UW;
    r.k = *(const u32x4*)(p + kcol + 8 * ds); r.v = *(const u32x4*)(p + vcol + 8 * ds);
  } else {
    const size_t off = (size_t)(64 * (ti - nt0) + key) * 128 + 8 * ds;
    const f32x4 a0 = *(const f32x4*)(ck + off), a1 = *(const f32x4*)(ck + off + 4), b0 = *(const f32x4*)(cv + off), b1 = *(const f32x4*)(cv + off + 4);
    r.k.x = cvtpk(a0[0], a0[1]); r.k.y = cvtpk(a0[2], a0[3]); r.k.z = cvtpk(a1[0], a1[1]); r.k.w = cvtpk(a1[2], a1[3]);
    r.v.x = cvtpk(b0[0], b0[1]); r.v.y = cvtpk(b0[2], b0[3]); r.v.z = cvtpk(b1[0], b1[1]); r.v.w = cvtpk(b1[2], b1[3]);
  }
  return r;
}
DI void attn_write(unsigned char* kb, unsigned char* vb, const KVRegs& r, int tid) {
  const int key = tid >> 3, ds = tid & 7;
  *(u32x4*)(kb + (key * KROW + 8 * ds) * 2) = r.k;
  bf16_t* vt = (bf16_t*)vb + (8 * ds) * KROW + key;
  vt[0] = (bf16_t)(r.v.x & 0xffff); vt[KROW] = (bf16_t)(r.v.x >> 16); vt[2 * KROW] = (bf16_t)(r.v.y & 0xffff); vt[3 * KROW] = (bf16_t)(r.v.y >> 16);
  vt[4 * KROW] = (bf16_t)(r.v.z & 0xffff); vt[5 * KROW] = (bf16_t)(r.v.z >> 16); vt[6 * KROW] = (bf16_t)(r.v.w & 0xffff); vt[7 * KROW] = (bf16_t)(r.v.w >> 16);
}

DI void attn_unit(CArgs& a, int l, int uidx, unsigned char* ldsb, int tid) {
  const bf16_t* U = (const bf16_t*)(a.ws + WS_ACT);
  bf16_t* O = (bf16_t*)(a.ws + WS_O);
  int type, b, kvh, qb;
  if (uidx < 64) { type = uidx < 32 ? 3 : 2; const int j = uidx & 31; b = j >> 4; kvh = (j >> 3) & 1; qb = j & 7; }
  else { type = uidx < 192 ? 0 : 1; const int j = (uidx - 64) & 127; b = j >> 2; kvh = (j >> 1) & 1; qb = j & 1; }
  const bool lat = type >= 2, isA = (type == 0 || type == 2);
  const int R0 = lat ? MCTX + b * 1024 : b * 256;
  const int w = tid >> 6, lane = tid & 63, hh = lane >> 5, l31 = lane & 31, g = w >> 2, head = 2 * kvh + g;
  const int qcol = (isA ? U_QA : U_QC) + head * 64, kcol = (isA ? U_KA : U_KC) + kvh * 64, vcol = (isA ? U_VA : U_VC) + kvh * 64;
  int k0start = 0, nk0 = lat ? 1024 : 256;
  if (type == 2) { const int lo = qb > 0 ? (qb - 1) * 128 : 0, hi = qb < 7 ? (qb + 2) * 128 : 1024; k0start = lo; nk0 = hi - lo; }
  const int nt0 = nk0 >> 6, nt = nt0 + (lat ? 8 : 0);
  const float* ck = nullptr; const float* cv = nullptr;
  if (lat) { const size_t co = ((size_t)((b * 2 + l) * 512)) * 128 + kvh * 64; ck = a.in[isA ? 2 : 4] + co; cv = a.in[isA ? 3 : 5] + co; }
  const int qrow = R0 + qb * 128 + (w & 3) * 32 + l31;
  const int qpos = qb * 128 + (w & 3) * 32 + l31;
  bf16x8 qf[4];
#pragma unroll
  for (int ks = 0; ks < 4; ++ks) qf[ks] = *(const bf16x8*)(U + (size_t)qrow * UW + qcol + 16 * ks + 8 * hh);
  float m_run = -1e30f, l_run = 0.f;
  if (isA) { m_run = a.in[17][l * 4 + head] * 1.4426950408889634f; l_run = hh == 0 ? 1.f : 0.f; }
  f32x16 o0, o1;
#pragma unroll
  for (int i = 0; i < 16; ++i) { o0[i] = 0.f; o1[i] = 0.f; }
  KVRegs regs = attn_load(U, R0, kcol, vcol, k0start, nt0, ck, cv, 0, tid);
  attn_write(ldsb, ldsb + KVBUF, regs, tid);
  __syncthreads();
  for (int ti = 0; ti < nt; ++ti) {
    const int cur = ti & 1;
    if (ti + 1 < nt) regs = attn_load(U, R0, kcol, vcol, k0start, nt0, ck, cv, ti + 1, tid);
    const unsigned char* kb = cur ? ldsb + 2 * KVBUF : ldsb;
    const unsigned char* vb = kb + KVBUF;
    const bool domask = (type == 2) && (ti < nt0);
#pragma unroll
    for (int sub = 0; sub < 2; ++sub) {
      f32x16 s;
#pragma unroll
      for (int i = 0; i < 16; ++i) s[i] = 0.f;
#pragma unroll
      for (int ks = 0; ks < 4; ++ks) {
        const bf16x8 ka = *(const bf16x8*)(kb + ((32 * sub + l31) * KROW + 16 * ks + 8 * hh) * 2);
        s = __builtin_amdgcn_mfma_f32_32x32x16_bf16(ka, qf[ks], s, 0, 0, 0);
      }
      if (domask) {
        const int kp0 = k0start + 64 * ti + 32 * sub;
#pragma unroll
        for (int i = 0; i < 16; ++i) { const int d = qpos - (kp0 + crow(i, hh)); if (d > 128 || d < -128) s[i] = -1e30f; }
      }
      float mt = s[0];
#pragma unroll
      for (int i = 1; i < 16; ++i) mt = fmaxf(mt, s[i]);
      mt = fmaxf(mt, __shfl_xor(mt, 32, 64));
      const float mn = fmaxf(m_run, mt);
      const float alpha = __builtin_amdgcn_exp2f(m_run - mn);
      m_run = mn;
      float ps = 0.f;
#pragma unroll
      for (int i = 0; i < 16; ++i) { s[i] = __builtin_amdgcn_exp2f(s[i] - mn); ps += s[i]; }
      l_run = l_run * alpha + ps;
#pragma unroll
      for (int i = 0; i < 16; ++i) { o0[i] *= alpha; o1[i] *= alpha; }
#pragma unroll
      for (int st = 0; st < 2; ++st) {
        u32x4 pw; pw.x = cvtpk(s[8 * st], s[8 * st + 1]); pw.y = cvtpk(s[8 * st + 2], s[8 * st + 3]); pw.z = cvtpk(s[8 * st + 4], s[8 * st + 5]); pw.w = cvtpk(s[8 * st + 6], s[8 * st + 7]);
        const bf16x8 pf = __builtin_bit_cast(bf16x8, pw);
        const int kofs = 32 * sub + 16 * st + 4 * hh;
        {
          const u32x2 lo = *(const u32x2*)(vb + (l31 * KROW + kofs) * 2), hi = *(const u32x2*)(vb + (l31 * KROW + kofs + 8) * 2);
          u32x4 vw; vw.x = lo.x; vw.y = lo.y; vw.z = hi.x; vw.w = hi.y;
          o0 = __builtin_amdgcn_mfma_f32_32x32x16_bf16(__builtin_bit_cast(bf16x8, vw), pf, o0, 0, 0, 0);
        }
        {
          const u32x2 lo = *(const u32x2*)(vb + ((32 + l31) * KROW + kofs) * 2), hi = *(const u32x2*)(vb + ((32 + l31) * KROW + kofs + 8) * 2);
          u32x4 vw; vw.x = lo.x; vw.y = lo.y; vw.z = hi.x; vw.w = hi.y;
          o1 = __builtin_amdgcn_mfma_f32_32x32x16_bf16(__builtin_bit_cast(bf16x8, vw), pf, o1, 0, 0, 0);
        }
      }
    }
    if (ti + 1 < nt) { unsigned char* nb = cur ? ldsb : ldsb + 2 * KVBUF; attn_write(nb, nb + KVBUF, regs, tid); }
    __syncthreads();
  }
  const float lt = l_run + __shfl_xor(l_run, 32, 64);
  const float inv = 1.f / lt;
  bf16_t* ost = (bf16_t*)(ldsb + w * (32 * KROW * 2));
#pragma unroll
  for (int gq = 0; gq < 4; ++gq) {
    u32x2 p0, p1;
    p0.x = cvtpk(o0[4 * gq] * inv, o0[4 * gq + 1] * inv); p0.y = cvtpk(o0[4 * gq + 2] * inv, o0[4 * gq + 3] * inv);
    p1.x = cvtpk(o1[4 * gq] * inv, o1[4 * gq + 1] * inv); p1.y = cvtpk(o1[4 * gq + 2] * inv, o1[4 * gq + 3] * inv);
    *(u32x2*)(ost + l31 * KROW + 8 * gq + 4 * hh) = p0;
    *(u32x2*)(ost + l31 * KROW + 32 + 8 * gq + 4 * hh) = p1;
  }
  __syncthreads();
  {
    const int q = lane >> 1, half = lane & 1;
    const int orow = R0 + qb * 128 + (w & 3) * 32 + q;
    bf16_t* op = O + (size_t)orow * 768 + (isA ? 0 : 256) + head * 64 + 32 * half;
    const bf16_t* sp = ost + q * KROW + 32 * half;
#pragma unroll
    for (int e = 0; e < 4; ++e) *(u32x4*)(op + 8 * e) = *(const u32x4*)(sp + 8 * e);
  }
  __syncthreads();
}

DI void hyena_unit(CArgs& a, int l, int conv, int c, int type, unsigned char* ldsb, int tid) {
  const int L = type ? 1024 : 256, nseq = type ? 2 : 32, tokbase = type ? MCTX : 0, L2 = 2 * L, L3 = 3 * L, CPS = L2 + 8;
  bf16_t* cp = (bf16_t*)ldsb;
  bf16_t* up = (bf16_t*)(ldsb + 33024);
  bf16_t* gt = (bf16_t*)(ldsb + 33024 + 49152);
  float* red = (float*)(ldsb + 33024 + 49152 + 16384);
  const bf16_t* HYT = (const bf16_t*)(a.ws + WS_HYT);
  bf16_t* Y1T = (bf16_t*)(a.ws + WS_Y1T);
  bf16_t* OBT = (bf16_t*)(a.ws + WS_OBT);
  const bf16_t* Kr = (const bf16_t*)(a.ws + WS_FILT) + ((size_t)((l * 2 + conv) * 256 + c)) * 2560 + (type ? 512 : 0);
  const float* cw = a.in[19] + l * 3 * 768; const float* cb = a.in[20] + l * 768;
  const int gc = (conv == 0 ? 256 : 512) + c;
  const float vw0 = cw[c], vw1 = cw[768 + c], vw2 = cw[1536 + c], vb = cb[c];
  const float gw0 = cw[gc], gw1 = cw[768 + gc], gw2 = cw[1536 + gc], gb = cb[gc];
  const int ntok = nseq * L, nch = L2 >> 3, nck = ntok >> 3;
  bf16_t* rawv = (bf16_t*)red;
  bf16_t* rawg = rawv + ntok + 16;
  {
    if (tid < nch) *(u32x4*)(cp + 8 * tid) = *(const u32x4*)(Kr + 8 * tid);
    const bf16_t* sg = HYT + (size_t)gc * MT + tokbase;
    const bf16_t* sv = (conv == 0 ? HYT : (const bf16_t*)Y1T) + (size_t)c * MT + tokbase;
    for (int ck = tid; ck < nck; ck += 512) {
      *(u32x4*)(rawg + 8 + 8 * ck) = *(const u32x4*)(sg + 8 * ck);
      *(u32x4*)(rawv + 8 + 8 * ck) = *(const u32x4*)(sv + 8 * ck);
    }
  }
  __syncthreads();
  if (tid < nch) {
    const u32x4 lo = *(const u32x4*)(cp + 8 * tid), hi = *(const u32x4*)(cp + 8 * tid + 8);
    const unsigned wv[8] = {lo.x, lo.y, lo.z, lo.w, hi.x, hi.y, hi.z, hi.w};
#pragma unroll
    for (int r = 1; r < 8; ++r) {
      u32x4 o;
      if ((r & 1) == 0) { o.x = wv[r / 2]; o.y = wv[r / 2 + 1]; o.z = wv[r / 2 + 2]; o.w = wv[r / 2 + 3]; }
      else { const int b = (r - 1) / 2;
        o.x = (wv[b] >> 16) | (wv[b + 1] << 16); o.y = (wv[b + 1] >> 16) | (wv[b + 2] << 16); o.z = (wv[b + 2] >> 16) | (wv[b + 3] << 16); o.w = (wv[b + 3] >> 16) | (wv[b + 4] << 16); }
      *(u32x4*)(cp + r * CPS + 8 * tid) = o;
    }
  }
  for (int ck = tid; ck < nck; ck += 512) {
    const int t0 = 8 * ck, s = t0 / L, p0 = t0 - s * L;
    const bool first = p0 == 0, last = p0 + 8 == L;
    float gx[10], vx[10];
    { const u32x4 m = *(const u32x4*)(rawg + 8 + t0);
      gx[0] = first ? 0.f : bf2f(rawg[8 + t0 - 1]); gx[9] = last ? 0.f : bf2f(rawg[8 + t0 + 8]);
      gx[1] = bflo(m.x); gx[2] = bfhi(m.x); gx[3] = bflo(m.y); gx[4] = bfhi(m.y); gx[5] = bflo(m.z); gx[6] = bfhi(m.z); gx[7] = bflo(m.w); gx[8] = bfhi(m.w); }
    u32x4 go, uo;
    { float y[8];
#pragma unroll
      for (int e = 0; e < 8; ++e) y[e] = gw0 * gx[e] + gw1 * gx[e + 1] + gw2 * gx[e + 2] + gb;
      go.x = cvtpk(y[0], y[1]); go.y = cvtpk(y[2], y[3]); go.z = cvtpk(y[4], y[5]); go.w = cvtpk(y[6], y[7]); }
    const u32x4 mv = *(const u32x4*)(rawv + 8 + t0);
    if (conv == 0) {
      vx[0] = first ? 0.f : bf2f(rawv[8 + t0 - 1]); vx[9] = last ? 0.f : bf2f(rawv[8 + t0 + 8]);
      vx[1] = bflo(mv.x); vx[2] = bfhi(mv.x); vx[3] = bflo(mv.y); vx[4] = bfhi(mv.y); vx[5] = bflo(mv.z); vx[6] = bfhi(mv.z); vx[7] = bflo(mv.w); vx[8] = bfhi(mv.w);
      float y[8];
#pragma unroll
      for (int e = 0; e < 8; ++e) y[e] = vw0 * vx[e] + vw1 * vx[e + 1] + vw2 * vx[e + 2] + vb;
      uo.x = cvtpk(y[0], y[1]); uo.y = cvtpk(y[2], y[3]); uo.z = cvtpk(y[4], y[5]); uo.w = cvtpk(y[6], y[7]);
    } else uo = mv;
    *(u32x4*)(gt + t0) = go;
    bf16_t* ub = up + s * L3 + p0;
    const u32x4 zz = {0u, 0u, 0u, 0u};
    *(u32x4*)(ub) = zz; *(u32x4*)(ub + L) = uo; *(u32x4*)(ub + L2) = zz;
  }
  __syncthreads();
  const int w = tid >> 6, lane = tid & 63, hh = lane >> 5, i = lane & 31, r = (8 - (i & 7)) & 7;
  int aa, sq, mlo, mhi;
  if (type == 0) { aa = i & 7; sq = 4 * w + (i >> 3); mlo = -7; mhi = 7; }
  else { aa = i; sq = w >> 2; mlo = -31 + 16 * (w & 3); mhi = mlo + 15 > 31 ? 31 : mlo + 15; }
  const bf16_t* useq = up + sq * L3;
  const bf16_t* cpr = cp + r * CPS;
  f32x16 acc;
#pragma unroll
  for (int q = 0; q < 16; ++q) acc[q] = 0.f;
  for (int m = mlo; m <= mhi; ++m) {
#pragma unroll
    for (int ks = 0; ks < 2; ++ks) {
      const int xi0 = L + 16 * ks + 8 * hh - i - 32 * m;
      const bf16x8 A = *(const bf16x8*)(cpr + (xi0 - r));
      const bf16x8 B = *(const bf16x8*)(useq + 32 * (aa - m) + 16 * ks + 8 * hh + L);
      acc = __builtin_amdgcn_mfma_f32_32x32x16_bf16(A, B, acc, 0, 0, 0);
    }
  }
  if (type == 1) {
#pragma unroll
    for (int q = 0; q < 16; ++q) red[w * 1024 + q * 64 + lane] = acc[q];
    __syncthreads();
    if ((w & 3) == 0) {
#pragma unroll
      for (int q = 0; q < 16; ++q) acc[q] += red[(w + 1) * 1024 + q * 64 + lane] + red[(w + 2) * 1024 + q * 64 + lane] + red[(w + 3) * 1024 + q * 64 + lane];
    }
  }
  if (type == 0 || (w & 3) == 0) {
    const float bias = a.in[27][(l * 2 + conv) * 256 + c];
    bf16_t* dst = (conv == 0 ? Y1T : OBT) + (size_t)c * MT + tokbase + sq * L;
#pragma unroll
    for (int gq = 0; gq < 4; ++gq) {
      float y[4];
#pragma unroll
      for (int e = 0; e < 4; ++e) {
        const int t = 32 * aa + 8 * gq + 4 * hh + e;
        y[e] = (acc[4 * gq + e] + bias * bf2f(useq[L + t])) * bf2f(gt[sq * L + t]);
      }
      u32x2 o; o.x = cvtpk(y[0], y[1]); o.y = cvtpk(y[2], y[3]);
      *(u32x2*)(dst + 32 * aa + 8 * gq + 4 * hh) = o;
    }
  }
  __syncthreads();
}

struct GlaLds { float *qs, *ks, *vs, *gls, *Ws, *bs, *gb, *A1, *A2; };
DI GlaLds gla_lds(unsigned char* ldsb) {
  GlaLds g; float* p = (float*)ldsb;
  g.qs = p; p += 64 * 33; g.ks = p; p += 64 * 33; g.vs = p; p += 64 * 65; g.gls = p; p += 64 * 32; g.Ws = p; p += 1024; g.bs = p; p += 64;
  g.gb = p; p += 2 * 64 * 33; g.A1 = p; p += 64 * 65; g.A2 = p; p += 64 * 65; return g;
}
DI int gla_row0(int seq, int cidx) { return (seq < 32 ? seq * 256 : MCTX + (seq - 32) * 1024) + 64 * cidx; }
DI int gla_gc(int seq, int n) { return (seq < 32 ? 4 * seq : 128 + 16 * (seq - 32)) + n; }

DI void gla_prep(CArgs& a, int l, int seq, int h, int cidx, const GlaLds& G, int tid) {
  const bf16_t* U = (const bf16_t*)(a.ws + WS_ACT);
  const int R0 = gla_row0(seq, cidx);
  { const int i = tid >> 3, d4 = (tid & 7) * 4; const bf16_t* rp = U + (size_t)(R0 + i) * UW;
    const u32x2 qv = *(const u32x2*)(rp + U_QD + h * 32 + d4), kv = *(const u32x2*)(rp + U_KD + h * 32 + d4);
    float* qd = G.qs + i * 33 + d4; qd[0] = bflo(qv.x); qd[1] = bfhi(qv.x); qd[2] = bflo(qv.y); qd[3] = bfhi(qv.y);
    float* kd = G.ks + i * 33 + d4; kd[0] = bflo(kv.x); kd[1] = bfhi(kv.x); kd[2] = bflo(kv.y); kd[3] = bfhi(kv.y);
    const int v8 = (tid & 7) * 8; const u32x4 vv = *(const u32x4*)(rp + U_VD + h * 64 + v8);
    float* vd = G.vs + i * 65 + v8; vd[0] = bflo(vv.x); vd[1] = bfhi(vv.x); vd[2] = bflo(vv.y); vd[3] = bfhi(vv.y); vd[4] = bflo(vv.z); vd[5] = bfhi(vv.z); vd[6] = bflo(vv.w); vd[7] = bfhi(vv.w);
    if (tid < 256) { const int i2 = tid >> 2, c8 = (tid & 3) * 8; const u32x4 gv = *(const u32x4*)(U + (size_t)(R0 + i2) * UW + U_GD + c8);
      float* gd = G.gls + i2 * 32 + c8; gd[0] = bflo(gv.x); gd[1] = bfhi(gv.x); gd[2] = bflo(gv.y); gd[3] = bfhi(gv.y); gd[4] = bflo(gv.z); gd[5] = bfhi(gv.z); gd[6] = bflo(gv.w); gd[7] = bfhi(gv.w); }
  }
  for (int e = tid; e < 1024; e += 512) { const int z = e >> 9, r = (e >> 5) & 15, d = e & 31; G.Ws[e] = a.in[28][(size_t)((l * 2 + z) * 16 + r) * 128 + h * 32 + d]; }
  if (tid < 64) G.bs[tid] = a.in[29][(l * 2 + (tid >> 5)) * 128 + h * 32 + (tid & 31)];
  for (int e = tid; e < 64 * 65; e += 512) { G.A1[e] = 0.f; G.A2[e] = 0.f; }
  __syncthreads();
#pragma unroll
  for (int e = 0; e < 8; ++e) {
    const int idx = tid * 8 + e, z = idx >> 11, i = (idx >> 5) & 63, d = idx & 31;
    float s = G.bs[z * 32 + d];
#pragma unroll
    for (int r = 0; r < 16; ++r) s += G.gls[i * 32 + z * 16 + r] * G.Ws[z * 512 + r * 32 + d];
    const float ls = fminf(s, 0.f) - log1pf(expf(-fabsf(s)));
    G.gb[z * 2112 + i * 33 + d] = ls * (1.f / 16.f);
  }
  __syncthreads();
  {
    const int w = tid >> 6, lane = tid & 63;
#pragma unroll
    for (int cc = 0; cc < 8; ++cc) {
      const int col = 8 * w + cc, z = col >> 5, d = col & 31, i = z == 0 ? lane : 63 - lane;
      float x = G.gb[z * 2112 + i * 33 + d];
#pragma unroll
      for (int o = 1; o < 64; o <<= 1) { const float y = __shfl_up(x, o, 64); if (lane >= o) x += y; }
      G.gb[z * 2112 + i * 33 + d] = x;
    }
  }
  __syncthreads();
}

constexpr float GLA_QS = 0.17677669529663687f;

DI void gla_a_unit(CArgs& a, int l, int uidx, unsigned char* ldsb, int tid) {
  int seq, h, cidx, nc;
  if (uidx < 512) { seq = uidx >> 4; h = (uidx >> 2) & 3; cidx = uidx & 3; nc = 4; } else { const int j = uidx - 512; seq = 32 + (j >> 6); h = (j >> 4) & 3; cidx = j & 15; nc = 16; }
  const GlaLds G = gla_lds(ldsb);
  gla_prep(a, l, seq, h, cidx, G, tid);
  const int w = tid >> 6, lane = tid & 63, hh = lane >> 5, l31 = lane & 31;
  const int R0 = gla_row0(seq, cidx);
  if (w < 6) {
    const int dir = w / 3, which = w % 3;
    const int ib = dir == 0 ? (which > 0) : (which == 2), jb = dir == 0 ? (which == 2) : (which > 0);
    const float* bz = G.gb + dir * 2112;
    f32x16 acc;
#pragma unroll
    for (int q = 0; q < 16; ++q) acc[q] = 0.f;
    const int ii = 32 * ib + l31, jj = 32 * jb + l31;
#pragma unroll 4
    for (int kk = 0; kk < 16; ++kk) {
      const int d = 2 * kk + hh;
      const float av = G.qs[ii * 33 + d] * __expf(bz[ii * 33 + d]) * GLA_QS;
      const float bv = G.ks[jj * 33 + d] * __expf(-bz[jj * 33 + d]);
      acc = __builtin_amdgcn_mfma_f32_32x32x2f32(av, bv, acc, 0, 0, 0);
    }
    float* Az = dir == 0 ? G.A1 : G.A2;
#pragma unroll
    for (int q = 0; q < 16; ++q) {
      const int i2 = 32 * ib + crow(q, hh);
      const bool keep = dir == 0 ? (jj <= i2) : (jj >= i2);
      Az[i2 * 65 + jj] = keep ? acc[q] : 0.f;
    }
  }
  __syncthreads();
  if (w < 4) {
    const int ib = w >> 1, vb = w & 1, ii = 32 * ib + l31;
    f32x16 acc;
#pragma unroll
    for (int q = 0; q < 16; ++q) acc[q] = 0.f;
#pragma unroll 4
    for (int kk = 0; kk < 32; ++kk) {
      const int j = 2 * kk + hh;
      const float av = G.A1[ii * 65 + j] + G.A2[ii * 65 + j];
      const float bv = G.vs[j * 65 + 32 * vb + l31];
      acc = __builtin_amdgcn_mfma_f32_32x32x2f32(av, bv, acc, 0, 0, 0);
    }
    float* od = (float*)(a.ws + WS_OD);
#pragma unroll
    for (int q = 0; q < 16; ++q) od[(size_t)(R0 + 32 * ib + crow(q, hh)) * 256 + h * 64 + 32 * vb + l31] = acc[q];
  } else {
    const int dir = (w - 4) >> 1, vb = w & 1;
    const float* bz = G.gb + dir * 2112;
    const float blast = dir == 0 ? bz[63 * 33 + l31] : bz[l31];
    f32x16 acc;
#pragma unroll
    for (int q = 0; q < 16; ++q) acc[q] = 0.f;
#pragma unroll 4
    for (int kk = 0; kk < 32; ++kk) {
      const int j = 2 * kk + hh;
      const float av = G.ks[j * 33 + l31] * __expf(blast - bz[j * 33 + l31]);
      const float bv = G.vs[j * 65 + 32 * vb + l31];
      acc = __builtin_amdgcn_mfma_f32_32x32x2f32(av, bv, acc, 0, 0, 0);
    }
    const int n = dir == 0 ? cidx : nc - 1 - cidx;
    const size_t gi = (size_t)(gla_gc(seq, n) * 4 + h) * 2 + dir;
    float* glc = (float*)(a.ws + WS_GLC) + gi * 2048;
#pragma unroll
    for (int q = 0; q < 16; ++q) glc[crow(q, hh) * 64 + 32 * vb + l31] = acc[q];
    if (vb == 0 && hh == 0) ((float*)(a.ws + WS_GLD))[gi * 32 + l31] = __expf(blast);
  }
  __syncthreads();
}

DI void gla_b_unit(CArgs& a, int l, int uidx, unsigned char* ldsb, int tid) {
  int seq, h, cidx, nc;
  if (uidx < 512) { seq = uidx >> 4; h = (uidx >> 2) & 3; cidx = uidx & 3; nc = 4; } else { const int j = uidx - 512; seq = 32 + (j >> 6); h = (j >> 4) & 3; cidx = j & 15; nc = 16; }
  const GlaLds G = gla_lds(ldsb);
  gla_prep(a, l, seq, h, cidx, G, tid);
  float* Ss = G.A1;
  const int w = tid >> 6, lane = tid & 63, hh = lane >> 5, l31 = lane & 31;
  const int R0 = gla_row0(seq, cidx);
  {
    const int dir = tid >> 8, e = tid & 255, d = e >> 3, v0 = (e & 7) * 8;
    float S[8];
    if (seq >= 32) { const float* sp = a.in[6] + ((size_t)((((seq - 32) * 2 + l) * 2 + dir) * 4 + h)) * 2048 + d * 64 + v0;
#pragma unroll
      for (int j = 0; j < 8; ++j) S[j] = sp[j]; }
    else {
#pragma unroll
      for (int j = 0; j < 8; ++j) S[j] = 0.f; }
    const int npos = dir == 0 ? cidx : nc - 1 - cidx;
    const float* glc = (const float*)(a.ws + WS_GLC); const float* gld = (const float*)(a.ws + WS_GLD);
    for (int n = 0; n < npos; n += 4) {
      float dec[4]; f32x4 c0[4], c1[4];
#pragma unroll
      for (int u = 0; u < 4; ++u) {
        dec[u] = 1.f; c0[u] = (f32x4){0.f, 0.f, 0.f, 0.f}; c1[u] = c0[u];
        if (n + u < npos) {
          const size_t gi = (size_t)(gla_gc(seq, n + u) * 4 + h) * 2 + dir;
          dec[u] = gld[gi * 32 + d]; c0[u] = *(const f32x4*)(glc + gi * 2048 + d * 64 + v0); c1[u] = *(const f32x4*)(glc + gi * 2048 + d * 64 + v0 + 4);
        }
      }
#pragma unroll
      for (int u = 0; u < 4; ++u) {
#pragma unroll
        for (int j = 0; j < 4; ++j) { S[j] = dec[u] * S[j] + c0[u][j]; S[4 + j] = dec[u] * S[4 + j] + c1[u][j]; }
      }
    }
#pragma unroll
    for (int j = 0; j < 8; ++j) Ss[dir * 2080 + d * 65 + v0 + j] = S[j];
    if (seq < 32 && npos == nc - 1) {
      const size_t gi = (size_t)(gla_gc(seq, npos) * 4 + h) * 2 + dir;
      const float dec = gld[gi * 32 + d];
      float* op = a.out + OUT_STATE + ((size_t)(((seq * 2 + l) * 2 + dir) * 4 + h)) * 2048 + d * 64 + v0;
#pragma unroll
      for (int j = 0; j < 8; ++j) op[j] = dec * S[j] + glc[gi * 2048 + d * 64 + v0 + j];
    }
  }
  __syncthreads();
  if (w < 4) {
    const int ib = w >> 1, vb = w & 1, ii = 32 * ib + l31;
    f32x16 acc;
#pragma unroll
    for (int q = 0; q < 16; ++q) acc[q] = 0.f;
#pragma unroll
    for (int dir = 0; dir < 2; ++dir) {
      const float* bz = G.gb + dir * 2112;
#pragma unroll 4
      for (int kk = 0; kk < 16; ++kk) {
        const int d = 2 * kk + hh;
        const float av = G.qs[ii * 33 + d] * __expf(bz[ii * 33 + d]) * GLA_QS;
        const float bv = Ss[dir * 2080 + d * 65 + 32 * vb + l31];
        acc = __builtin_amdgcn_mfma_f32_32x32x2f32(av, bv, acc, 0, 0, 0);
      }
    }
    const float* od = (const float*)(a.ws + WS_OD);
    bf16_t* O = (bf16_t*)(a.ws + WS_O);
#pragma unroll
    for (int q = 0; q < 16; ++q) {
      const int row = R0 + 32 * ib + crow(q, hh);
      O[(size_t)row * 768 + 512 + h * 64 + 32 * vb + l31] = f2bf(acc[q] + od[(size_t)row * 256 + h * 64 + 32 * vb + l31]);
    }
  }
  __syncthreads();
}

DI void merge_phase(CArgs& a, int l, unsigned char* ldsb, int tid) {
  bf16_t* obs = (bf16_t*)ldsb;
  const bf16_t* O = (const bf16_t*)(a.ws + WS_O); const bf16_t* OBT = (const bf16_t*)(a.ws + WS_OBT); const bf16_t* U = (const bf16_t*)(a.ws + WS_ACT);
  bf16_t* cat = (bf16_t*)(a.ws + WS_XN);
  const float* mg = a.in[16] + l * 1024;
  const int w = tid >> 6, lane = tid & 63;
  for (int tile = BID(); tile < MT / 32; tile += gridDim.x) {
    const int t0 = tile * 32;
    { const int c = tid >> 1, half = tid & 1;
      const u32x4 x0 = *(const u32x4*)(OBT + (size_t)c * MT + t0 + 16 * half), x1 = *(const u32x4*)(OBT + (size_t)c * MT + t0 + 16 * half + 8);
      bf16_t* d = obs + (16 * half) * 264 + c;
      d[0] = (bf16_t)(x0.x & 0xffff); d[264] = (bf16_t)(x0.x >> 16); d[2 * 264] = (bf16_t)(x0.y & 0xffff); d[3 * 264] = (bf16_t)(x0.y >> 16);
      d[4 * 264] = (bf16_t)(x0.z & 0xffff); d[5 * 264] = (bf16_t)(x0.z >> 16); d[6 * 264] = (bf16_t)(x0.w & 0xffff); d[7 * 264] = (bf16_t)(x0.w >> 16);
      d[8 * 264] = (bf16_t)(x1.x & 0xffff); d[9 * 264] = (bf16_t)(x1.x >> 16); d[10 * 264] = (bf16_t)(x1.y & 0xffff); d[11 * 264] = (bf16_t)(x1.y >> 16);
      d[12 * 264] = (bf16_t)(x1.z & 0xffff); d[13 * 264] = (bf16_t)(x1.z >> 16); d[14 * 264] = (bf16_t)(x1.w & 0xffff); d[15 * 264] = (bf16_t)(x1.w >> 16); }
    __syncthreads();
#pragma unroll
    for (int k = 0; k < 4; ++k) {
      const int tl = 4 * w + k, row = t0 + tl;
      const u32x2 wa = *(const u32x2*)(O + (size_t)row * 768 + 4 * lane), wc = *(const u32x2*)(O + (size_t)row * 768 + 256 + 4 * lane), wd = *(const u32x2*)(O + (size_t)row * 768 + 512 + 4 * lane);
      const u32x2 wb = *(const u32x2*)(obs + tl * 264 + 4 * lane), wr = *(const u32x2*)(U + (size_t)row * UW + U_RD + 4 * lane);
      float xa[4] = {bflo(wa.x), bfhi(wa.x), bflo(wa.y), bfhi(wa.y)}, xb[4] = {bflo(wb.x), bfhi(wb.x), bflo(wb.y), bfhi(wb.y)};
      float xc[4] = {bflo(wc.x), bfhi(wc.x), bflo(wc.y), bfhi(wc.y)}, xd[4] = {bflo(wd.x), bfhi(wd.x), bflo(wd.y), bfhi(wd.y)};
      float rd[4] = {bflo(wr.x), bfhi(wr.x), bflo(wr.y), bfhi(wr.y)};
      float sa = xa[0] * xa[0] + xa[1] * xa[1] + xa[2] * xa[2] + xa[3] * xa[3];
      float sb = xb[0] * xb[0] + xb[1] * xb[1] + xb[2] * xb[2] + xb[3] * xb[3];
      float sc = xc[0] * xc[0] + xc[1] * xc[1] + xc[2] * xc[2] + xc[3] * xc[3];
      float sd = xd[0] * xd[0] + xd[1] * xd[1] + xd[2] * xd[2] + xd[3] * xd[3];
      sa = wave_sum(sa); sb = wave_sum(sb); sc = wave_sum(sc);
#pragma unroll
      for (int o = 8; o >= 1; o >>= 1) sd += __shfl_xor(sd, o, 64);
      const float ra = rsqrtf(sa * (1.f / 256.f) + EPSF), rb = rsqrtf(sb * (1.f / 256.f) + EPSF), rc = rsqrtf(sc * (1.f / 256.f) + EPSF), rdn = rsqrtf(sd * (1.f / 64.f) + EPSF);
      const f32x4 ga = *(const f32x4*)(mg + 4 * lane), gb = *(const f32x4*)(mg + 256 + 4 * lane), gc = *(const f32x4*)(mg + 512 + 4 * lane), gd = *(const f32x4*)(mg + 768 + 4 * lane);
      float ya[4], yb[4], yc[4], yd[4];
#pragma unroll
      for (int e = 0; e < 4; ++e) { ya[e] = xa[e] * ra * ga[e]; yb[e] = xb[e] * rb * gb[e]; yc[e] = xc[e] * rc * gc[e]; yd[e] = xd[e] * rdn * gd[e] * (rd[e] / (1.f + __expf(-rd[e]))); }
      bf16_t* cp = cat + (size_t)row * DM + 4 * lane;
      u32x2 o;
      o.x = cvtpk(ya[0], ya[1]); o.y = cvtpk(ya[2], ya[3]); *(u32x2*)(cp) = o;
      o.x = cvtpk(yb[0], yb[1]); o.y = cvtpk(yb[2], yb[3]); *(u32x2*)(cp + 256) = o;
      o.x = cvtpk(yc[0], yc[1]); o.y = cvtpk(yc[2], yc[3]); *(u32x2*)(cp + 512) = o;
      o.x = cvtpk(yd[0], yd[1]); o.y = cvtpk(yd[2], yd[3]); *(u32x2*)(cp + 768) = o;
    }
    __syncthreads();
  }
}

#ifndef REP_G1
#define REP_G1 1
#endif
#ifndef REP_G2
#define REP_G2 1
#endif
#ifndef REP_G3
#define REP_G3 1
#endif
#ifndef REP_N
#define REP_N 1
#endif
#ifndef REP_M1
#define REP_M1 1
#endif
#ifndef REP_M2
#define REP_M2 1
#endif
#ifndef REP_MG
#define REP_MG 1
#endif
#ifndef REP_P0
#define REP_P0 1
#endif
#ifndef REP_PP
#define REP_PP 1
#endif
#ifndef REP_SYNC
#define REP_SYNC 1
#endif

#ifdef NO_ATTN
#define ATTN(...) do{}while(0)
#else
#define ATTN attn_unit
#endif
#ifdef NO_GLAA
#define GLAA(...) do{}while(0)
#else
#define GLAA gla_a_unit
#endif
#ifdef NO_GLAB
#define GLAB(...) do{}while(0)
#else
#define GLAB gla_b_unit
#endif
#ifdef NO_HY
#define HYEN(...) do{}while(0)
#else
#define HYEN hyena_unit
#endif

DI int q_fetch(unsigned* ctr, int tid) { int v = 0; if (tid == 0) v = (int)__hip_atomic_fetch_add(ctr, 1u, __ATOMIC_RELAXED, __HIP_MEMORY_SCOPE_AGENT); return v; }
DI int q_bcast(int v, unsigned char* ldsb, int tid) {
  volatile int* slot = (volatile int*)(ldsb + LDS_CTL_OFF);
  if (tid == 0) *slot = v;
  __syncthreads();
  const int r = *slot;
  __syncthreads();
  return r;
}

#ifndef N_LAUNCH_PER_PHASE
#define N_LAUNCH_PER_PHASE 0
#endif
constexpr int NPHASE = 28;

__global__ void __launch_bounds__(512, 2) fwd_kernel(Args a_) {
  extern __shared__ __attribute__((aligned(16))) unsigned char lds[];
  cg::grid_group grid = cg::this_grid();
  if (threadIdx.x < 16) ((volatile LAS unsigned*)((LAS unsigned char*)lds + LDS_CTL_OFF))[threadIdx.x] = 0u;
  __syncthreads();
  XcdBarrier xbar = xcd_barrier_post((unsigned*)(a_.ws + WS_BAR), (volatile LAS unsigned*)((LAS unsigned char*)lds + LDS_CTL_OFF + 16));
  const int ph_hi = a_.ph_hi;
  for (int ph = a_.ph_lo; ph < ph_hi; ++ph) {
    CArgs* ap = (CArgs*)__builtin_amdgcn_kernarg_segment_ptr();
    asm volatile("" : "+s"(ap));
    CArgs& a = *ap;
    int tid = threadIdx.x; asm volatile("" : "+v"(tid));
    int bid = blockIdx.x; asm volatile("" : "+s"(bid));
    unsigned char* ws = a.ws;
    float* mod = (float*)(ws + WS_MOD);
    bf16_t* XN = (bf16_t*)(ws + WS_XN); bf16_t* ACT = (bf16_t*)(ws + WS_ACT); float* H = (float*)(ws + WS_H);
    if (ph == 0) {

#ifndef NO_P0
      for (int rep = 0; rep < REP_P0; ++rep) {
      p0_convert(a, lds, tid);
      p0_modulation(a, lds, tid);
      p0_filters(a, lds, tid);
      }
#endif

    } else if (ph == NPHASE - 1) {
      for (int rep = 0; rep < REP_PP; ++rep) final_norm_phase(H, a.out, a.in[30], tid);
    } else {
      const int l = (ph - 1) / 13, s = (ph - 1) % 13;
      const float* mod_l = mod + (size_t)l * 3 * 9216;
      if (s == 0 || s == 3 || s == 10) {
        const int j = s == 0 ? 0 : (s == 3 ? 1 : 2);
        const bool first = (l == 0 && s == 0);
        for (int rep = 0; rep < REP_N; ++rep) norm_mod_phase(first ? a.in[0] : H, first ? a.in[1] : H + (size_t)MCTX * DM, XN, a.in[11] + (l * 3 + j) * 1024, mod_l, j, tid, first ? (const float*)(ws + WS_MODP) : nullptr, a.in[10]);
        if (first) mod_finalize(a, tid);
      } else if (s == 1 || s == 11) {
        const int f = s == 1 ? 0 : 1;
        pg8::Gemm g; g.A = XN; g.Bt = (const bf16_t*)(ws + WS_WFI) + (size_t)(l * 2 + f) * 5632 * 1024; g.M = MT; g.N = 5632; g.K = 1024;
        pg8::StaticOrder S; S.init(MT, 5632, gridDim.x, bid);
        EpiSwiglu E; E.act = ACT;

#ifndef NO_G1
for (int rep = 0; rep < REP_G1; ++rep) pg8::gemm_phase<EpiSwiglu, pg8::StaticOrder, true, true>((PG8_LAS unsigned char*)lds, g, S, E);
#endif

      } else if (s == 2 || s == 9 || s == 12) {
        pg8::Gemm g; g.M = MT; g.N = 1024;
        EpiRes E; E.h = H; E.resA = H; E.resB = H;
        if (s == 9) { g.A = XN; g.Bt = (const bf16_t*)(ws + WS_WOUT) + (size_t)l * 1024 * 1024; g.K = 1024; E.gate = mod_l + 5 * 1024; E.coef = 1.f; }
        else { const int f = s == 2 ? 0 : 1; g.A = ACT; g.Bt = (const bf16_t*)(ws + WS_WFO) + (size_t)(l * 2 + f) * 1024 * 2816; g.K = 2816; E.gate = mod_l + (f == 0 ? 2 : 8) * 1024; E.coef = 0.5f;
          if (l == 0 && s == 2) { E.resA = a.in[0]; E.resB = a.in[1] - (size_t)MCTX * DM; } }
        pg8::StaticOrder S; S.init(MT, 1024, gridDim.x, bid);

#ifndef NO_G2
for (int rep = 0; rep < REP_G2; ++rep) { E.h = rep + 1 < REP_G2 ? (float*)(ws + WS_O) : H; pg8::gemm_phase<EpiRes, pg8::StaticOrder, true, true>((PG8_LAS unsigned char*)lds, g, S, E); }
#endif

      } else if (s == 4) {
        pg8::Gemm g; g.A = XN; g.Bt = (const bf16_t*)(ws + WS_WIN) + (size_t)l * NINP * 1024; g.M = MT; g.N = NINP; g.K = 1024;
        pg8::StaticOrder S; S.init(MT, NINP, gridDim.x, bid);
        EpiInproj E; E.U = ACT; E.HYT = (bf16_t*)(ws + WS_HYT); E.out = a.out; E.l = l;

#ifndef NO_G3
for (int rep = 0; rep < REP_G3; ++rep) pg8::gemm_phase<EpiInproj, pg8::StaticOrder, true, true>((PG8_LAS unsigned char*)lds, g, S, E);
#endif

      } else if (s == 5) {
        for (int rep = 0; rep < REP_PP; ++rep) post_proj_phase(ACT, rep + 1 < REP_PP ? (bf16_t*)nullptr : ACT, a.out, a.in[18] + l * 128, l, tid);
      } else if (s == 6) {
        for (int rep = 0; rep < REP_M1; ++rep) {
        unsigned* ctr = (unsigned*)(ws + WS_CTL) + 64 * (l * 2 + 0) + 16 * rep;
        int q = q_bcast(q_fetch(ctr, tid), lds, tid);
        for (;;) {
          if (q >= 1472) break;
          const int qn = q_fetch(ctr, tid);
          if (q < 64) { ATTN(a, l, q, lds, tid); }
          else if (q < 704) { const int j = q - 64; GLAA(a, l, j < 128 ? 512 + j : j - 128, lds, tid); }
          else if (q < 1216) { const int j = q - 704; HYEN(a, l, 0, j & 255, j < 256 ? 1 : 0, lds, tid); }
          else { ATTN(a, l, 64 + (q - 1216), lds, tid); }
          q = q_bcast(qn, lds, tid);
        }
        }
      } else if (s == 7) {
        for (int rep = 0; rep < REP_M2; ++rep) {
        unsigned* ctr = (unsigned*)(ws + WS_CTL) + 64 * (l * 2 + 1) + 16 * rep;
        int q = q_bcast(q_fetch(ctr, tid), lds, tid);
        for (;;) {
          if (q >= 1152) break;
          const int qn = q_fetch(ctr, tid);
          if (q < 640) { GLAB(a, l, q < 128 ? 512 + q : q - 128, lds, tid); }
          else { const int j = q - 640; HYEN(a, l, 1, j & 255, j < 256 ? 1 : 0, lds, tid); }
          q = q_bcast(qn, lds, tid);
        }
        }
      } else if (s == 8) {

#ifndef NO_MERGE
for (int rep = 0; rep < REP_MG; ++rep) merge_phase(a, l, lds, tid);
#endif

      }
    }
    if (ph + 1 < ph_hi) { for (int rep = 0; rep < REP_SYNC; ++rep) { if (a_.ph_lo < 0) grid.sync(); xcd_barrier(xbar); } }
  }
}

extern "C" void kernel_launch(void* const* d_in, const int* in_sizes, int n_in, void* d_out, int out_size, void* d_ws, size_t ws_size, hipStream_t stream) {
  static int grid = 0;
  if (grid == 0) {
    if (n_in != 31 || ws_size < WS_END) { fprintf(stderr, "kernel_launch: need 31 inputs and >= %zu bytes of workspace; got %d, %zu\n", (size_t)WS_END, n_in, ws_size); grid = -1; return; }
    int dev = 0, cus = 0, per_cu = 0;
    (void)hipGetDevice(&dev);
    (void)hipDeviceGetAttribute(&cus, hipDeviceAttributeMultiprocessorCount, dev);
    if (hipFuncSetAttribute((const void*)fwd_kernel, hipFuncAttributeMaxDynamicSharedMemorySize, LDS_BYTES) != hipSuccess) { fprintf(stderr, "kernel_launch: hipFuncSetAttribute failed\n"); grid = -1; return; }
    if (hipOccupancyMaxActiveBlocksPerMultiprocessor(&per_cu, (const void*)fwd_kernel, 512, LDS_BYTES) != hipSuccess || per_cu < 1) { fprintf(stderr, "kernel_launch: occupancy query says %d\n", per_cu); per_cu = 1; }
    (void)hipGetLastError();
    grid = cus * 1;
    if (grid <= 0) grid = 256;
  }
  if (grid < 0) return;
  (void)hipMemsetAsync((char*)d_ws + WS_CTL, 0, 32768, stream);
  Args a{};
  for (int i = 0; i < 31; ++i) a.in[i] = (const float*)d_in[i];
  a.out = (float*)d_out; a.ws = (unsigned char*)d_ws;
#if N_LAUNCH_PER_PHASE
  for (int ph = 0; ph < NPHASE; ++ph) { a.ph_lo = ph; a.ph_hi = ph + 1; hipLaunchKernelGGL(fwd_kernel, dim3(grid), dim3(512), LDS_BYTES, stream, a); }
#else
  a.ph_lo = 0; a.ph_hi = NPHASE;
  void* args[] = {&a};
  hipError_t e = hipLaunchCooperativeKernel((const void*)fwd_kernel, dim3(grid), dim3(512), args, LDS_BYTES, stream);
  if (e != hipSuccess) fprintf(stderr, "kernel_launch: cooperative launch failed: %s (grid %d)\n", hipGetErrorString(e), grid);
#endif
}
```

```cpp
#include <hip/hip_runtime.h>
#include <hip/hip_cooperative_groups.h>
#include <cstdio>
#include <cstdint>
namespace cg = cooperative_groups;

#define DI __device__ __forceinline__
#define LAS __attribute__((address_space(3)))
typedef unsigned short bf16_t;
typedef short bf16x8 __attribute__((ext_vector_type(8)));
typedef float f32x4 __attribute__((ext_vector_type(4)));
typedef float f32x16 __attribute__((ext_vector_type(16)));
typedef unsigned u32x4 __attribute__((ext_vector_type(4)));
typedef unsigned u32x2 __attribute__((ext_vector_type(2)));
typedef __bf16 bf16x2_t __attribute__((ext_vector_type(2)));
typedef float f32x2_t __attribute__((ext_vector_type(2)));

DI unsigned cvtpk(float lo, float hi) { f32x2_t v = {lo, hi}; bf16x2_t b = __builtin_convertvector(v, bf16x2_t); return __builtin_bit_cast(unsigned, b); }
DI float bf2f(bf16_t x) { return __uint_as_float(((unsigned)x) << 16); }
DI bf16_t f2bf(float x) { return (bf16_t)(cvtpk(x, 0.f) & 0xffffu); }
DI float bflo(unsigned w) { return __uint_as_float(w << 16); }
DI float bfhi(unsigned w) { return __uint_as_float(w & 0xffff0000u); }
DI float wave_sum(float v) {
#pragma unroll
  for (int o = 32; o >= 1; o >>= 1) v += __shfl_xor(v, o, 64);
  return v;
}
DI float siluf(float a) { return a * __builtin_amdgcn_rcpf(1.f + __expf(-a)); }
DI int crow(int r, int hi) { return (r & 3) + 8 * (r >> 2) + 4 * hi; }

constexpr int MT = 10240, MCTX = 8192, DM = 1024, DFF = 2816, NINP = 2816, NIN = 2592, UW = 1824;
constexpr int U_QA = 0, U_KA = 256, U_VA = 384, U_QC = 512, U_KC = 768, U_VC = 896, U_QD = 1024, U_KD = 1152, U_VD = 1280, U_GD = 1536, U_RD = 1568;
constexpr float EPSF = 1e-6f;
constexpr float QSCALE = 0.125f * 1.4426950408889634f;
constexpr size_t OUT_SWAK = 10485760, OUT_SWAV = 12582912, OUT_GQAK = 14680064, OUT_GQAV = 16777216, OUT_STATE = 18874368;
constexpr size_t WS_CTL = 0;
constexpr size_t WS_BAR = 4096;
constexpr size_t WS_WFI = 32768;
constexpr size_t WS_WFO = WS_WFI + (size_t)4 * 5632 * 1024 * 2;
constexpr size_t WS_WIN = WS_WFO + (size_t)4 * 1024 * 2816 * 2;
constexpr size_t WS_WOUT = WS_WIN + (size_t)2 * 2816 * 1024 * 2;
constexpr size_t WS_MOD = WS_WOUT + (size_t)2 * 1024 * 1024 * 2;
constexpr size_t WS_FILT = WS_MOD + (size_t)2 * 3 * 9216 * 4;
constexpr size_t WS_XN = WS_FILT + (size_t)2 * 2 * 256 * 2560 * 2;
constexpr size_t WS_ACT = WS_XN + (size_t)MT * 1024 * 2;
constexpr size_t WS_H = WS_ACT + (size_t)MT * 2816 * 2;
constexpr size_t WS_O = WS_H + (size_t)MT * 1024 * 4;
constexpr size_t WS_OBT = WS_O + (size_t)MT * 768 * 2;
constexpr size_t WS_HYT = WS_OBT + (size_t)256 * MT * 2;
constexpr size_t WS_Y1T = WS_HYT + (size_t)768 * MT * 2;
constexpr size_t WS_OD = WS_Y1T + (size_t)256 * MT * 2;
constexpr size_t WS_GLC = WS_OD + (size_t)MT * 256 * 4;
constexpr size_t WS_GLD = WS_GLC + (size_t)160 * 4 * 2 * 2048 * 4;
constexpr size_t WS_MODP = WS_GLD + (size_t)160 * 4 * 2 * 32 * 4;
constexpr size_t WS_END = WS_MODP + (size_t)4 * 55296 * 4;
constexpr int LDS_BYTES = 147456;
constexpr int LDS_CTL_OFF = LDS_BYTES - 64;

struct Args { const float* in[31]; float* out; unsigned char* ws; int ph_lo, ph_hi; };
typedef const __attribute__((address_space(4))) Args CArgs;


DI int BID() { int b = blockIdx.x; asm volatile("" : "+s"(b)); return b; }
namespace pg8 {
#define PG8_LAS __attribute__((address_space(3)))
typedef unsigned short bf16_t;
typedef short bf16x8 __attribute__((ext_vector_type(8)));
typedef float f32x4 __attribute__((ext_vector_type(4)));
typedef unsigned u32x4 __attribute__((ext_vector_type(4)));
constexpr int BM = 256, BK = 64, HALF = 128, HTB = HALF * BK * 2  , STAGE_BYTES = 8 * HTB, NXCD = 8, WGM = 8;

__host__ __device__ __forceinline__ int lds_byte(int r, int c) { const int st = (r >> 4) * 2 + (c >> 5), rr = r & 15, cc = c & 31, ob = rr * 64 + cc * 2; return st * 1024 + (ob ^ (((ob >> 9) & 1) << 5)); }
__host__ __device__ __forceinline__ void stage_rc(int b, int& R, int& C) { const int st = b / 1024, sb = b % 1024, swz = sb ^ (((sb >> 9) & 1) << 5); R = (st >> 1) * 16 + swz / 64; C = (st & 1) * 32 + (swz % 64) / 2; }
__host__ __device__ __forceinline__ int perm32(int rho) { const int n = rho >> 4, i = rho & 15; return 8 * (i >> 2) + 4 * n + (i & 3); }

struct Unit { int pm, pn; };
struct Gemm { const bf16_t* A; const bf16_t* Bt; int M, N, K; };

struct StaticOrder {
    int nM, nN, nwg, G, c;
    __host__ __device__ void init(int M, int N, int G_, int c_) { nM = M / BM; nN = N / BM; nwg = nM * nN; G = G_; c = c_; }
    __host__ __device__ bool next(int i, Unit& u) const {
        const long L = (long)i * G + c; if (L >= nwg) return false;
        int wgid = (int)L; { const int q = nwg / NXCD, r = nwg % NXCD, xcd = wgid % NXCD, off = wgid / NXCD; wgid = (xcd < r ? xcd * (q + 1) : r * (q + 1) + (xcd - r) * q) + off; }
        const int nig = WGM * nN, gid = wgid / nig, fm = gid * WGM, gsz = (nM - fm) < WGM ? (nM - fm) : WGM;
        u.pm = fm + ((wgid % nig) % gsz); u.pn = (wgid % nig) / gsz; return true;
    }
    __device__ __forceinline__ void a_ready(const Unit&) const {}
    __device__ __forceinline__ void done(const Unit&) const {}
};
template <class Epi, class Sched, bool ALIGN_EPI = false, bool SP2 = false>
__device__ __forceinline__ void gemm_phase(PG8_LAS unsigned char* lds, const Gemm g, const Sched& S, const Epi& E) {
    int tid_l = threadIdx.x; asm volatile("" : "+v"(tid_l));
    const int tid = tid_l, wid = __builtin_amdgcn_readfirstlane(tid >> 6), lane = tid & 63, wr = wid >> 2, wc = wid & 3, fr = lane & 15, fq = lane >> 4;
    const int K = g.K, nt = K / BK;
    unsigned voffA[2], voffB[2];
#pragma unroll
    for (int i = 0; i < 2; ++i) { int R, C; stage_rc(tid * 16 + i * 8192, R, C); const int Rb = Epi::PERM ? ((R & ~31) + perm32(R & 31)) : R;
        voffA[i] = (unsigned)(R * K + C) * 2u; voffB[i] = (unsigned)(Rb * K + C) * 2u; }
    const size_t kstep = (size_t)(BK * 2);
    const size_t hstep = (size_t)HALF * K * 2;
    const size_t tstep = 2 * hstep;
    const unsigned ldsw = (unsigned)wid * 1024u;
    const int aoff = lds_byte(wr * 64 + fr, fq * 8), boff = lds_byte(wc * 32 + fr, fq * 8);
#define PG8_SA(b, h) (((b) * 2 + (h)) * HTB)
#define PG8_SB(b, h) ((4 + (b) * 2 + (h)) * HTB)
#define PG8_STAGE(bufoff, gbase, voff) do { _Pragma("unroll") for (int _i = 0; _i < 2; ++_i) \
        __builtin_amdgcn_global_load_lds((const unsigned*)((const char*)(gbase) + (voff)[_i]), (PG8_LAS unsigned*)(lds + (bufoff) + ldsw + _i * 8192), 16, 0, 0); } while (0)
#define PG8_LDA(dst, b, h) do { _Pragma("unroll") for (int m = 0; m < 4; ++m) _Pragma("unroll") for (int k = 0; k < 2; ++k) dst[m][k] = *(const PG8_LAS bf16x8*)(lds + PG8_SA(b, h) + aoff + m * 2048 + k * 1024); } while (0)
#define PG8_LDB(dst, b, h) do { _Pragma("unroll") for (int n = 0; n < 2; ++n) _Pragma("unroll") for (int k = 0; k < 2; ++k) dst[n][k] = *(const PG8_LAS bf16x8*)(lds + PG8_SB(b, h) + boff + n * 2048 + k * 1024); } while (0)
#define PG8_MMA(ai, bj, At, Bt) do { __builtin_amdgcn_s_setprio(1); _Pragma("unroll") for (int m = 0; m < 4; ++m) _Pragma("unroll") for (int n = 0; n < 2; ++n) _Pragma("unroll") for (int k = 0; k < 2; ++k) \
        acc[ai][bj][m][n] = __builtin_amdgcn_mfma_f32_16x16x32_bf16(Bt[n][k], At[m][k], acc[ai][bj][m][n], 0, 0, 0); __builtin_amdgcn_s_setprio(0); } while (0)
#define PG8_WAIT_V(n) asm volatile("s_waitcnt vmcnt(" #n ")" ::: "memory")
#define PG8_WAIT_L(n) asm volatile("s_waitcnt lgkmcnt(" #n ")" ::: "memory")
#define PG8_BAR __builtin_amdgcn_s_barrier()
#define PG8_SCHED __builtin_amdgcn_sched_barrier(0)
    Unit cur, nxt; int ui = 0;
    if (!S.next(0, cur)) return;
    f32x4 acc[2][2][4][2];
#pragma unroll
    for (int a = 0; a < 2; ++a)
#pragma unroll
        for (int b = 0; b < 2; ++b)
#pragma unroll
            for (int m = 0; m < 4; ++m)
#pragma unroll
                for (int n = 0; n < 2; ++n) acc[a][b][m][n] = (f32x4){0.f, 0.f, 0.f, 0.f};
    bf16x8 At[4][2], B0[2][2], B1[2][2];
    const char* cA = (const char*)g.A + (size_t)cur.pm * tstep; const char* cB = (const char*)g.Bt + (size_t)cur.pn * tstep;
    S.a_ready(cur);
    if constexpr (SP2) {
        PG8_STAGE(PG8_SB(0, 0), cB, voffB); PG8_STAGE(PG8_SB(0, 1), cB + hstep, voffB); PG8_STAGE(PG8_SA(0, 0), cA, voffA); PG8_STAGE(PG8_SA(0, 1), cA + hstep, voffA);
        if (wr == 1) PG8_BAR;
        PG8_WAIT_V(2); PG8_BAR;
        PG8_STAGE(PG8_SB(1, 0), cB + kstep, voffB); PG8_STAGE(PG8_SA(1, 0), cA + kstep, voffA); PG8_STAGE(PG8_SB(1, 1), cB + hstep + kstep, voffB);
        PG8_WAIT_V(6); PG8_BAR;
    } else {
        PG8_STAGE(PG8_SB(0, 0), cB, voffB); PG8_STAGE(PG8_SA(0, 0), cA, voffA); PG8_STAGE(PG8_SB(0, 1), cB + hstep, voffB); PG8_STAGE(PG8_SA(0, 1), cA + hstep, voffA);
        if (wr == 1) PG8_BAR;
        PG8_WAIT_V(4); PG8_BAR;
        PG8_STAGE(PG8_SB(1, 0), cB + kstep, voffB); PG8_STAGE(PG8_SA(1, 0), cA + kstep, voffA); PG8_STAGE(PG8_SB(1, 1), cB + hstep + kstep, voffB);
        PG8_WAIT_V(6); PG8_BAR;
    }
    for (;;) {
        const bool has_next = S.next(ui + 1, nxt);
        const char* nA = has_next ? (const char*)g.A + (size_t)nxt.pm * tstep : cA; const char* nB = has_next ? (const char*)g.Bt + (size_t)nxt.pn * tstep : cB;
        for (int t = 0; t < nt; t += 2) {
            const bool last = (t == nt - 2);
            const char* a1 = cA + (size_t)(t + 1) * kstep;
            const char* a2 = last ? nA : cA + (size_t)(t + 2) * kstep; const char* b2 = last ? nB : cB + (size_t)(t + 2) * kstep;
            const char* a3 = a2 + kstep; const char* b3 = b2 + kstep;
            if (last && has_next) S.a_ready(nxt);
            if constexpr (SP2) {
            PG8_LDB(B0, 0, 0); PG8_LDB(B1, 0, 1); PG8_SCHED; PG8_LDA(At, 0, 0); PG8_STAGE(PG8_SA(1, 1), a1 + hstep, voffA);
            PG8_WAIT_V(8); PG8_WAIT_L(0); PG8_BAR; PG8_MMA(0, 0, At, B0); PG8_MMA(0, 1, At, B1); PG8_BAR; PG8_SCHED;
            PG8_LDA(At, 0, 1); PG8_STAGE(PG8_SB(0, 0), b2, voffB); PG8_STAGE(PG8_SB(0, 1), b2 + hstep, voffB); PG8_STAGE(PG8_SA(0, 0), a2, voffA);
            PG8_WAIT_V(8); PG8_WAIT_L(0); PG8_BAR; PG8_MMA(1, 0, At, B0); PG8_MMA(1, 1, At, B1); PG8_BAR; PG8_SCHED;
            PG8_LDB(B0, 1, 0); PG8_LDB(B1, 1, 1); PG8_SCHED; PG8_LDA(At, 1, 0); PG8_STAGE(PG8_SA(0, 1), a2 + hstep, voffA);
            PG8_WAIT_V(8); PG8_WAIT_L(0); PG8_BAR; PG8_MMA(0, 0, At, B0); PG8_MMA(0, 1, At, B1); PG8_BAR; PG8_SCHED;
            PG8_LDA(At, 1, 1); PG8_STAGE(PG8_SB(1, 0), b3, voffB); PG8_STAGE(PG8_SB(1, 1), b3 + hstep, voffB); PG8_STAGE(PG8_SA(1, 0), a3, voffA);
            PG8_WAIT_V(8); PG8_WAIT_L(0); PG8_BAR; PG8_MMA(1, 0, At, B0); PG8_MMA(1, 1, At, B1); PG8_BAR; PG8_SCHED;
            } else {
            PG8_LDB(B0, 0, 0); PG8_SCHED; PG8_LDA(At, 0, 0); PG8_STAGE(PG8_SA(1, 1), a1 + hstep, voffA);
            PG8_WAIT_L(8); PG8_BAR; PG8_WAIT_L(0); PG8_MMA(0, 0, At, B0); PG8_BAR; PG8_SCHED;
            PG8_LDB(B1, 0, 1); PG8_STAGE(PG8_SB(0, 0), b2, voffB);
            PG8_BAR; PG8_WAIT_L(0); PG8_MMA(0, 1, At, B1); PG8_BAR;
            PG8_LDA(At, 0, 1); PG8_STAGE(PG8_SA(0, 0), a2, voffA);
            PG8_BAR; PG8_WAIT_L(0); PG8_MMA(1, 0, At, B0); PG8_BAR; PG8_SCHED;
            PG8_STAGE(PG8_SB(0, 1), b2 + hstep, voffB);
            PG8_WAIT_V(6); PG8_BAR; PG8_MMA(1, 1, At, B1); PG8_BAR;
            PG8_LDB(B0, 1, 0); PG8_SCHED; PG8_LDA(At, 1, 0); PG8_STAGE(PG8_SA(0, 1), a2 + hstep, voffA);
            PG8_WAIT_L(8); PG8_BAR; PG8_WAIT_L(0); PG8_MMA(0, 0, At, B0); PG8_BAR; PG8_SCHED;
            PG8_LDB(B1, 1, 1); PG8_STAGE(PG8_SB(1, 0), b3, voffB);
            PG8_BAR; PG8_WAIT_L(0); PG8_MMA(0, 1, At, B1); PG8_BAR;
            PG8_LDA(At, 1, 1); PG8_STAGE(PG8_SA(1, 0), a3, voffA);
            PG8_BAR; PG8_WAIT_L(0); PG8_MMA(1, 0, At, B0); PG8_BAR; PG8_SCHED;
            PG8_STAGE(PG8_SB(1, 1), b3 + hstep, voffB);
            PG8_WAIT_V(6); PG8_BAR; PG8_MMA(1, 1, At, B1); PG8_BAR;
            }
        }
        if constexpr (ALIGN_EPI) { if (wr == 0) PG8_BAR; }
        if constexpr (!Epi::AFTER_DRAIN) { E(acc, cur, wr, wc, fr, fq); S.done(cur); }
        if (!has_next) break;
#pragma unroll
        for (int a = 0; a < 2; ++a)
#pragma unroll
            for (int b = 0; b < 2; ++b)
#pragma unroll
                for (int m = 0; m < 4; ++m)
#pragma unroll
                    for (int n = 0; n < 2; ++n) acc[a][b][m][n] = (f32x4){0.f, 0.f, 0.f, 0.f};
        cur = nxt; cA = nA; cB = nB; ++ui;
        if constexpr (ALIGN_EPI) { if (wr == 1) PG8_BAR; }
    }
    PG8_WAIT_V(0);
    if constexpr (!ALIGN_EPI) { if (wr == 0) PG8_BAR; }
    PG8_BAR;
    if constexpr (Epi::AFTER_DRAIN) { E.fused(acc, cur, wr, wc, fr, fq, lds, wid, lane); S.done(cur); }
#undef PG8_SA
#undef PG8_SB
#undef PG8_STAGE
#undef PG8_LDA
#undef PG8_LDB
#undef PG8_MMA
#undef PG8_WAIT_V
#undef PG8_WAIT_L
#undef PG8_BAR
#undef PG8_SCHED
}
}
#define XB_TMO      128
#define XB_XCNT(j)  (256  + 64 * (j))
#define XB_XSUB(j)  (1280 + 64 * (j))
#define XB_XGEN(j)  (2304 + 64 * (j))
#define XB_TOP      3328
#define XB_TOPGEN   3392
#define XCD_BAR_WORDS 3456
#define XB_SPIN_CAP (1u << 18)

__device__ __forceinline__ unsigned xb_ld(unsigned* p)              { return __hip_atomic_load(p, __ATOMIC_RELAXED, __HIP_MEMORY_SCOPE_AGENT); }
__device__ __forceinline__ unsigned xb_add(unsigned* p, unsigned v) { return __hip_atomic_fetch_add(p, v, __ATOMIC_RELAXED, __HIP_MEMORY_SCOPE_AGENT); }
__device__ __forceinline__ unsigned xb_xcc_id() { return (unsigned)__builtin_amdgcn_s_getreg((3 << 11) | 20) & 0xFu; }
#define XB_SPIN(cond, bar) do { unsigned _sp = 0; while (cond) { __builtin_amdgcn_s_sleep(1); \
    if ((++_sp & 255u) == 0u) { if (xb_ld(&(bar)[XB_TMO])) break; if (_sp > XB_SPIN_CAP) { atomicAdd(&(bar)[XB_TMO], 1u); break; } } } } while (0)

struct XcdBarrier {
    unsigned* bar; unsigned x;
    volatile LAS unsigned* st;
};

__device__ __forceinline__ XcdBarrier xcd_barrier_post(unsigned* bar, volatile LAS unsigned* st) {
    XcdBarrier b; b.bar = bar; b.x = xb_xcc_id(); b.st = st;
    if (threadIdx.x == 0) (void)xb_add(&bar[XB_XCNT(b.x)], 1u);
    return b;
}
__device__ __forceinline__ void xcd_barrier_complete(unsigned* bar, unsigned x, unsigned& nloc, unsigned& nx) {
    const unsigned G = gridDim.x * gridDim.y * gridDim.z;
    unsigned sum, cnt, mine, sp = 0u;
    for (;;) {
        sum = 0u; cnt = 0u; mine = 0u;
#pragma unroll
        for (unsigned j = 0; j < 16; ++j) { const unsigned c = xb_ld(&bar[XB_XCNT(j)]); sum += c; cnt += (c > 0u) ? 1u : 0u; mine = (j == x) ? c : mine; }
        if (sum == G) break;
        __builtin_amdgcn_s_sleep(1);
        if ((++sp & 255u) == 0u) { if (xb_ld(&bar[XB_TMO])) break; if (sp > XB_SPIN_CAP) { atomicAdd(&bar[XB_TMO], 1u); break; } }
    }
    nloc = mine > 0u ? mine : 1u; nx = cnt > 0u ? cnt : 1u;
}

__device__ __forceinline__ void xcd_barrier(const XcdBarrier& b) {
    asm volatile("s_waitcnt vmcnt(0)" ::: "memory");
    __syncthreads();
    if (threadIdx.x == 0) {
        unsigned* bar = b.bar;
        __builtin_amdgcn_s_waitcnt(0);
        unsigned nloc = b.st[0], nx = b.st[1];
        if (nloc == 0u) { xcd_barrier_complete(bar, b.x, nloc, nx); b.st[0] = nloc; b.st[1] = nx; }
        const unsigned old = xb_add(&bar[XB_XSUB(b.x)], 1u);
        const unsigned gen = old / nloc;
        if (old + 1u == (gen + 1u) * nloc) {
            __builtin_amdgcn_fence(__ATOMIC_RELEASE, "agent");
            asm volatile("s_waitcnt vmcnt(0)" ::: "memory");
            const unsigned og = xb_add(&bar[XB_TOP], 1u);
            const unsigned tg = og / nx;
            if (og + 1u == (tg + 1u) * nx) xb_add(&bar[XB_TOPGEN], 1u);
            else XB_SPIN(xb_ld(&bar[XB_TOPGEN]) == tg, bar);
            __builtin_amdgcn_fence(__ATOMIC_ACQUIRE, "agent");
            xb_add(&bar[XB_XGEN(b.x)], 1u);
            asm volatile("s_waitcnt vmcnt(0)" ::: "memory");
        } else {
            XB_SPIN(xb_ld(&bar[XB_XGEN(b.x)]) == gen, bar);
            __builtin_amdgcn_fence(__ATOMIC_ACQUIRE, "agent");
            asm volatile("s_waitcnt vmcnt(0)" ::: "memory");
        }
    }
    __syncthreads();
}

struct EpiSwiglu {
  static constexpr bool PERM = true, AFTER_DRAIN = false;
  bf16_t* act;
  DI void operator()(const f32x4 (&acc)[2][2][4][2], const pg8::Unit& u, int wr, int wc, int fr, int fq) const {
    const int row0 = u.pm * 256 + wr * 64 + fr, col0 = u.pn * 128 + wc * 32 + 8 * fq;
#pragma unroll
    for (int ai = 0; ai < 2; ++ai)
#pragma unroll
      for (int m = 0; m < 4; ++m) {
        bf16_t* rowp = act + (size_t)(row0 + ai * 128 + m * 16) * DFF + col0;
        const f32x4 a0 = acc[ai][0][m][0], a1 = acc[ai][0][m][1], b0 = acc[ai][1][m][0], b1 = acc[ai][1][m][1];
        u32x4 w;
        w.x = cvtpk(siluf(a0[0]) * b0[0], siluf(a0[1]) * b0[1]); w.y = cvtpk(siluf(a0[2]) * b0[2], siluf(a0[3]) * b0[3]);
        w.z = cvtpk(siluf(a1[0]) * b1[0], siluf(a1[1]) * b1[1]); w.w = cvtpk(siluf(a1[2]) * b1[2], siluf(a1[3]) * b1[3]);
        *(u32x4*)rowp = w;
      }
  }
};

struct EpiRes {
  static constexpr bool PERM = true, AFTER_DRAIN = false;
  float* h; const float* resA; const float* resB; const float* gate; float coef;
  DI void operator()(const f32x4 (&acc)[2][2][4][2], const pg8::Unit& u, int wr, int wc, int fr, int fq) const {
    const int g = u.pm < 32 ? 0 : (u.pm < 36 ? 1 : 2);
    const float* res = u.pm < 32 ? resA : resB;
    const int row0 = u.pm * 256 + wr * 64 + fr, col0 = u.pn * 256 + wc * 32 + 8 * fq;
    f32x4 gv[2][2];
#pragma unroll
    for (int bj = 0; bj < 2; ++bj)
#pragma unroll
      for (int n = 0; n < 2; ++n) gv[bj][n] = *(const f32x4*)(gate + (size_t)g * 9216 + col0 + bj * 128 + 4 * n) * coef;
#pragma unroll
    for (int ai = 0; ai < 2; ++ai)
#pragma unroll
      for (int m = 0; m < 4; ++m)
#pragma unroll
        for (int bj = 0; bj < 2; ++bj)
#pragma unroll
          for (int n = 0; n < 2; ++n) {
            const size_t idx = (size_t)(row0 + ai * 128 + m * 16) * DM + col0 + bj * 128 + 4 * n;
            const f32x4 r = *(const f32x4*)(res + idx);
            *(f32x4*)(h + idx) = r + gv[bj][n] * acc[ai][bj][m][n];
          }
  }
};

struct EpiInproj {
  static constexpr bool PERM = true, AFTER_DRAIN = false;
  bf16_t* U; bf16_t* HYT; float* out; int l;
  DI void operator()(const f32x4 (&acc)[2][2][4][2], const pg8::Unit& u, int wr, int wc, int fr, int fq) const {
    const int row0 = u.pm * 256 + wr * 64 + fr, cw = wc * 32 + 8 * fq;
    const int pn = u.pn;
    if (pn >= 2 && pn <= 4) {
#pragma unroll
      for (int ai = 0; ai < 2; ++ai)
#pragma unroll
        for (int m = 0; m < 4; ++m)
#pragma unroll
          for (int bj = 0; bj < 2; ++bj)
#pragma unroll
            for (int n = 0; n < 2; ++n)
#pragma unroll
              for (int e = 0; e < 4; ++e) {
                const int c = pn * 256 - 512 + bj * 128 + cw + 4 * n + e, row = row0 + ai * 128 + m * 16;
                HYT[(size_t)c * MT + row] = f2bf(acc[ai][bj][m][n][e]);
              }
    } else {
      const int ub = (pn < 2 ? pn * 256 : pn * 256 - 768) + cw;
#pragma unroll
      for (int ai = 0; ai < 2; ++ai)
#pragma unroll
        for (int m = 0; m < 4; ++m)
#pragma unroll
          for (int bj = 0; bj < 2; ++bj) {
            const int row = row0 + ai * 128 + m * 16;
            const bool ok = (pn < 10) || (bj == 0 && wc == 0);
            if (ok) {
              const f32x4 v0 = acc[ai][bj][m][0], v1 = acc[ai][bj][m][1];
              u32x4 w; w.x = cvtpk(v0[0], v0[1]); w.y = cvtpk(v0[2], v0[3]); w.z = cvtpk(v1[0], v1[1]); w.w = cvtpk(v1[2], v1[3]);
              *(u32x4*)(U + (size_t)row * UW + ub + bj * 128) = w;
              if (u.pm < 32 && (pn == 1 || (pn == 6 && bj == 1))) {
                const int b = row >> 8, t = row & 255;
                const size_t off = (pn == 1 ? (bj == 0 ? OUT_SWAK : OUT_SWAV) : OUT_GQAV) + ((size_t)(b * 512 + l * 256 + t)) * 128 + cw;
                *(f32x4*)(out + off) = v0; *(f32x4*)(out + off + 4) = v1;
              }
            }
          }
    }
  }
};

struct CvItem { const float* W; bf16_t* WT; int Nsrc, K, n0, sca, scb, k0; };
DI CvItem cv_decode(CArgs& a, int v) {
  CvItem it; int kind, m, r;
  if (v < 352) { kind = 0; m = 0; r = v; } else if (v < 528) { kind = 1; m = 0; r = v - 352; } else if (v < 704) { kind = 2; m = 0; r = v - 528; } else if (v < 768) { kind = 3; m = 0; r = v - 704; }
  else if (v < 1120) { kind = 0; m = 1; r = v - 768; } else if (v < 1296) { kind = 1; m = 1; r = v - 1120; } else if (v < 1648) { kind = 0; m = 2; r = v - 1296; } else if (v < 1824) { kind = 1; m = 2; r = v - 1648; }
  else if (v < 2000) { kind = 2; m = 1; r = v - 1824; } else if (v < 2064) { kind = 3; m = 1; r = v - 2000; } else if (v < 2416) { kind = 0; m = 3; r = v - 2064; } else { kind = 1; m = 3; r = v - 2416; }
  if (kind == 0) { const int pn = r >> 4, kt = r & 15; it.W = a.in[12] + (size_t)m * 1024 * 5632; it.WT = (bf16_t*)(a.ws + WS_WFI) + (size_t)m * 5632 * 1024; it.Nsrc = 5632; it.K = 1024; it.n0 = 256 * pn; it.sca = 128 * pn; it.scb = 2816 + 128 * pn; it.k0 = 64 * kt; }
  else if (kind == 1) { const int nt = r / 44, kt = r % 44; it.W = a.in[13] + (size_t)m * 2816 * 1024; it.WT = (bf16_t*)(a.ws + WS_WFO) + (size_t)m * 1024 * 2816; it.Nsrc = 1024; it.K = 2816; it.n0 = 256 * nt; it.sca = 256 * nt; it.scb = 256 * nt + 128; it.k0 = 64 * kt; }
  else if (kind == 2) { const int nt = r >> 4, kt = r & 15; it.W = a.in[14] + (size_t)m * 1024 * NIN; it.WT = (bf16_t*)(a.ws + WS_WIN) + (size_t)m * NINP * 1024; it.Nsrc = NIN; it.K = 1024; it.n0 = 256 * nt; it.sca = 256 * nt; it.scb = 256 * nt + 128; it.k0 = 64 * kt; }
  else { const int nt = r >> 4, kt = r & 15; it.W = a.in[15] + (size_t)m * 1024 * 1024; it.WT = (bf16_t*)(a.ws + WS_WOUT) + (size_t)m * 1024 * 1024; it.Nsrc = 1024; it.K = 1024; it.n0 = 256 * nt; it.sca = 256 * nt; it.scb = 256 * nt + 128; it.k0 = 64 * kt; }
  return it;
}
#define CV_LOAD(v, it) do { const int c4_ = tid & 63, col_ = ((c4_ >> 5) ? (it).scb : (it).sca) + 4 * (c4_ & 31); _Pragma("unroll") for (int rr = 0; rr < 8; ++rr) { const int r_ = (tid >> 6) + 8 * rr; \
    v[rr] = (f32x4){0.f, 0.f, 0.f, 0.f}; if (col_ < (it).Nsrc) v[rr] = __builtin_nontemporal_load((const f32x4*)((it).W + (size_t)((it).k0 + r_) * (it).Nsrc + col_)); } } while (0)
DI void p0_convert_range(CArgs& a, unsigned char* ldsb, int tid, int lo, int hi, int j, int nj) {
  float* tile = (float*)ldsb;
  int idx = lo + j;
  if (idx >= hi) return;
  f32x4 v[8];
  CvItem it = cv_decode(a, idx);
  CV_LOAD(v, it);
  for (;;) {
    const int c4 = tid & 63;
#pragma unroll
    for (int rr = 0; rr < 8; ++rr) { const int r = (tid >> 6) + 8 * rr; float* tp = tile + r * 257 + 4 * c4; tp[0] = v[rr][0]; tp[1] = v[rr][1]; tp[2] = v[rr][2]; tp[3] = v[rr][3]; }
    __syncthreads();
    const int nxt = idx + nj;
    CvItem itn = it;
    if (nxt < hi) { itn = cv_decode(a, nxt); CV_LOAD(v, itn); }
    const int n = tid >> 1, kh = tid & 1;
#pragma unroll
    for (int q = 0; q < 4; ++q) {
      const float* sp = tile + (32 * kh + 8 * q) * 257 + n;
      u32x4 w; w.x = cvtpk(sp[0], sp[257]); w.y = cvtpk(sp[514], sp[771]); w.z = cvtpk(sp[1028], sp[1285]); w.w = cvtpk(sp[1542], sp[1799]);
      *(u32x4*)(it.WT + (size_t)(it.n0 + n) * it.K + it.k0 + 32 * kh + 8 * q) = w;
    }
    __syncthreads();
    if (nxt >= hi) break;
    idx = nxt; it = itn;
  }
}

DI void p0_modulation(CArgs& a, unsigned char* ldsb, int tid) {
  float* sc = (float*)ldsb;
  float* red = sc + 3072;
  float* modp = (float*)(a.ws + WS_MODP);
  for (int i = tid; i < 3072; i += 512) { const int g = i >> 10, k = i & 1023; const float x = g == 0 ? a.in[8][k] : a.in[7][(g - 1) * 1024 + k]; sc[i] = x / (1.f + expf(-x)); }
  __syncthreads();
  for (int item = BID(); item < 288; item += gridDim.x) {
    const int l = item / 144, rem = item % 144, nt = rem >> 2, kq = rem & 3, n0 = nt * 256, c4 = tid & 63, kg = tid >> 6;
    const int kbase = kq * 256 + kg * 32;
    const float* wp = a.in[9] + (size_t)l * 1024 * 9216 + (size_t)kbase * 9216 + n0 + 4 * c4;
    f32x4 acc0 = {0, 0, 0, 0}, acc1 = {0, 0, 0, 0}, acc2 = {0, 0, 0, 0};
#pragma unroll 8
    for (int kk = 0; kk < 32; ++kk) {
      const f32x4 w = __builtin_nontemporal_load((const f32x4*)(wp + (size_t)kk * 9216));
      const int k = kbase + kk;
      acc0 += w * sc[k]; acc1 += w * sc[1024 + k]; acc2 += w * sc[2048 + k];
    }
    float* rp = red + kg * 768 + 4 * c4;
#pragma unroll
    for (int e = 0; e < 4; ++e) { rp[e] = acc0[e]; rp[256 + e] = acc1[e]; rp[512 + e] = acc2[e]; }
    __syncthreads();
    for (int o = tid; o < 768; o += 512) {
      const int g = o >> 8, n = o & 255; float s = 0.f;
#pragma unroll
      for (int q = 0; q < 8; ++q) s += red[q * 768 + o];
      modp[(size_t)kq * 55296 + (size_t)(l * 3 + g) * 9216 + n0 + n] = s;
    }
    __syncthreads();
  }
}
DI void mod_finalize(CArgs& a, int tid) {
  const float* modp = (const float*)(a.ws + WS_MODP); float* mod = (float*)(a.ws + WS_MOD);
  for (int idx = BID() * 512 + tid; idx < 55296; idx += gridDim.x * 512) {
    const int l = idx / 27648, n = idx % 9216;
    mod[idx] = modp[idx] + modp[55296 + idx] + modp[2 * 55296 + idx] + modp[3 * 55296 + idx] + a.in[10][l * 9216 + n];
  }
}

DI void p0_filters(CArgs& a, unsigned char* ldsb, int tid) {
  float* zs = (float*)ldsb;
  float* h1 = zs + 1024;
  float* h2 = h1 + 1024;
  bf16_t* F = (bf16_t*)(a.ws + WS_FILT);
  const int w = tid >> 6, lane = tid & 63;
  for (int item = BID(); item < 160; item += gridDim.x) {
    const int l = item / 80, r = item % 80;
    const int L = r < 16 ? 256 : 1024, tb = (r < 16 ? 16 * r : 16 * (r - 16)) + 2 * w, Loff = r < 16 ? 0 : 512;
#pragma unroll
    for (int u = 0; u < 2; ++u) {
      const int t = tb + u;
      const float tt = (float)t / (float)(L - 1);
      const float wt = (6.283185307179586f / (float)L) * (float)t;
      if (lane < 33) {
        float z;
        if (lane == 0) z = tt;
        else { const int bi = (lane - 1) & 15; const float band = 1e-4f + (float)bi * ((15.f - 1e-4f) / 15.f); z = lane <= 16 ? cosf(band * wt) : -sinf(band * wt); }
        zs[(2 * w + u) * 64 + lane] = z;
      }
    }
    __syncthreads();
    { float s0 = a.in[22][l * 64 + lane], s1 = s0;
      for (int i = 0; i < 33; ++i) { const float wv = a.in[21][(l * 33 + i) * 64 + lane]; s0 += zs[(2 * w) * 64 + i] * wv; s1 += zs[(2 * w + 1) * 64 + i] * wv; }
      const float fq = a.in[26][(l * 2 + 0) * 64 + lane];
      h1[(2 * w) * 64 + lane] = sinf(fq * s0); h1[(2 * w + 1) * 64 + lane] = sinf(fq * s1); }
    __syncthreads();
    { float s0 = a.in[24][l * 64 + lane], s1 = s0;
      for (int i = 0; i < 64; ++i) { const float wv = a.in[23][(l * 64 + i) * 64 + lane]; s0 += h1[(2 * w) * 64 + i] * wv; s1 += h1[(2 * w + 1) * 64 + i] * wv; }
      const float fq = a.in[26][(l * 2 + 1) * 64 + lane];
      h2[(2 * w) * 64 + lane] = sinf(fq * s0); h2[(2 * w + 1) * 64 + lane] = sinf(fq * s1); }
    __syncthreads();
    for (int qq = 0; qq < 4; ++qq) {
      const int col0 = 4 * lane + 256 * qq;
      f32x4 s0 = {0.f, 0.f, 0.f, 0.f}, s1 = s0;
#pragma unroll 16
      for (int i = 0; i < 64; ++i) { const f32x4 wv = *(const f32x4*)(a.in[25] + (size_t)(l * 64 + i) * 1024 + col0); s0 += wv * h2[(2 * w) * 64 + i]; s1 += wv * h2[(2 * w + 1) * 64 + i]; }
      const int dir = col0 >> 9, o = (col0 >> 8) & 1;
#pragma unroll
      for (int u = 0; u < 2; ++u) {
        const int t = tb + u;
        const float tt = (float)t / (float)(L - 1);
#pragma unroll
        for (int e = 0; e < 4; ++e) {
          const int ch = (col0 & 255) + e;
          const float d0 = -4.605170185988091f / 1.5f, d1 = -4.605170185988091f / 0.3f;
          const float delta = d0 + (float)ch * ((d1 - d0) / 255.f);
          const float val = (u == 0 ? s0[e] : s1[e]) * expf(-tt * fabsf(delta));
          bf16_t* fp = F + ((size_t)((l * 2 + o) * 256 + ch)) * 2560 + Loff;
          if (dir == 0) fp[L - t] = f2bf(val);
          else { if (t == 0) fp[0] = 0; else fp[L + t] = f2bf(val); }
        }
      }
    }
    __syncthreads();
  }
}

DI const float* xrow(const float* A, const float* B, int row) { return row < MCTX ? A + (size_t)row * DM : B + (size_t)(row - MCTX) * DM; }
DI int grp_of(int row) { return row < MCTX ? 0 : 1 + ((row - MCTX) >> 10); }

constexpr int RB = 5;
DI void norm_mod_phase(const float* srcA, const float* srcB, bf16_t* xn, const float* ng, const float* mod_l, int j, int tid, const float* modp, const float* bmod) {
  const int w = tid >> 6, lane = tid & 63, stride = gridDim.x * 8;
  for (int base = BID() * 8 + w; base < MT; base += stride * RB) {
    f32x4 v[RB][4];
#pragma unroll
    for (int r = 0; r < RB; ++r) {
      const int row = base + r * stride;
      if (row < MT) { const float* x = xrow(srcA, srcB, row);
#pragma unroll
        for (int q = 0; q < 4; ++q) v[r][q] = *(const f32x4*)(x + 256 * q + 4 * lane); }
      else {
#pragma unroll
        for (int q = 0; q < 4; ++q) v[r][q] = (f32x4){0.f, 0.f, 0.f, 0.f}; }
    }
#pragma unroll
    for (int r = 0; r < RB; ++r) {
      const int row = base + r * stride;
      float ss = 0.f;
#pragma unroll
      for (int q = 0; q < 4; ++q) ss += v[r][q][0] * v[r][q][0] + v[r][q][1] * v[r][q][1] + v[r][q][2] * v[r][q][2] + v[r][q][3] * v[r][q][3];
      ss = wave_sum(ss);
      const float rstd = rsqrtf(ss * (1.f / 1024.f) + EPSF);
      if (row < MT) {
        const float* mg = mod_l + (size_t)grp_of(row) * 9216 + (3 * j) * 1024;
#pragma unroll
        for (int q = 0; q < 4; ++q) {
          const int k = 256 * q + 4 * lane;
          const f32x4 g = *(const f32x4*)(ng + k);
          f32x4 sh, sc;
          if (modp) {
            const size_t o = (size_t)grp_of(row) * 9216 + (3 * j) * 1024 + k;
            sh = *(const f32x4*)(modp + o) + *(const f32x4*)(modp + 55296 + o) + *(const f32x4*)(modp + 2 * 55296 + o) + *(const f32x4*)(modp + 3 * 55296 + o) + *(const f32x4*)(bmod + (3 * j) * 1024 + k);
            sc = *(const f32x4*)(modp + o + 1024) + *(const f32x4*)(modp + 55296 + o + 1024) + *(const f32x4*)(modp + 2 * 55296 + o + 1024) + *(const f32x4*)(modp + 3 * 55296 + o + 1024) + *(const f32x4*)(bmod + (3 * j) * 1024 + 1024 + k);
          } else { sh = *(const f32x4*)(mg + k); sc = *(const f32x4*)(mg + 1024 + k); }
          const f32x4 y = (v[r][q] * rstd * g) * (sc + 1.f) + sh;
          u32x2 o; o.x = cvtpk(y[0], y[1]); o.y = cvtpk(y[2], y[3]);
          *(u32x2*)(xn + (size_t)row * DM + k) = o;
        }
      }
    }
  }
}

DI void final_norm_phase(const float* h, float* out, const float* fg, int tid) {
  const int w = tid >> 6, lane = tid & 63, stride = gridDim.x * 8;
  for (int base = BID() * 8 + w; base < MT; base += stride * RB) {
    f32x4 v[RB][4];
#pragma unroll
    for (int r = 0; r < RB; ++r) {
      const int row = base + r * stride;
      if (row < MT) {
#pragma unroll
        for (int q = 0; q < 4; ++q) v[r][q] = *(const f32x4*)(h + (size_t)row * DM + 256 * q + 4 * lane); }
      else {
#pragma unroll
        for (int q = 0; q < 4; ++q) v[r][q] = (f32x4){0.f, 0.f, 0.f, 0.f}; }
    }
#pragma unroll
    for (int r = 0; r < RB; ++r) {
      const int row = base + r * stride;
      float ss = 0.f;
#pragma unroll
      for (int q = 0; q < 4; ++q) ss += v[r][q][0] * v[r][q][0] + v[r][q][1] * v[r][q][1] + v[r][q][2] * v[r][q][2] + v[r][q][3] * v[r][q][3];
      ss = wave_sum(ss);
      const float rstd = rsqrtf(ss * (1.f / 1024.f) + EPSF);
      if (row < MT) {
#pragma unroll
        for (int q = 0; q < 4; ++q) { const int k = 256 * q + 4 * lane; *(f32x4*)(out + (size_t)row * DM + k) = v[r][q] * rstd * *(const f32x4*)(fg + k); }
      }
    }
  }
}

DI int pp_base(int s) { return (s < 4) ? U_QA + 64 * s : (s < 6) ? U_KA + 64 * (s - 4) : (s < 10) ? U_QC + 64 * (s - 6) : U_KC + 64 * (s - 10); }
DI void post_proj_phase(bf16_t* U, bf16_t* Ud, float* out, const float* qkg, int l, int tid) {
  const int w = tid >> 6, lane = tid & 63, stride = gridDim.x * 8;
  const float g0 = qkg[lane], g1 = qkg[64 + lane];
  for (int base = BID() * 8 + w; base < MT; base += stride * RB) {
    float xv[RB][12];
#pragma unroll
    for (int r = 0; r < RB; ++r) {
      const int row = base + r * stride;
#pragma unroll
      for (int s = 0; s < 12; ++s) xv[r][s] = row < MT ? bf2f(U[(size_t)row * UW + pp_base(s) + lane]) : 0.f;
    }
#pragma unroll
    for (int r = 0; r < RB; ++r) {
      const int row = base + r * stride;
      const bool lat = row >= MCTX;
      float cs = 1.f, sn = 0.f;
      if (lat) {
        const int t = (row - MCTX) & 1023, i = lane & 31, f = i & 15;
        const float inv = exp2f(-(float)f * (13.287712379549449f / 16.f));
        const float ang = (float)(i < 16 ? (t >> 6) : (t & 63)) * inv;
        sincosf(ang, &sn, &cs);
      }
#pragma unroll
      for (int s = 0; s < 12; ++s) {
        const bool isq = (s < 4) || (s >= 6 && s < 10), nrm = s >= 6;
        float x = xv[r][s];
        if (nrm) { const float ss = wave_sum(x * x); x = x * rsqrtf(ss * (1.f / 64.f) + EPSF) * (s < 10 ? g0 : g1); }
        if (lat) { const float p = __shfl_xor(x, 32, 64); x = lane < 32 ? x * cs - p * sn : x * cs + p * sn; }
        if (row < MT) {
          if (s >= 10 && !lat) { const int b = row >> 8, t = row & 255; out[OUT_GQAK + ((size_t)(b * 512 + l * 256 + t)) * 128 + (s - 10) * 64 + lane] = x; }
          if (isq) x *= QSCALE;
          if (Ud) Ud[(size_t)row * UW + pp_base(s) + lane] = f2bf(x);
        }
      }
    }
  }
}

struct KVRegs { u32x4 k, v; };
constexpr int KROW = 72;
constexpr int KVBUF = 64 * KROW * 2;

DI KVRegs attn_load(const bf16_t* __restrict__ U, int R0, int kcol, int vcol, int k0start, int nt0, const float* __restrict__ ck, const float* __restrict__ cv, int ti, int tid) {
  KVRegs r; const int key = tid >> 3, ds = tid & 7;
  if (ti < nt0) {
    const bf16_t* p = U + (size_t)(R0 + k0start + 64 * ti + key) * UW;
    r.k = *(const u32x4*)(p + kcol + 8 * ds); r.v = *(const u32x4*)(p + vcol + 8 * ds);
  } else {
    const size_t off = (size_t)(64 * (ti - nt0) + key) * 128 + 8 * ds;
    const f32x4 a0 = *(const f32x4*)(ck + off), a1 = *(const f32x4*)(ck + off + 4), b0 = *(const f32x4*)(cv + off), b1 = *(const f32x4*)(cv + off + 4);
    r.k.x = cvtpk(a0[0], a0[1]); r.k.y = cvtpk(a0[2], a0[3]); r.k.z = cvtpk(a1[0], a1[1]); r.k.w = cvtpk(a1[2], a1[3]);
    r.v.x = cvtpk(b0[0], b0[1]); r.v.y = cvtpk(b0[2], b0[3]); r.v.z = cvtpk(b1[0], b1[1]); r.v.w = cvtpk(b1[2], b1[3]);
  }
  return r;
}
DI void attn_write(unsigned char* kb, unsigned char* vb, const KVRegs& r, int tid) {
  const int key = tid >> 3, ds = tid & 7;
  *(u32x4*)(kb + (key * KROW + 8 * ds) * 2) = r.k;
  bf16_t* vt = (bf16_t*)vb + (8 * ds) * KROW + key;
  vt[0] = (bf16_t)(r.v.x & 0xffff); vt[KROW] = (bf16_t)(r.v.x >> 16); vt[2 * KROW] = (bf16_t)(r.v.y & 0xffff); vt[3 * KROW] = (bf16_t)(r.v.y >> 16);
  vt[4 * KROW] = (bf16_t)(r.v.z & 0xffff); vt[5 * KROW] = (bf16_t)(r.v.z >> 16); vt[6 * KROW] = (bf16_t)(r.v.w & 0xffff); vt[7 * KROW] = (bf16_t)(r.v.w >> 16);
}

DI void attn_unit(CArgs& a, int l, int uidx, unsigned char* ldsb, int tid) {
  const bf16_t* U = (const bf16_t*)(a.ws + WS_ACT);
  bf16_t* O = (bf16_t*)(a.ws + WS_O);
  int type, b, kvh, qb;
  if (uidx < 64) { type = uidx < 32 ? 3 : 2; const int j = uidx & 31; b = j >> 4; kvh = (j >> 3) & 1; qb = j & 7; }
  else { type = uidx < 192 ? 0 : 1; const int j = (uidx - 64) & 127; b = j >> 2; kvh = (j >> 1) & 1; qb = j & 1; }
  const bool lat = type >= 2, isA = (type == 0 || type == 2);
  const int R0 = lat ? MCTX + b * 1024 : b * 256;
  const int w = tid >> 6, lane = tid & 63, hh = lane >> 5, l31 = lane & 31, g = w >> 2, head = 2 * kvh + g;
  const int qcol = (isA ? U_QA : U_QC) + head * 64, kcol = (isA ? U_KA : U_KC) + kvh * 64, vcol = (isA ? U_VA : U_VC) + kvh * 64;
  int k0start = 0, nk0 = lat ? 1024 : 256;
  if (type == 2) { const int lo = qb > 0 ? (qb - 1) * 128 : 0, hi = qb < 7 ? (qb + 2) * 128 : 1024; k0start = lo; nk0 = hi - lo; }
  const int nt0 = nk0 >> 6, nt = nt0 + (lat ? 8 : 0);
  const float* ck = nullptr; const float* cv = nullptr;
  if (lat) { const size_t co = ((size_t)((b * 2 + l) * 512)) * 128 + kvh * 64; ck = a.in[isA ? 2 : 4] + co; cv = a.in[isA ? 3 : 5] + co; }
  const int qrow = R0 + qb * 128 + (w & 3) * 32 + l31;
  const int qpos = qb * 128 + (w & 3) * 32 + l31;
  bf16x8 qf[4];
#pragma unroll
  for (int ks = 0; ks < 4; ++ks) qf[ks] = *(const bf16x8*)(U + (size_t)qrow * UW + qcol + 16 * ks + 8 * hh);
  float m_run = -1e30f, l_run = 0.f;
  if (isA) { m_run = a.in[17][l * 4 + head] * 1.4426950408889634f; l_run = hh == 0 ? 1.f : 0.f; }
  f32x16 o0, o1;
#pragma unroll
  for (int i = 0; i < 16; ++i) { o0[i] = 0.f; o1[i] = 0.f; }
  KVRegs regs = attn_load(U, R0, kcol, vcol, k0start, nt0, ck, cv, 0, tid);
  attn_write(ldsb, ldsb + KVBUF, regs, tid);
  __syncthreads();
  for (int ti = 0; ti < nt; ++ti) {
    const int cur = ti & 1;
    if (ti + 1 < nt) regs = attn_load(U, R0, kcol, vcol, k0start, nt0, ck, cv, ti + 1, tid);
    const unsigned char* kb = cur ? ldsb + 2 * KVBUF : ldsb;
    const unsigned char* vb = kb + KVBUF;
    const bool domask = (type == 2) && (ti < nt0);
#pragma unroll
    for (int sub = 0; sub < 2; ++sub) {
      f32x16 s;
#pragma unroll
      for (int i = 0; i < 16; ++i) s[i] = 0.f;
#pragma unroll
      for (int ks = 0; ks < 4; ++ks) {
        const bf16x8 ka = *(const bf16x8*)(kb + ((32 * sub + l31) * KROW + 16 * ks + 8 * hh) * 2);
        s = __builtin_amdgcn_mfma_f32_32x32x16_bf16(ka, qf[ks], s, 0, 0, 0);
      }
      if (domask) {
        const int kp0 = k0start + 64 * ti + 32 * sub;
#pragma unroll
        for (int i = 0; i < 16; ++i) { const int d = qpos - (kp0 + crow(i, hh)); if (d > 128 || d < -128) s[i] = -1e30f; }
      }
      float mt = s[0];
#pragma unroll
      for (int i = 1; i < 16; ++i) mt = fmaxf(mt, s[i]);
      mt = fmaxf(mt, __shfl_xor(mt, 32, 64));
      const float mn = fmaxf(m_run, mt);
      const float alpha = __builtin_amdgcn_exp2f(m_run - mn);
      m_run = mn;
      float ps = 0.f;
#pragma unroll
      for (int i = 0; i < 16; ++i) { s[i] = __builtin_amdgcn_exp2f(s[i] - mn); ps += s[i]; }
      l_run = l_run * alpha + ps;
#pragma unroll
      for (int i = 0; i < 16; ++i) { o0[i] *= alpha; o1[i] *= alpha; }
#pragma unroll
      for (int st = 0; st < 2; ++st) {
        u32x4 pw; pw.x = cvtpk(s[8 * st], s[8 * st + 1]); pw.y = cvtpk(s[8 * st + 2], s[8 * st + 3]); pw.z = cvtpk(s[8 * st + 4], s[8 * st + 5]); pw.w = cvtpk(s[8 * st + 6], s[8 * st + 7]);
        const bf16x8 pf = __builtin_bit_cast(bf16x8, pw);
        const int kofs = 32 * sub + 16 * st + 4 * hh;
        {
          const u32x2 lo = *(const u32x2*)(vb + (l31 * KROW + kofs) * 2), hi = *(const u32x2*)(vb + (l31 * KROW + kofs + 8) * 2);
          u32x4 vw; vw.x = lo.x; vw.y = lo.y; vw.z = hi.x; vw.w = hi.y;
          o0 = __builtin_amdgcn_mfma_f32_32x32x16_bf16(__builtin_bit_cast(bf16x8, vw), pf, o0, 0, 0, 0);
        }
        {
          const u32x2 lo = *(const u32x2*)(vb + ((32 + l31) * KROW + kofs) * 2), hi = *(const u32x2*)(vb + ((32 + l31) * KROW + kofs + 8) * 2);
          u32x4 vw; vw.x = lo.x; vw.y = lo.y; vw.z = hi.x; vw.w = hi.y;
          o1 = __builtin_amdgcn_mfma_f32_32x32x16_bf16(__builtin_bit_cast(bf16x8, vw), pf, o1, 0, 0, 0);
        }
      }
    }
    if (ti + 1 < nt) { unsigned char* nb = cur ? ldsb : ldsb + 2 * KVBUF; attn_write(nb, nb + KVBUF, regs, tid); }
    __syncthreads();
  }
  const float lt = l_run + __shfl_xor(l_run, 32, 64);
  const float inv = 1.f / lt;
  bf16_t* ost = (bf16_t*)(ldsb + w * (32 * KROW * 2));
#pragma unroll
  for (int gq = 0; gq < 4; ++gq) {
    u32x2 p0, p1;
    p0.x = cvtpk(o0[4 * gq] * inv, o0[4 * gq + 1] * inv); p0.y = cvtpk(o0[4 * gq + 2] * inv, o0[4 * gq + 3] * inv);
    p1.x = cvtpk(o1[4 * gq] * inv, o1[4 * gq + 1] * inv); p1.y = cvtpk(o1[4 * gq + 2] * inv, o1[4 * gq + 3] * inv);
    *(u32x2*)(ost + l31 * KROW + 8 * gq + 4 * hh) = p0;
    *(u32x2*)(ost + l31 * KROW + 32 + 8 * gq + 4 * hh) = p1;
  }
  __syncthreads();
  {
    const int q = lane >> 1, half = lane & 1;
    const int orow = R0 + qb * 128 + (w & 3) * 32 + q;
    bf16_t* op = O + (size_t)orow * 768 + (isA ? 0 : 256) + head * 64 + 32 * half;
    const bf16_t* sp = ost + q * KROW + 32 * half;
#pragma unroll
    for (int e = 0; e < 4; ++e) *(u32x4*)(op + 8 * e) = *(const u32x4*)(sp + 8 * e);
  }
  __syncthreads();
}

DI void hyena_unit(CArgs& a, int l, int conv, int c, int type, unsigned char* ldsb, int tid) {
  const int L = type ? 1024 : 256, nseq = type ? 2 : 32, tokbase = type ? MCTX : 0, L2 = 2 * L, L3 = 3 * L, CPS = L2 + 8;
  bf16_t* cp = (bf16_t*)ldsb;
  bf16_t* up = (bf16_t*)(ldsb + 33024);
  bf16_t* gt = (bf16_t*)(ldsb + 33024 + 49152);
  float* red = (float*)(ldsb + 33024 + 49152 + 16384);
  const bf16_t* HYT = (const bf16_t*)(a.ws + WS_HYT);
  bf16_t* Y1T = (bf16_t*)(a.ws + WS_Y1T);
  bf16_t* OBT = (bf16_t*)(a.ws + WS_OBT);
  const bf16_t* Kr = (const bf16_t*)(a.ws + WS_FILT) + ((size_t)((l * 2 + conv) * 256 + c)) * 2560 + (type ? 512 : 0);
  const float* cw = a.in[19] + l * 3 * 768; const float* cb = a.in[20] + l * 768;
  const int gc = (conv == 0 ? 256 : 512) + c;
  const float vw0 = cw[c], vw1 = cw[768 + c], vw2 = cw[1536 + c], vb = cb[c];
  const float gw0 = cw[gc], gw1 = cw[768 + gc], gw2 = cw[1536 + gc], gb = cb[gc];
  const int ntok = nseq * L, nch = L2 >> 3, nck = ntok >> 3;
  bf16_t* rawv = (bf16_t*)red;
  bf16_t* rawg = rawv + ntok + 16;
  {
    if (tid < nch) *(u32x4*)(cp + 8 * tid) = *(const u32x4*)(Kr + 8 * tid);
    const bf16_t* sg = HYT + (size_t)gc * MT + tokbase;
    const bf16_t* sv = (conv == 0 ? HYT : (const bf16_t*)Y1T) + (size_t)c * MT + tokbase;
    for (int ck = tid; ck < nck; ck += 512) {
      *(u32x4*)(rawg + 8 + 8 * ck) = *(const u32x4*)(sg + 8 * ck);
      *(u32x4*)(rawv + 8 + 8 * ck) = *(const u32x4*)(sv + 8 * ck);
    }
  }
  __syncthreads();
  if (tid < nch) {
    const u32x4 lo = *(const u32x4*)(cp + 8 * tid), hi = *(const u32x4*)(cp + 8 * tid + 8);
    const unsigned wv[8] = {lo.x, lo.y, lo.z, lo.w, hi.x, hi.y, hi.z, hi.w};
#pragma unroll
    for (int r = 1; r < 8; ++r) {
      u32x4 o;
      if ((r & 1) == 0) { o.x = wv[r / 2]; o.y = wv[r / 2 + 1]; o.z = wv[r / 2 + 2]; o.w = wv[r / 2 + 3]; }
      else { const int b = (r - 1) / 2;
        o.x = (wv[b] >> 16) | (wv[b + 1] << 16); o.y = (wv[b + 1] >> 16) | (wv[b + 2] << 16); o.z = (wv[b + 2] >> 16) | (wv[b + 3] << 16); o.w = (wv[b + 3] >> 16) | (wv[b + 4] << 16); }
      *(u32x4*)(cp + r * CPS + 8 * tid) = o;
    }
  }
  for (int ck = tid; ck < nck; ck += 512) {
    const int t0 = 8 * ck, s = t0 / L, p0 = t0 - s * L;
    const bool first = p0 == 0, last = p0 + 8 == L;
    float gx[10], vx[10];
    { const u32x4 m = *(const u32x4*)(rawg + 8 + t0);
      gx[0] = first ? 0.f : bf2f(rawg[8 + t0 - 1]); gx[9] = last ? 0.f : bf2f(rawg[8 + t0 + 8]);
      gx[1] = bflo(m.x); gx[2] = bfhi(m.x); gx[3] = bflo(m.y); gx[4] = bfhi(m.y); gx[5] = bflo(m.z); gx[6] = bfhi(m.z); gx[7] = bflo(m.w); gx[8] = bfhi(m.w); }
    u32x4 go, uo;
    { float y[8];
#pragma unroll
      for (int e = 0; e < 8; ++e) y[e] = gw0 * gx[e] + gw1 * gx[e + 1] + gw2 * gx[e + 2] + gb;
      go.x = cvtpk(y[0], y[1]); go.y = cvtpk(y[2], y[3]); go.z = cvtpk(y[4], y[5]); go.w = cvtpk(y[6], y[7]); }
    const u32x4 mv = *(const u32x4*)(rawv + 8 + t0);
    if (conv == 0) {
      vx[0] = first ? 0.f : bf2f(rawv[8 + t0 - 1]); vx[9] = last ? 0.f : bf2f(rawv[8 + t0 + 8]);
      vx[1] = bflo(mv.x); vx[2] = bfhi(mv.x); vx[3] = bflo(mv.y); vx[4] = bfhi(mv.y); vx[5] = bflo(mv.z); vx[6] = bfhi(mv.z); vx[7] = bflo(mv.w); vx[8] = bfhi(mv.w);
      float y[8];
#pragma unroll
      for (int e = 0; e < 8; ++e) y[e] = vw0 * vx[e] + vw1 * vx[e + 1] + vw2 * vx[e + 2] + vb;
      uo.x = cvtpk(y[0], y[1]); uo.y = cvtpk(y[2], y[3]); uo.z = cvtpk(y[4], y[5]); uo.w = cvtpk(y[6], y[7]);
    } else uo = mv;
    *(u32x4*)(gt + t0) = go;
    bf16_t* ub = up + s * L3 + p0;
    const u32x4 zz = {0u, 0u, 0u, 0u};
    *(u32x4*)(ub) = zz; *(u32x4*)(ub + L) = uo; *(u32x4*)(ub + L2) = zz;
  }
  __syncthreads();
  const int w = tid >> 6, lane = tid & 63, hh = lane >> 5, i = lane & 31, r = (8 - (i & 7)) & 7;
  int aa, sq, mlo, mhi;
  if (type == 0) { aa = i & 7; sq = 4 * w + (i >> 3); mlo = -7; mhi = 7; }
  else { aa = i; sq = w >> 2; mlo = -31 + 16 * (w & 3); mhi = mlo + 15 > 31 ? 31 : mlo + 15; }
  const bf16_t* useq = up + sq * L3;
  const bf16_t* cpr = cp + r * CPS;
  f32x16 acc;
#pragma unroll
  for (int q = 0; q < 16; ++q) acc[q] = 0.f;
  for (int m = mlo; m <= mhi; ++m) {
#pragma unroll
    for (int ks = 0; ks < 2; ++ks) {
      const int xi0 = L + 16 * ks + 8 * hh - i - 32 * m;
      const bf16x8 A = *(const bf16x8*)(cpr + (xi0 - r));
      const bf16x8 B = *(const bf16x8*)(useq + 32 * (aa - m) + 16 * ks + 8 * hh + L);
      acc = __builtin_amdgcn_mfma_f32_32x32x16_bf16(A, B, acc, 0, 0, 0);
    }
  }
  if (type == 1) {
#pragma unroll
    for (int q = 0; q < 16; ++q) red[w * 1024 + q * 64 + lane] = acc[q];
    __syncthreads();
    if ((w & 3) == 0) {
#pragma unroll
      for (int q = 0; q < 16; ++q) acc[q] += red[(w + 1) * 1024 + q * 64 + lane] + red[(w + 2) * 1024 + q * 64 + lane] + red[(w + 3) * 1024 + q * 64 + lane];
    }
  }
  if (type == 0 || (w & 3) == 0) {
    const float bias = a.in[27][(l * 2 + conv) * 256 + c];
    bf16_t* dst = (conv == 0 ? Y1T : OBT) + (size_t)c * MT + tokbase + sq * L;
#pragma unroll
    for (int gq = 0; gq < 4; ++gq) {
      float y[4];
#pragma unroll
      for (int e = 0; e < 4; ++e) {
        const int t = 32 * aa + 8 * gq + 4 * hh + e;
        y[e] = (acc[4 * gq + e] + bias * bf2f(useq[L + t])) * bf2f(gt[sq * L + t]);
      }
      u32x2 o; o.x = cvtpk(y[0], y[1]); o.y = cvtpk(y[2], y[3]);
      *(u32x2*)(dst + 32 * aa + 8 * gq + 4 * hh) = o;
    }
  }
  __syncthreads();
}

struct GlaLds { float *qs, *ks, *vs, *gls, *Ws, *bs, *gb, *A1, *A2; };
DI GlaLds gla_lds(unsigned char* ldsb) {
  GlaLds g; float* p = (float*)ldsb;
  g.qs = p; p += 64 * 33; g.ks = p; p += 64 * 33; g.vs = p; p += 64 * 65; g.gls = p; p += 64 * 32; g.Ws = p; p += 1024; g.bs = p; p += 64;
  g.gb = p; p += 2 * 64 * 33; g.A1 = p; p += 64 * 65; g.A2 = p; p += 64 * 65; return g;
}
DI int gla_row0(int seq, int cidx) { return (seq < 32 ? seq * 256 : MCTX + (seq - 32) * 1024) + 64 * cidx; }
DI int gla_gc(int seq, int n) { return (seq < 32 ? 4 * seq : 128 + 16 * (seq - 32)) + n; }

DI void gla_prep(CArgs& a, int l, int seq, int h, int cidx, const GlaLds& G, int tid) {
  const bf16_t* U = (const bf16_t*)(a.ws + WS_ACT);
  const int R0 = gla_row0(seq, cidx);
  { const int i = tid >> 3, d4 = (tid & 7) * 4; const bf16_t* rp = U + (size_t)(R0 + i) * UW;
    const u32x2 qv = *(const u32x2*)(rp + U_QD + h * 32 + d4), kv = *(const u32x2*)(rp + U_KD + h * 32 + d4);
    float* qd = G.qs + i * 33 + d4; qd[0] = bflo(qv.x); qd[1] = bfhi(qv.x); qd[2] = bflo(qv.y); qd[3] = bfhi(qv.y);
    float* kd = G.ks + i * 33 + d4; kd[0] = bflo(kv.x); kd[1] = bfhi(kv.x); kd[2] = bflo(kv.y); kd[3] = bfhi(kv.y);
    const int v8 = (tid & 7) * 8; const u32x4 vv = *(const u32x4*)(rp + U_VD + h * 64 + v8);
    float* vd = G.vs + i * 65 + v8; vd[0] = bflo(vv.x); vd[1] = bfhi(vv.x); vd[2] = bflo(vv.y); vd[3] = bfhi(vv.y); vd[4] = bflo(vv.z); vd[5] = bfhi(vv.z); vd[6] = bflo(vv.w); vd[7] = bfhi(vv.w);
    if (tid < 256) { const int i2 = tid >> 2, c8 = (tid & 3) * 8; const u32x4 gv = *(const u32x4*)(U + (size_t)(R0 + i2) * UW + U_GD + c8);
      float* gd = G.gls + i2 * 32 + c8; gd[0] = bflo(gv.x); gd[1] = bfhi(gv.x); gd[2] = bflo(gv.y); gd[3] = bfhi(gv.y); gd[4] = bflo(gv.z); gd[5] = bfhi(gv.z); gd[6] = bflo(gv.w); gd[7] = bfhi(gv.w); }
  }
  for (int e = tid; e < 1024; e += 512) { const int z = e >> 9, r = (e >> 5) & 15, d = e & 31; G.Ws[e] = a.in[28][(size_t)((l * 2 + z) * 16 + r) * 128 + h * 32 + d]; }
  if (tid < 64) G.bs[tid] = a.in[29][(l * 2 + (tid >> 5)) * 128 + h * 32 + (tid & 31)];
  for (int e = tid; e < 64 * 65; e += 512) { G.A1[e] = 0.f; G.A2[e] = 0.f; }
  __syncthreads();
#pragma unroll
  for (int e = 0; e < 8; ++e) {
    const int idx = tid * 8 + e, z = idx >> 11, i = (idx >> 5) & 63, d = idx & 31;
    float s = G.bs[z * 32 + d];
#pragma unroll
    for (int r = 0; r < 16; ++r) s += G.gls[i * 32 + z * 16 + r] * G.Ws[z * 512 + r * 32 + d];
    const float ls = fminf(s, 0.f) - log1pf(expf(-fabsf(s)));
    G.gb[z * 2112 + i * 33 + d] = ls * (1.f / 16.f);
  }
  __syncthreads();
  {
    const int w = tid >> 6, lane = tid & 63;
#pragma unroll
    for (int cc = 0; cc < 8; ++cc) {
      const int col = 8 * w + cc, z = col >> 5, d = col & 31, i = z == 0 ? lane : 63 - lane;
      float x = G.gb[z * 2112 + i * 33 + d];
#pragma unroll
      for (int o = 1; o < 64; o <<= 1) { const float y = __shfl_up(x, o, 64); if (lane >= o) x += y; }
      G.gb[z * 2112 + i * 33 + d] = x;
    }
  }
  __syncthreads();
}

constexpr float GLA_QS = 0.17677669529663687f;

DI void gla_a_unit(CArgs& a, int l, int uidx, unsigned char* ldsb, int tid) {
  int seq, h, cidx, nc;
  if (uidx < 512) { seq = uidx >> 4; h = (uidx >> 2) & 3; cidx = uidx & 3; nc = 4; } else { const int j = uidx - 512; seq = 32 + (j >> 6); h = (j >> 4) & 3; cidx = j & 15; nc = 16; }
  const GlaLds G = gla_lds(ldsb);
  gla_prep(a, l, seq, h, cidx, G, tid);
  const int w = tid >> 6, lane = tid & 63, hh = lane >> 5, l31 = lane & 31;
  const int R0 = gla_row0(seq, cidx);
  if (w < 6) {
    const int dir = w / 3, which = w % 3;
    const int ib = dir == 0 ? (which > 0) : (which == 2), jb = dir == 0 ? (which == 2) : (which > 0);
    const float* bz = G.gb + dir * 2112;
    f32x16 acc;
#pragma unroll
    for (int q = 0; q < 16; ++q) acc[q] = 0.f;
    const int ii = 32 * ib + l31, jj = 32 * jb + l31;
#pragma unroll 4
    for (int kk = 0; kk < 16; ++kk) {
      const int d = 2 * kk + hh;
      const float av = G.qs[ii * 33 + d] * __expf(bz[ii * 33 + d]) * GLA_QS;
      const float bv = G.ks[jj * 33 + d] * __expf(-bz[jj * 33 + d]);
      acc = __builtin_amdgcn_mfma_f32_32x32x2f32(av, bv, acc, 0, 0, 0);
    }
    float* Az = dir == 0 ? G.A1 : G.A2;
#pragma unroll
    for (int q = 0; q < 16; ++q) {
      const int i2 = 32 * ib + crow(q, hh);
      const bool keep = dir == 0 ? (jj <= i2) : (jj >= i2);
      Az[i2 * 65 + jj] = keep ? acc[q] : 0.f;
    }
  }
  __syncthreads();
  if (w < 4) {
    const int ib = w >> 1, vb = w & 1, ii = 32 * ib + l31;
    f32x16 acc;
#pragma unroll
    for (int q = 0; q < 16; ++q) acc[q] = 0.f;
#pragma unroll 4
    for (int kk = 0; kk < 32; ++kk) {
      const int j = 2 * kk + hh;
      const float av = G.A1[ii * 65 + j] + G.A2[ii * 65 + j];
      const float bv = G.vs[j * 65 + 32 * vb + l31];
      acc = __builtin_amdgcn_mfma_f32_32x32x2f32(av, bv, acc, 0, 0, 0);
    }
    float* od = (float*)(a.ws + WS_OD);
#pragma unroll
    for (int q = 0; q < 16; ++q) od[(size_t)(R0 + 32 * ib + crow(q, hh)) * 256 + h * 64 + 32 * vb + l31] = acc[q];
  } else {
    const int dir = (w - 4) >> 1, vb = w & 1;
    const float* bz = G.gb + dir * 2112;
    const float blast = dir == 0 ? bz[63 * 33 + l31] : bz[l31];
    f32x16 acc;
#pragma unroll
    for (int q = 0; q < 16; ++q) acc[q] = 0.f;
#pragma unroll 4
    for (int kk = 0; kk < 32; ++kk) {
      const int j = 2 * kk + hh;
      const float av = G.ks[j * 33 + l31] * __expf(blast - bz[j * 33 + l31]);
      const float bv = G.vs[j * 65 + 32 * vb + l31];
      acc = __builtin_amdgcn_mfma_f32_32x32x2f32(av, bv, acc, 0, 0, 0);
    }
    const int n = dir == 0 ? cidx : nc - 1 - cidx;
    const size_t gi = (size_t)(gla_gc(seq, n) * 4 + h) * 2 + dir;
    float* glc = (float*)(a.ws + WS_GLC) + gi * 2048;
#pragma unroll
    for (int q = 0; q < 16; ++q) glc[crow(q, hh) * 64 + 32 * vb + l31] = acc[q];
    if (vb == 0 && hh == 0) ((float*)(a.ws + WS_GLD))[gi * 32 + l31] = __expf(blast);
  }
  __syncthreads();
}

DI void gla_b_unit(CArgs& a, int l, int uidx, unsigned char* ldsb, int tid) {
  int seq, h, cidx, nc;
  if (uidx < 512) { seq = uidx >> 4; h = (uidx >> 2) & 3; cidx = uidx & 3; nc = 4; } else { const int j = uidx - 512; seq = 32 + (j >> 6); h = (j >> 4) & 3; cidx = j & 15; nc = 16; }
  const GlaLds G = gla_lds(ldsb);
  gla_prep(a, l, seq, h, cidx, G, tid);
  float* Ss = G.A1;
  const int w = tid >> 6, lane = tid & 63, hh = lane >> 5, l31 = lane & 31;
  const int R0 = gla_row0(seq, cidx);
  {
    const int dir = tid >> 8, e = tid & 255, d = e >> 3, v0 = (e & 7) * 8;
    float S[8];
    if (seq >= 32) { const float* sp = a.in[6] + ((size_t)((((seq - 32) * 2 + l) * 2 + dir) * 4 + h)) * 2048 + d * 64 + v0;
#pragma unroll
      for (int j = 0; j < 8; ++j) S[j] = sp[j]; }
    else {
#pragma unroll
      for (int j = 0; j < 8; ++j) S[j] = 0.f; }
    const int npos = dir == 0 ? cidx : nc - 1 - cidx;
    const float* glc = (const float*)(a.ws + WS_GLC); const float* gld = (const float*)(a.ws + WS_GLD);
    for (int n = 0; n < npos; n += 4) {
      float dec[4]; f32x4 c0[4], c1[4];
#pragma unroll
      for (int u = 0; u < 4; ++u) {
        dec[u] = 1.f; c0[u] = (f32x4){0.f, 0.f, 0.f, 0.f}; c1[u] = c0[u];
        if (n + u < npos) {
          const size_t gi = (size_t)(gla_gc(seq, n + u) * 4 + h) * 2 + dir;
          dec[u] = gld[gi * 32 + d]; c0[u] = *(const f32x4*)(glc + gi * 2048 + d * 64 + v0); c1[u] = *(const f32x4*)(glc + gi * 2048 + d * 64 + v0 + 4);
        }
      }
#pragma unroll
      for (int u = 0; u < 4; ++u) {
#pragma unroll
        for (int j = 0; j < 4; ++j) { S[j] = dec[u] * S[j] + c0[u][j]; S[4 + j] = dec[u] * S[4 + j] + c1[u][j]; }
      }
    }
#pragma unroll
    for (int j = 0; j < 8; ++j) Ss[dir * 2080 + d * 65 + v0 + j] = S[j];
    if (seq < 32 && npos == nc - 1) {
      const size_t gi = (size_t)(gla_gc(seq, npos) * 4 + h) * 2 + dir;
      const float dec = gld[gi * 32 + d];
      float* op = a.out + OUT_STATE + ((size_t)(((seq * 2 + l) * 2 + dir) * 4 + h)) * 2048 + d * 64 + v0;
#pragma unroll
      for (int j = 0; j < 8; ++j) op[j] = dec * S[j] + glc[gi * 2048 + d * 64 + v0 + j];
    }
  }
  __syncthreads();
  if (w < 4) {
    const int ib = w >> 1, vb = w & 1, ii = 32 * ib + l31;
    f32x16 acc;
#pragma unroll
    for (int q = 0; q < 16; ++q) acc[q] = 0.f;
#pragma unroll
    for (int dir = 0; dir < 2; ++dir) {
      const float* bz = G.gb + dir * 2112;
#pragma unroll 4
      for (int kk = 0; kk < 16; ++kk) {
        const int d = 2 * kk + hh;
        const float av = G.qs[ii * 33 + d] * __expf(bz[ii * 33 + d]) * GLA_QS;
        const float bv = Ss[dir * 2080 + d * 65 + 32 * vb + l31];
        acc = __builtin_amdgcn_mfma_f32_32x32x2f32(av, bv, acc, 0, 0, 0);
      }
    }
    const float* od = (const float*)(a.ws + WS_OD);
    bf16_t* O = (bf16_t*)(a.ws + WS_O);
#pragma unroll
    for (int q = 0; q < 16; ++q) {
      const int row = R0 + 32 * ib + crow(q, hh);
      O[(size_t)row * 768 + 512 + h * 64 + 32 * vb + l31] = f2bf(acc[q] + od[(size_t)row * 256 + h * 64 + 32 * vb + l31]);
    }
  }
  __syncthreads();
}

DI void merge_phase(CArgs& a, int l, unsigned char* ldsb, int tid) {
  bf16_t* obs = (bf16_t*)ldsb;
  const bf16_t* O = (const bf16_t*)(a.ws + WS_O); const bf16_t* OBT = (const bf16_t*)(a.ws + WS_OBT); const bf16_t* U = (const bf16_t*)(a.ws + WS_ACT);
  bf16_t* cat = (bf16_t*)(a.ws + WS_XN);
  const float* mg = a.in[16] + l * 1024;
  const int w = tid >> 6, lane = tid & 63;
  for (int tile = BID(); tile < MT / 32; tile += gridDim.x) {
    const int t0 = tile * 32;
    { const int c = tid >> 1, half = tid & 1;
      const u32x4 x0 = *(const u32x4*)(OBT + (size_t)c * MT + t0 + 16 * half), x1 = *(const u32x4*)(OBT + (size_t)c * MT + t0 + 16 * half + 8);
      bf16_t* d = obs + (16 * half) * 264 + c;
      d[0] = (bf16_t)(x0.x & 0xffff); d[264] = (bf16_t)(x0.x >> 16); d[2 * 264] = (bf16_t)(x0.y & 0xffff); d[3 * 264] = (bf16_t)(x0.y >> 16);
      d[4 * 264] = (bf16_t)(x0.z & 0xffff); d[5 * 264] = (bf16_t)(x0.z >> 16); d[6 * 264] = (bf16_t)(x0.w & 0xffff); d[7 * 264] = (bf16_t)(x0.w >> 16);
      d[8 * 264] = (bf16_t)(x1.x & 0xffff); d[9 * 264] = (bf16_t)(x1.x >> 16); d[10 * 264] = (bf16_t)(x1.y & 0xffff); d[11 * 264] = (bf16_t)(x1.y >> 16);
      d[12 * 264] = (bf16_t)(x1.z & 0xffff); d[13 * 264] = (bf16_t)(x1.z >> 16); d[14 * 264] = (bf16_t)(x1.w & 0xffff); d[15 * 264] = (bf16_t)(x1.w >> 16); }
    __syncthreads();
#pragma unroll
    for (int k = 0; k < 4; ++k) {
      const int tl = 4 * w + k, row = t0 + tl;
      const u32x2 wa = *(const u32x2*)(O + (size_t)row * 768 + 4 * lane), wc = *(const u32x2*)(O + (size_t)row * 768 + 256 + 4 * lane), wd = *(const u32x2*)(O + (size_t)row * 768 + 512 + 4 * lane);
      const u32x2 wb = *(const u32x2*)(obs + tl * 264 + 4 * lane), wr = *(const u32x2*)(U + (size_t)row * UW + U_RD + 4 * lane);
      float xa[4] = {bflo(wa.x), bfhi(wa.x), bflo(wa.y), bfhi(wa.y)}, xb[4] = {bflo(wb.x), bfhi(wb.x), bflo(wb.y), bfhi(wb.y)};
      float xc[4] = {bflo(wc.x), bfhi(wc.x), bflo(wc.y), bfhi(wc.y)}, xd[4] = {bflo(wd.x), bfhi(wd.x), bflo(wd.y), bfhi(wd.y)};
      float rd[4] = {bflo(wr.x), bfhi(wr.x), bflo(wr.y), bfhi(wr.y)};
      float sa = xa[0] * xa[0] + xa[1] * xa[1] + xa[2] * xa[2] + xa[3] * xa[3];
      float sb = xb[0] * xb[0] + xb[1] * xb[1] + xb[2] * xb[2] + xb[3] * xb[3];
      float sc = xc[0] * xc[0] + xc[1] * xc[1] + xc[2] * xc[2] + xc[3] * xc[3];
      float sd = xd[0] * xd[0] + xd[1] * xd[1] + xd[2] * xd[2] + xd[3] * xd[3];
      sa = wave_sum(sa); sb = wave_sum(sb); sc = wave_sum(sc);
#pragma unroll
      for (int o = 8; o >= 1; o >>= 1) sd += __shfl_xor(sd, o, 64);
      const float ra = rsqrtf(sa * (1.f / 256.f) + EPSF), rb = rsqrtf(sb * (1.f / 256.f) + EPSF), rc = rsqrtf(sc * (1.f / 256.f) + EPSF), rdn = rsqrtf(sd * (1.f / 64.f) + EPSF);
      const f32x4 ga = *(const f32x4*)(mg + 4 * lane), gb = *(const f32x4*)(mg + 256 + 4 * lane), gc = *(const f32x4*)(mg + 512 + 4 * lane), gd = *(const f32x4*)(mg + 768 + 4 * lane);
      float ya[4], yb[4], yc[4], yd[4];
#pragma unroll
      for (int e = 0; e < 4; ++e) { ya[e] = xa[e] * ra * ga[e]; yb[e] = xb[e] * rb * gb[e]; yc[e] = xc[e] * rc * gc[e]; yd[e] = xd[e] * rdn * gd[e] * (rd[e] / (1.f + __expf(-rd[e]))); }
      bf16_t* cp = cat + (size_t)row * DM + 4 * lane;
      u32x2 o;
      o.x = cvtpk(ya[0], ya[1]); o.y = cvtpk(ya[2], ya[3]); *(u32x2*)(cp) = o;
      o.x = cvtpk(yb[0], yb[1]); o.y = cvtpk(yb[2], yb[3]); *(u32x2*)(cp + 256) = o;
      o.x = cvtpk(yc[0], yc[1]); o.y = cvtpk(yc[2], yc[3]); *(u32x2*)(cp + 512) = o;
      o.x = cvtpk(yd[0], yd[1]); o.y = cvtpk(yd[2], yd[3]); *(u32x2*)(cp + 768) = o;
    }
    __syncthreads();
  }
}

#ifndef REP_G1
#define REP_G1 1
#endif
#ifndef REP_G2
#define REP_G2 1
#endif
#ifndef REP_G3
#define REP_G3 1
#endif
#ifndef REP_N
#define REP_N 1
#endif
#ifndef REP_M1
#define REP_M1 1
#endif
#ifndef REP_M2
#define REP_M2 1
#endif
#ifndef REP_MG
#define REP_MG 1
#endif
#ifndef REP_P0
#define REP_P0 1
#endif
#ifndef REP_PP
#define REP_PP 1
#endif
#ifndef REP_SYNC
#define REP_SYNC 1
#endif

#ifdef NO_ATTN
#define ATTN(...) do{}while(0)
#else
#define ATTN attn_unit
#endif
#ifdef NO_GLAA
#define GLAA(...) do{}while(0)
#else
#define GLAA gla_a_unit
#endif
#ifdef NO_GLAB
#define GLAB(...) do{}while(0)
#else
#define GLAB gla_b_unit
#endif
#ifdef NO_HY
#define HYEN(...) do{}while(0)
#else
#define HYEN hyena_unit
#endif

DI int q_fetch(unsigned* ctr, int tid) { int v = 0; if (tid == 0) v = (int)__hip_atomic_fetch_add(ctr, 1u, __ATOMIC_RELAXED, __HIP_MEMORY_SCOPE_AGENT); return v; }
DI int q_bcast(int v, unsigned char* ldsb, int tid) {
  volatile int* slot = (volatile int*)(ldsb + LDS_CTL_OFF);
  if (tid == 0) *slot = v;
  __syncthreads();
  const int r = *slot;
  __syncthreads();
  return r;
}

#ifndef N_LAUNCH_PER_PHASE
#define N_LAUNCH_PER_PHASE 0
#endif
constexpr int NPHASE = 28;

__global__ void __launch_bounds__(512, 2) fwd_kernel(Args a_) {
  extern __shared__ __attribute__((aligned(16))) unsigned char lds[];
  cg::grid_group grid = cg::this_grid();
  if (threadIdx.x < 16) ((volatile LAS unsigned*)((LAS unsigned char*)lds + LDS_CTL_OFF))[threadIdx.x] = 0u;
  __syncthreads();
  XcdBarrier xbar = xcd_barrier_post((unsigned*)(a_.ws + WS_BAR), (volatile LAS unsigned*)((LAS unsigned char*)lds + LDS_CTL_OFF + 16));
  const int ph_hi = a_.ph_hi;
  for (int ph = a_.ph_lo; ph < ph_hi; ++ph) {
    CArgs* ap = (CArgs*)__builtin_amdgcn_kernarg_segment_ptr();
    asm volatile("" : "+s"(ap));
    CArgs& a = *ap;
    int tid = threadIdx.x; asm volatile("" : "+v"(tid));
    int bid = blockIdx.x; asm volatile("" : "+s"(bid));
    unsigned char* ws = a.ws;
    float* mod = (float*)(ws + WS_MOD);
    bf16_t* XN = (bf16_t*)(ws + WS_XN); bf16_t* ACT = (bf16_t*)(ws + WS_ACT); float* H = (float*)(ws + WS_H);
    if (ph == 0) {

#ifndef NO_P0
      for (int rep = 0; rep < REP_P0; ++rep) {
      p0_filters(a, lds, tid);
      p0_modulation(a, lds, tid);
      p0_convert_range(a, lds, tid, 0, 528, bid, gridDim.x);
      }
#endif

    } else if (ph == NPHASE - 1) {
      for (int rep = 0; rep < REP_PP; ++rep) final_norm_phase(H, a.out, a.in[30], tid);
    } else {
      const int l = (ph - 1) / 13, s = (ph - 1) % 13;
      const float* mod_l = mod + (size_t)l * 3 * 9216;
      if (s == 0 || s == 3 || s == 10) {
        const int j = s == 0 ? 0 : (s == 3 ? 1 : 2);
        const bool first = (l == 0 && s == 0);
        for (int rep = 0; rep < REP_N; ++rep) norm_mod_phase(first ? a.in[0] : H, first ? a.in[1] : H + (size_t)MCTX * DM, XN, a.in[11] + (l * 3 + j) * 1024, mod_l, j, tid, first ? (const float*)(ws + WS_MODP) : nullptr, a.in[10]);
        if (first) mod_finalize(a, tid);
      } else if (s == 1 || s == 11) {
        const int f = s == 1 ? 0 : 1;
        pg8::Gemm g; g.A = XN; g.Bt = (const bf16_t*)(ws + WS_WFI) + (size_t)(l * 2 + f) * 5632 * 1024; g.M = MT; g.N = 5632; g.K = 1024;
        pg8::StaticOrder S; S.init(MT, 5632, gridDim.x, bid);
        EpiSwiglu E; E.act = ACT;

#ifndef NO_G1
for (int rep = 0; rep < REP_G1; ++rep) pg8::gemm_phase<EpiSwiglu, pg8::StaticOrder, true, true>((PG8_LAS unsigned char*)lds, g, S, E);
#endif

      } else if (s == 2 || s == 9 || s == 12) {
        pg8::Gemm g; g.M = MT; g.N = 1024;
        EpiRes E; E.h = H; E.resA = H; E.resB = H;
        if (s == 9) { g.A = XN; g.Bt = (const bf16_t*)(ws + WS_WOUT) + (size_t)l * 1024 * 1024; g.K = 1024; E.gate = mod_l + 5 * 1024; E.coef = 1.f; }
        else { const int f = s == 2 ? 0 : 1; g.A = ACT; g.Bt = (const bf16_t*)(ws + WS_WFO) + (size_t)(l * 2 + f) * 1024 * 2816; g.K = 2816; E.gate = mod_l + (f == 0 ? 2 : 8) * 1024; E.coef = 0.5f;
          if (l == 0 && s == 2) { E.resA = a.in[0]; E.resB = a.in[1] - (size_t)MCTX * DM; } }
        pg8::StaticOrder S; S.init(MT, 1024, gridDim.x, bid);

#ifndef NO_G2
for (int rep = 0; rep < REP_G2; ++rep) { E.h = rep + 1 < REP_G2 ? (float*)(ws + WS_O) : H; pg8::gemm_phase<EpiRes, pg8::StaticOrder, true, true>((PG8_LAS unsigned char*)lds, g, S, E); }
        if (l == 0) { const int lo = s == 2 ? 528 : (s == 9 ? 1296 : 1680), hi = s == 2 ? 1296 : (s == 9 ? 1680 : 2592), Gn = gridDim.x;
          if (Gn > 160) { if (bid >= 160) p0_convert_range(a, lds, tid, lo, hi, bid - 160, Gn - 160); } else p0_convert_range(a, lds, tid, lo, hi, bid, Gn); }
#endif

      } else if (s == 4) {
        pg8::Gemm g; g.A = XN; g.Bt = (const bf16_t*)(ws + WS_WIN) + (size_t)l * NINP * 1024; g.M = MT; g.N = NINP; g.K = 1024;
        pg8::StaticOrder S; S.init(MT, NINP, gridDim.x, bid);
        EpiInproj E; E.U = ACT; E.HYT = (bf16_t*)(ws + WS_HYT); E.out = a.out; E.l = l;

#ifndef NO_G3
for (int rep = 0; rep < REP_G3; ++rep) pg8::gemm_phase<EpiInproj, pg8::StaticOrder, true, true>((PG8_LAS unsigned char*)lds, g, S, E);
#endif

      } else if (s == 5) {
        for (int rep = 0; rep < REP_PP; ++rep) post_proj_phase(ACT, rep + 1 < REP_PP ? (bf16_t*)nullptr : ACT, a.out, a.in[18] + l * 128, l, tid);
      } else if (s == 6) {
        for (int rep = 0; rep < REP_M1; ++rep) {
        unsigned* ctr = (unsigned*)(ws + WS_CTL) + 64 * (l * 2 + 0) + 16 * rep;
        int q = q_bcast(q_fetch(ctr, tid), lds, tid);
        for (;;) {
          if (q >= 1472) break;
          const int qn = q_fetch(ctr, tid);
          if (q < 64) { ATTN(a, l, q, lds, tid); }
          else if (q < 704) { const int j = q - 64; GLAA(a, l, j < 128 ? 512 + j : j - 128, lds, tid); }
          else if (q < 1216) { const int j = q - 704; HYEN(a, l, 0, j & 255, j < 256 ? 1 : 0, lds, tid); }
          else { ATTN(a, l, 64 + (q - 1216), lds, tid); }
          q = q_bcast(qn, lds, tid);
        }
        }
      } else if (s == 7) {
        for (int rep = 0; rep < REP_M2; ++rep) {
        unsigned* ctr = (unsigned*)(ws + WS_CTL) + 64 * (l * 2 + 1) + 16 * rep;
        int q = q_bcast(q_fetch(ctr, tid), lds, tid);
        for (;;) {
          if (q >= 1152) break;
          const int qn = q_fetch(ctr, tid);
          if (q < 640) { GLAB(a, l, q < 128 ? 512 + q : q - 128, lds, tid); }
          else { const int j = q - 640; HYEN(a, l, 1, j & 255, j < 256 ? 1 : 0, lds, tid); }
          q = q_bcast(qn, lds, tid);
        }
        }
      } else if (s == 8) {

#ifndef NO_MERGE
for (int rep = 0; rep < REP_MG; ++rep) merge_phase(a, l, lds, tid);
#endif

      }
    }
    if (ph + 1 < ph_hi) { for (int rep = 0; rep < REP_SYNC; ++rep) { if (a_.ph_lo < 0) grid.sync(); xcd_barrier(xbar); } }
  }
}

extern "C" void kernel_launch(void* const* d_in, const int* in_sizes, int n_in, void* d_out, int out_size, void* d_ws, size_t ws_size, hipStream_t stream) {
  static int grid = 0;
  if (grid == 0) {
    if (n_in != 31 || ws_size < WS_END) { fprintf(stderr, "kernel_launch: need 31 inputs and >= %zu bytes of workspace; got %d, %zu\n", (size_t)WS_END, n_in, ws_size); grid = -1; return; }
    int dev = 0, cus = 0, per_cu = 0;
    (void)hipGetDevice(&dev);
    (void)hipDeviceGetAttribute(&cus, hipDeviceAttributeMultiprocessorCount, dev);
    if (hipFuncSetAttribute((const void*)fwd_kernel, hipFuncAttributeMaxDynamicSharedMemorySize, LDS_BYTES) != hipSuccess) { fprintf(stderr, "kernel_launch: hipFuncSetAttribute failed\n"); grid = -1; return; }
    if (hipOccupancyMaxActiveBlocksPerMultiprocessor(&per_cu, (const void*)fwd_kernel, 512, LDS_BYTES) != hipSuccess || per_cu < 1) { fprintf(stderr, "kernel_launch: occupancy query says %d\n", per_cu); per_cu = 1; }
    (void)hipGetLastError();
    grid = cus * 1;
    if (grid <= 0) grid = 256;
  }
  if (grid < 0) return;
  (void)hipMemsetAsync((char*)d_ws + WS_CTL, 0, 32768, stream);
  Args a{};
  for (int i = 0; i < 31; ++i) a.in[i] = (const float*)d_in[i];
  a.out = (float*)d_out; a.ws = (unsigned char*)d_ws;
#if N_LAUNCH_PER_PHASE
  for (int ph = 0; ph < NPHASE; ++ph) { a.ph_lo = ph; a.ph_hi = ph + 1; hipLaunchKernelGGL(fwd_kernel, dim3(grid), dim3(512), LDS_BYTES, stream, a); }
#else
  a.ph_lo = 0; a.ph_hi = NPHASE;
  void* args[] = {&a};
  hipError_t e = hipLaunchCooperativeKernel((const void*)fwd_kernel, dim3(grid), dim3(512), args, LDS_BYTES, stream);
  if (e != hipSuccess) fprintf(stderr, "kernel_launch: cooperative launch failed: %s (grid %d)\n", hipGetErrorString(e), grid);
#endif
}
```

```cpp
#include <hip/hip_runtime.h>
#include <hip/hip_cooperative_groups.h>
#include <cstdio>
#include <cstdint>
namespace cg = cooperative_groups;

#define DI __device__ __forceinline__
#define LAS __attribute__((address_space(3)))
typedef unsigned short bf16_t;
typedef short bf16x8 __attribute__((ext_vector_type(8)));
typedef float f32x4 __attribute__((ext_vector_type(4)));
typedef float f32x16 __attribute__((ext_vector_type(16)));
typedef unsigned u32x4 __attribute__((ext_vector_type(4)));
typedef unsigned u32x2 __attribute__((ext_vector_type(2)));
typedef __bf16 bf16x2_t __attribute__((ext_vector_type(2)));
typedef float f32x2_t __attribute__((ext_vector_type(2)));

DI unsigned cvtpk(float lo, float hi) { f32x2_t v = {lo, hi}; bf16x2_t b = __builtin_convertvector(v, bf16x2_t); return __builtin_bit_cast(unsigned, b); }
DI float bf2f(bf16_t x) { return __uint_as_float(((unsigned)x) << 16); }
DI bf16_t f2bf(float x) { return (bf16_t)(cvtpk(x, 0.f) & 0xffffu); }
DI float bflo(unsigned w) { return __uint_as_float(w << 16); }
DI float bfhi(unsigned w) { return __uint_as_float(w & 0xffff0000u); }
DI float wave_sum(float v) {
#pragma unroll
  for (int o = 32; o >= 1; o >>= 1) v += __shfl_xor(v, o, 64);
  return v;
}
DI float siluf(float a) { return a * __builtin_amdgcn_rcpf(1.f + __expf(-a)); }
DI int crow(int r, int hi) { return (r & 3) + 8 * (r >> 2) + 4 * hi; }

constexpr int MT = 10240, MCTX = 8192, DM = 1024, DFF = 2816, NINP = 2816, NIN = 2592, UW = 1824;
constexpr int U_QA = 0, U_KA = 256, U_VA = 384, U_QC = 512, U_KC = 768, U_VC = 896, U_QD = 1024, U_KD = 1152, U_VD = 1280, U_GD = 1536, U_RD = 1568;
constexpr float EPSF = 1e-6f;
constexpr float QSCALE = 0.125f * 1.4426950408889634f;
constexpr size_t OUT_SWAK = 10485760, OUT_SWAV = 12582912, OUT_GQAK = 14680064, OUT_GQAV = 16777216, OUT_STATE = 18874368;
constexpr size_t WS_CTL = 0;
constexpr size_t WS_BAR = 4096;
constexpr size_t WS_WFI = 32768;
constexpr size_t WS_WFO = WS_WFI + (size_t)4 * 5632 * 1024 * 2;
constexpr size_t WS_WIN = WS_WFO + (size_t)4 * 1024 * 2816 * 2;
constexpr size_t WS_WOUT = WS_WIN + (size_t)2 * 2816 * 1024 * 2;
constexpr size_t WS_MOD = WS_WOUT + (size_t)2 * 1024 * 1024 * 2;
constexpr size_t WS_FILT = WS_MOD + (size_t)2 * 3 * 9216 * 4;
constexpr size_t WS_XN = WS_FILT + (size_t)2 * 2 * 256 * 2560 * 2;
constexpr size_t WS_ACT = WS_XN + (size_t)MT * 1024 * 2;
constexpr size_t WS_H = WS_ACT + (size_t)MT * 2816 * 2;
constexpr size_t WS_O = WS_H + (size_t)MT * 1024 * 4;
constexpr size_t WS_OBT = WS_O + (size_t)MT * 768 * 2;
constexpr size_t WS_HYT = WS_OBT + (size_t)256 * MT * 2;
constexpr size_t WS_Y1T = WS_HYT + (size_t)768 * MT * 2;
constexpr size_t WS_OD = WS_Y1T + (size_t)256 * MT * 2;
constexpr size_t WS_GLC = WS_OD + (size_t)MT * 256 * 4;
constexpr size_t WS_GLD = WS_GLC + (size_t)160 * 4 * 2 * 2048 * 4;
constexpr size_t WS_MODP = WS_GLD + (size_t)160 * 4 * 2 * 32 * 4;
constexpr size_t WS_END = WS_MODP + (size_t)4 * 55296 * 4;
constexpr int LDS_BYTES = 147456;
constexpr int LDS_CTL_OFF = LDS_BYTES - 64;

struct Args { const float* in[31]; float* out; unsigned char* ws; int ph_lo, ph_hi; };
typedef const __attribute__((address_space(4))) Args CArgs;


DI int BID() { int b = blockIdx.x; asm volatile("" : "+s"(b)); return b; }
namespace pg8 {
#define PG8_LAS __attribute__((address_space(3)))
typedef unsigned short bf16_t;
typedef short bf16x8 __attribute__((ext_vector_type(8)));
typedef float f32x4 __attribute__((ext_vector_type(4)));
typedef unsigned u32x4 __attribute__((ext_vector_type(4)));
constexpr int BM = 256, BK = 64, HALF = 128, HTB = HALF * BK * 2  , STAGE_BYTES = 8 * HTB, NXCD = 8, WGM = 8;

__host__ __device__ __forceinline__ int lds_byte(int r, int c) { const int st = (r >> 4) * 2 + (c >> 5), rr = r & 15, cc = c & 31, ob = rr * 64 + cc * 2; return st * 1024 + (ob ^ (((ob >> 9) & 1) << 5)); }
__host__ __device__ __forceinline__ void stage_rc(int b, int& R, int& C) { const int st = b / 1024, sb = b % 1024, swz = sb ^ (((sb >> 9) & 1) << 5); R = (st >> 1) * 16 + swz / 64; C = (st & 1) * 32 + (swz % 64) / 2; }
__host__ __device__ __forceinline__ int perm32(int rho) { const int n = rho >> 4, i = rho & 15; return 8 * (i >> 2) + 4 * n + (i & 3); }

struct Unit { int pm, pn; };
struct Gemm { const bf16_t* A; const bf16_t* Bt; int M, N, K; };

struct StaticOrder {
    int nM, nN, nwg, G, c;
    __host__ __device__ void init(int M, int N, int G_, int c_) { nM = M / BM; nN = N / BM; nwg = nM * nN; G = G_; c = c_; }
    __host__ __device__ bool next(int i, Unit& u) const {
        const long L = (long)i * G + c; if (L >= nwg) return false;
        int wgid = (int)L; { const int q = nwg / NXCD, r = nwg % NXCD, xcd = wgid % NXCD, off = wgid / NXCD; wgid = (xcd < r ? xcd * (q + 1) : r * (q + 1) + (xcd - r) * q) + off; }
        const int nig = WGM * nN, gid = wgid / nig, fm = gid * WGM, gsz = (nM - fm) < WGM ? (nM - fm) : WGM;
        u.pm = fm + ((wgid % nig) % gsz); u.pn = (wgid % nig) / gsz; return true;
    }
    __device__ __forceinline__ void a_ready(const Unit&) const {}
    __device__ __forceinline__ void done(const Unit&) const {}
};
template <class Epi, class Sched, bool ALIGN_EPI = false, bool SP2 = false>
__device__ __forceinline__ void gemm_phase(PG8_LAS unsigned char* lds, const Gemm g, const Sched& S, const Epi& E) {
    int tid_l = threadIdx.x; asm volatile("" : "+v"(tid_l));
    const int tid = tid_l, wid = __builtin_amdgcn_readfirstlane(tid >> 6), lane = tid & 63, wr = wid >> 2, wc = wid & 3, fr = lane & 15, fq = lane >> 4;
    const int K = g.K, nt = K / BK;
    unsigned voffA[2], voffB[2];
#pragma unroll
    for (int i = 0; i < 2; ++i) { int R, C; stage_rc(tid * 16 + i * 8192, R, C); const int Rb = Epi::PERM ? ((R & ~31) + perm32(R & 31)) : R;
        voffA[i] = (unsigned)(R * K + C) * 2u; voffB[i] = (unsigned)(Rb * K + C) * 2u; }
    const size_t kstep = (size_t)(BK * 2);
    const size_t hstep = (size_t)HALF * K * 2;
    const size_t tstep = 2 * hstep;
    const unsigned ldsw = (unsigned)wid * 1024u;
    const int aoff = lds_byte(wr * 64 + fr, fq * 8), boff = lds_byte(wc * 32 + fr, fq * 8);
#define PG8_SA(b, h) (((b) * 2 + (h)) * HTB)
#define PG8_SB(b, h) ((4 + (b) * 2 + (h)) * HTB)
#define PG8_STAGE(bufoff, gbase, voff) do { _Pragma("unroll") for (int _i = 0; _i < 2; ++_i) \
        __builtin_amdgcn_global_load_lds((const unsigned*)((const char*)(gbase) + (voff)[_i]), (PG8_LAS unsigned*)(lds + (bufoff) + ldsw + _i * 8192), 16, 0, 0); } while (0)
#define PG8_LDA(dst, b, h) do { _Pragma("unroll") for (int m = 0; m < 4; ++m) _Pragma("unroll") for (int k = 0; k < 2; ++k) dst[m][k] = *(const PG8_LAS bf16x8*)(lds + PG8_SA(b, h) + aoff + m * 2048 + k * 1024); } while (0)
#define PG8_LDB(dst, b, h) do { _Pragma("unroll") for (int n = 0; n < 2; ++n) _Pragma("unroll") for (int k = 0; k < 2; ++k) dst[n][k] = *(const PG8_LAS bf16x8*)(lds + PG8_SB(b, h) + boff + n * 2048 + k * 1024); } while (0)
#define PG8_MMA(ai, bj, At, Bt) do { __builtin_amdgcn_s_setprio(1); _Pragma("unroll") for (int m = 0; m < 4; ++m) _Pragma("unroll") for (int n = 0; n < 2; ++n) _Pragma("unroll") for (int k = 0; k < 2; ++k) \
        acc[ai][bj][m][n] = __builtin_amdgcn_mfma_f32_16x16x32_bf16(Bt[n][k], At[m][k], acc[ai][bj][m][n], 0, 0, 0); __builtin_amdgcn_s_setprio(0); } while (0)
#define PG8_WAIT_V(n) asm volatile("s_waitcnt vmcnt(" #n ")" ::: "memory")
#define PG8_WAIT_L(n) asm volatile("s_waitcnt lgkmcnt(" #n ")" ::: "memory")
#define PG8_BAR __builtin_amdgcn_s_barrier()
#define PG8_SCHED __builtin_amdgcn_sched_barrier(0)
    Unit cur, nxt; int ui = 0;
    if (!S.next(0, cur)) return;
    f32x4 acc[2][2][4][2];
#pragma unroll
    for (int a = 0; a < 2; ++a)
#pragma unroll
        for (int b = 0; b < 2; ++b)
#pragma unroll
            for (int m = 0; m < 4; ++m)
#pragma unroll
                for (int n = 0; n < 2; ++n) acc[a][b][m][n] = (f32x4){0.f, 0.f, 0.f, 0.f};
    bf16x8 At[4][2], B0[2][2], B1[2][2];
    const char* cA = (const char*)g.A + (size_t)cur.pm * tstep; const char* cB = (const char*)g.Bt + (size_t)cur.pn * tstep;
    S.a_ready(cur);
    if constexpr (SP2) {
        PG8_STAGE(PG8_SB(0, 0), cB, voffB); PG8_STAGE(PG8_SB(0, 1), cB + hstep, voffB); PG8_STAGE(PG8_SA(0, 0), cA, voffA); PG8_STAGE(PG8_SA(0, 1), cA + hstep, voffA);
        if (wr == 1) PG8_BAR;
        PG8_WAIT_V(2); PG8_BAR;
        PG8_STAGE(PG8_SB(1, 0), cB + kstep, voffB); PG8_STAGE(PG8_SA(1, 0), cA + kstep, voffA); PG8_STAGE(PG8_SB(1, 1), cB + hstep + kstep, voffB);
        PG8_WAIT_V(6); PG8_BAR;
    } else {
        PG8_STAGE(PG8_SB(0, 0), cB, voffB); PG8_STAGE(PG8_SA(0, 0), cA, voffA); PG8_STAGE(PG8_SB(0, 1), cB + hstep, voffB); PG8_STAGE(PG8_SA(0, 1), cA + hstep, voffA);
        if (wr == 1) PG8_BAR;
        PG8_WAIT_V(4); PG8_BAR;
        PG8_STAGE(PG8_SB(1, 0), cB + kstep, voffB); PG8_STAGE(PG8_SA(1, 0), cA + kstep, voffA); PG8_STAGE(PG8_SB(1, 1), cB + hstep + kstep, voffB);
        PG8_WAIT_V(6); PG8_BAR;
    }
    for (;;) {
        const bool has_next = S.next(ui + 1, nxt);
        const char* nA = has_next ? (const char*)g.A + (size_t)nxt.pm * tstep : cA; const char* nB = has_next ? (const char*)g.Bt + (size_t)nxt.pn * tstep : cB;
        for (int t = 0; t < nt; t += 2) {
            const bool last = (t == nt - 2);
            const char* a1 = cA + (size_t)(t + 1) * kstep;
            const char* a2 = last ? nA : cA + (size_t)(t + 2) * kstep; const char* b2 = last ? nB : cB + (size_t)(t + 2) * kstep;
            const char* a3 = a2 + kstep; const char* b3 = b2 + kstep;
            if (last && has_next) S.a_ready(nxt);
            if constexpr (SP2) {
            PG8_LDB(B0, 0, 0); PG8_LDB(B1, 0, 1); PG8_SCHED; PG8_LDA(At, 0, 0); PG8_STAGE(PG8_SA(1, 1), a1 + hstep, voffA);
            PG8_WAIT_V(8); PG8_WAIT_L(0); PG8_BAR; PG8_MMA(0, 0, At, B0); PG8_MMA(0, 1, At, B1); PG8_BAR; PG8_SCHED;
            PG8_LDA(At, 0, 1); PG8_STAGE(PG8_SB(0, 0), b2, voffB); PG8_STAGE(PG8_SB(0, 1), b2 + hstep, voffB); PG8_STAGE(PG8_SA(0, 0), a2, voffA);
            PG8_WAIT_V(8); PG8_WAIT_L(0); PG8_BAR; PG8_MMA(1, 0, At, B0); PG8_MMA(1, 1, At, B1); PG8_BAR; PG8_SCHED;
            PG8_LDB(B0, 1, 0); PG8_LDB(B1, 1, 1); PG8_SCHED; PG8_LDA(At, 1, 0); PG8_STAGE(PG8_SA(0, 1), a2 + hstep, voffA);
            PG8_WAIT_V(8); PG8_WAIT_L(0); PG8_BAR; PG8_MMA(0, 0, At, B0); PG8_MMA(0, 1, At, B1); PG8_BAR; PG8_SCHED;
            PG8_LDA(At, 1, 1); PG8_STAGE(PG8_SB(1, 0), b3, voffB); PG8_STAGE(PG8_SB(1, 1), b3 + hstep, voffB); PG8_STAGE(PG8_SA(1, 0), a3, voffA);
            PG8_WAIT_V(8); PG8_WAIT_L(0); PG8_BAR; PG8_MMA(1, 0, At, B0); PG8_MMA(1, 1, At, B1); PG8_BAR; PG8_SCHED;
            } else {
            PG8_LDB(B0, 0, 0); PG8_SCHED; PG8_LDA(At, 0, 0); PG8_STAGE(PG8_SA(1, 1), a1 + hstep, voffA);
            PG8_WAIT_L(8); PG8_BAR; PG8_WAIT_L(0); PG8_MMA(0, 0, At, B0); PG8_BAR; PG8_SCHED;
            PG8_LDB(B1, 0, 1); PG8_STAGE(PG8_SB(0, 0), b2, voffB);
            PG8_BAR; PG8_WAIT_L(0); PG8_MMA(0, 1, At, B1); PG8_BAR;
            PG8_LDA(At, 0, 1); PG8_STAGE(PG8_SA(0, 0), a2, voffA);
            PG8_BAR; PG8_WAIT_L(0); PG8_MMA(1, 0, At, B0); PG8_BAR; PG8_SCHED;
            PG8_STAGE(PG8_SB(0, 1), b2 + hstep, voffB);
            PG8_WAIT_V(6); PG8_BAR; PG8_MMA(1, 1, At, B1); PG8_BAR;
            PG8_LDB(B0, 1, 0); PG8_SCHED; PG8_LDA(At, 1, 0); PG8_STAGE(PG8_SA(0, 1), a2 + hstep, voffA);
            PG8_WAIT_L(8); PG8_BAR; PG8_WAIT_L(0); PG8_MMA(0, 0, At, B0); PG8_BAR; PG8_SCHED;
            PG8_LDB(B1, 1, 1); PG8_STAGE(PG8_SB(1, 0), b3, voffB);
            PG8_BAR; PG8_WAIT_L(0); PG8_MMA(0, 1, At, B1); PG8_BAR;
            PG8_LDA(At, 1, 1); PG8_STAGE(PG8_SA(1, 0), a3, voffA);
            PG8_BAR; PG8_WAIT_L(0); PG8_MMA(1, 0, At, B0); PG8_BAR; PG8_SCHED;
            PG8_STAGE(PG8_SB(1, 1), b3 + hstep, voffB);
            PG8_WAIT_V(6); PG8_BAR; PG8_MMA(1, 1, At, B1); PG8_BAR;
            }
        }
        if constexpr (ALIGN_EPI) { if (wr == 0) PG8_BAR; }
        if constexpr (!Epi::AFTER_DRAIN) { E(acc, cur, wr, wc, fr, fq); S.done(cur); }
        if (!has_next) break;
#pragma unroll
        for (int a = 0; a < 2; ++a)
#pragma unroll
            for (int b = 0; b < 2; ++b)
#pragma unroll
                for (int m = 0; m < 4; ++m)
#pragma unroll
                    for (int n = 0; n < 2; ++n) acc[a][b][m][n] = (f32x4){0.f, 0.f, 0.f, 0.f};
        cur = nxt; cA = nA; cB = nB; ++ui;
        if constexpr (ALIGN_EPI) { if (wr == 1) PG8_BAR; }
    }
    PG8_WAIT_V(0);
    if constexpr (!ALIGN_EPI) { if (wr == 0) PG8_BAR; }
    PG8_BAR;
    if constexpr (Epi::AFTER_DRAIN) { E.fused(acc, cur, wr, wc, fr, fq, lds, wid, lane); S.done(cur); }
#undef PG8_SA
#undef PG8_SB
#undef PG8_STAGE
#undef PG8_LDA
#undef PG8_LDB
#undef PG8_MMA
#undef PG8_WAIT_V
#undef PG8_WAIT_L
#undef PG8_BAR
#undef PG8_SCHED
}
}
#define XB_TMO      128
#define XB_XCNT(j)  (256  + 64 * (j))
#define XB_XSUB(j)  (1280 + 64 * (j))
#define XB_XGEN(j)  (2304 + 64 * (j))
#define XB_TOP      3328
#define XB_TOPGEN   3392
#define XCD_BAR_WORDS 3456
#define XB_SPIN_CAP (1u << 18)

__device__ __forceinline__ unsigned xb_ld(unsigned* p)              { return __hip_atomic_load(p, __ATOMIC_RELAXED, __HIP_MEMORY_SCOPE_AGENT); }
__device__ __forceinline__ unsigned xb_add(unsigned* p, unsigned v) { return __hip_atomic_fetch_add(p, v, __ATOMIC_RELAXED, __HIP_MEMORY_SCOPE_AGENT); }
__device__ __forceinline__ unsigned xb_xcc_id() { return (unsigned)__builtin_amdgcn_s_getreg((3 << 11) | 20) & 0xFu; }
#define XB_SPIN(cond, bar) do { unsigned _sp = 0; while (cond) { __builtin_amdgcn_s_sleep(1); \
    if ((++_sp & 255u) == 0u) { if (xb_ld(&(bar)[XB_TMO])) break; if (_sp > XB_SPIN_CAP) { atomicAdd(&(bar)[XB_TMO], 1u); break; } } } } while (0)

struct XcdBarrier {
    unsigned* bar; unsigned x;
    volatile LAS unsigned* st;
};

__device__ __forceinline__ XcdBarrier xcd_barrier_post(unsigned* bar, volatile LAS unsigned* st) {
    XcdBarrier b; b.bar = bar; b.x = xb_xcc_id(); b.st = st;
    if (threadIdx.x == 0) (void)xb_add(&bar[XB_XCNT(b.x)], 1u);
    return b;
}
__device__ __forceinline__ void xcd_barrier_complete(unsigned* bar, unsigned x, unsigned& nloc, unsigned& nx) {
    const unsigned G = gridDim.x * gridDim.y * gridDim.z;
    unsigned sum, cnt, mine, sp = 0u;
    for (;;) {
        sum = 0u; cnt = 0u; mine = 0u;
#pragma unroll
        for (unsigned j = 0; j < 16; ++j) { const unsigned c = xb_ld(&bar[XB_XCNT(j)]); sum += c; cnt += (c > 0u) ? 1u : 0u; mine = (j == x) ? c : mine; }
        if (sum == G) break;
        __builtin_amdgcn_s_sleep(1);
        if ((++sp & 255u) == 0u) { if (xb_ld(&bar[XB_TMO])) break; if (sp > XB_SPIN_CAP) { atomicAdd(&bar[XB_TMO], 1u); break; } }
    }
    nloc = mine > 0u ? mine : 1u; nx = cnt > 0u ? cnt : 1u;
}

__device__ __forceinline__ void xcd_barrier(const XcdBarrier& b) {
    asm volatile("s_waitcnt vmcnt(0)" ::: "memory");
    __syncthreads();
    if (threadIdx.x == 0) {
        unsigned* bar = b.bar;
        __builtin_amdgcn_s_waitcnt(0);
        unsigned nloc = b.st[0], nx = b.st[1];
        if (nloc == 0u) { xcd_barrier_complete(bar, b.x, nloc, nx); b.st[0] = nloc; b.st[1] = nx; }
        const unsigned old = xb_add(&bar[XB_XSUB(b.x)], 1u);
        const unsigned gen = old / nloc;
        if (old + 1u == (gen + 1u) * nloc) {
            __builtin_amdgcn_fence(__ATOMIC_RELEASE, "agent");
            asm volatile("s_waitcnt vmcnt(0)" ::: "memory");
            const unsigned og = xb_add(&bar[XB_TOP], 1u);
            const unsigned tg = og / nx;
            if (og + 1u == (tg + 1u) * nx) xb_add(&bar[XB_TOPGEN], 1u);
            else XB_SPIN(xb_ld(&bar[XB_TOPGEN]) == tg, bar);
            __builtin_amdgcn_fence(__ATOMIC_ACQUIRE, "agent");
            xb_add(&bar[XB_XGEN(b.x)], 1u);
            asm volatile("s_waitcnt vmcnt(0)" ::: "memory");
        } else {
            XB_SPIN(xb_ld(&bar[XB_XGEN(b.x)]) == gen, bar);
            __builtin_amdgcn_fence(__ATOMIC_ACQUIRE, "agent");
            asm volatile("s_waitcnt vmcnt(0)" ::: "memory");
        }
    }
    __syncthreads();
}

struct EpiSwiglu {
  static constexpr bool PERM = true, AFTER_DRAIN = false;
  bf16_t* act;
  DI void operator()(const f32x4 (&acc)[2][2][4][2], const pg8::Unit& u, int wr, int wc, int fr, int fq) const {
    const int row0 = u.pm * 256 + wr * 64 + fr, col0 = u.pn * 128 + wc * 32 + 8 * fq;
#pragma unroll
    for (int ai = 0; ai < 2; ++ai)
#pragma unroll
      for (int m = 0; m < 4; ++m) {
        bf16_t* rowp = act + (size_t)(row0 + ai * 128 + m * 16) * DFF + col0;
        const f32x4 a0 = acc[ai][0][m][0], a1 = acc[ai][0][m][1], b0 = acc[ai][1][m][0], b1 = acc[ai][1][m][1];
        u32x4 w;
        w.x = cvtpk(siluf(a0[0]) * b0[0], siluf(a0[1]) * b0[1]); w.y = cvtpk(siluf(a0[2]) * b0[2], siluf(a0[3]) * b0[3]);
        w.z = cvtpk(siluf(a1[0]) * b1[0], siluf(a1[1]) * b1[1]); w.w = cvtpk(siluf(a1[2]) * b1[2], siluf(a1[3]) * b1[3]);
        *(u32x4*)rowp = w;
      }
  }
};

struct EpiRes {
  static constexpr bool PERM = true, AFTER_DRAIN = false;
  float* h; const float* resA; const float* resB; const float* gate; float coef;
  DI void operator()(const f32x4 (&acc)[2][2][4][2], const pg8::Unit& u, int wr, int wc, int fr, int fq) const {
    const int g = u.pm < 32 ? 0 : (u.pm < 36 ? 1 : 2);
    const float* res = u.pm < 32 ? resA : resB;
    const int row0 = u.pm * 256 + wr * 64 + fr, col0 = u.pn * 256 + wc * 32 + 8 * fq;
    f32x4 gv[2][2];
#pragma unroll
    for (int bj = 0; bj < 2; ++bj)
#pragma unroll
      for (int n = 0; n < 2; ++n) gv[bj][n] = *(const f32x4*)(gate + (size_t)g * 9216 + col0 + bj * 128 + 4 * n) * coef;
#pragma unroll
    for (int ai = 0; ai < 2; ++ai)
#pragma unroll
      for (int m = 0; m < 4; ++m)
#pragma unroll
        for (int bj = 0; bj < 2; ++bj)
#pragma unroll
          for (int n = 0; n < 2; ++n) {
            const size_t idx = (size_t)(row0 + ai * 128 + m * 16) * DM + col0 + bj * 128 + 4 * n;
            const f32x4 r = *(const f32x4*)(res + idx);
            *(f32x4*)(h + idx) = r + gv[bj][n] * acc[ai][bj][m][n];
          }
  }
};

struct EpiInproj {
  static constexpr bool PERM = true, AFTER_DRAIN = false;
  bf16_t* U; bf16_t* HYT; float* out; int l;
  DI void operator()(const f32x4 (&acc)[2][2][4][2], const pg8::Unit& u, int wr, int wc, int fr, int fq) const {
    const int row0 = u.pm * 256 + wr * 64 + fr, cw = wc * 32 + 8 * fq;
    const int pn = u.pn;
    if (pn >= 2 && pn <= 4) {
#pragma unroll
      for (int ai = 0; ai < 2; ++ai)
#pragma unroll
        for (int m = 0; m < 4; ++m)
#pragma unroll
          for (int bj = 0; bj < 2; ++bj)
#pragma unroll
            for (int n = 0; n < 2; ++n)
#pragma unroll
              for (int e = 0; e < 4; ++e) {
                const int c = pn * 256 - 512 + bj * 128 + cw + 4 * n + e, row = row0 + ai * 128 + m * 16;
                HYT[(size_t)c * MT + row] = f2bf(acc[ai][bj][m][n][e]);
              }
    } else {
      const int ub = (pn < 2 ? pn * 256 : pn * 256 - 768) + cw;
#pragma unroll
      for (int ai = 0; ai < 2; ++ai)
#pragma unroll
        for (int m = 0; m < 4; ++m)
#pragma unroll
          for (int bj = 0; bj < 2; ++bj) {
            const int row = row0 + ai * 128 + m * 16;
            const bool ok = (pn < 10) || (bj == 0 && wc == 0);
            if (ok) {
              const f32x4 v0 = acc[ai][bj][m][0], v1 = acc[ai][bj][m][1];
              u32x4 w; w.x = cvtpk(v0[0], v0[1]); w.y = cvtpk(v0[2], v0[3]); w.z = cvtpk(v1[0], v1[1]); w.w = cvtpk(v1[2], v1[3]);
              *(u32x4*)(U + (size_t)row * UW + ub + bj * 128) = w;
              if (u.pm < 32 && (pn == 1 || (pn == 6 && bj == 1))) {
                const int b = row >> 8, t = row & 255;
                const size_t off = (pn == 1 ? (bj == 0 ? OUT_SWAK : OUT_SWAV) : OUT_GQAV) + ((size_t)(b * 512 + l * 256 + t)) * 128 + cw;
                *(f32x4*)(out + off) = v0; *(f32x4*)(out + off + 4) = v1;
              }
            }
          }
    }
  }
};

struct CvItem { const float* W; bf16_t* WT; int Nsrc, K, n0, sca, scb, k0; };
DI CvItem cv_decode(CArgs& a, int v) {
  CvItem it; int kind, m, r;
  if (v < 352) { kind = 0; m = 0; r = v; } else if (v < 528) { kind = 1; m = 0; r = v - 352; } else if (v < 704) { kind = 2; m = 0; r = v - 528; } else if (v < 768) { kind = 3; m = 0; r = v - 704; }
  else if (v < 1120) { kind = 0; m = 1; r = v - 768; } else if (v < 1296) { kind = 1; m = 1; r = v - 1120; } else if (v < 1648) { kind = 0; m = 2; r = v - 1296; } else if (v < 1824) { kind = 1; m = 2; r = v - 1648; }
  else if (v < 2000) { kind = 2; m = 1; r = v - 1824; } else if (v < 2064) { kind = 3; m = 1; r = v - 2000; } else if (v < 2416) { kind = 0; m = 3; r = v - 2064; } else { kind = 1; m = 3; r = v - 2416; }
  if (kind == 0) { const int pn = r >> 4, kt = r & 15; it.W = a.in[12] + (size_t)m * 1024 * 5632; it.WT = (bf16_t*)(a.ws + WS_WFI) + (size_t)m * 5632 * 1024; it.Nsrc = 5632; it.K = 1024; it.n0 = 256 * pn; it.sca = 128 * pn; it.scb = 2816 + 128 * pn; it.k0 = 64 * kt; }
  else if (kind == 1) { const int nt = r / 44, kt = r % 44; it.W = a.in[13] + (size_t)m * 2816 * 1024; it.WT = (bf16_t*)(a.ws + WS_WFO) + (size_t)m * 1024 * 2816; it.Nsrc = 1024; it.K = 2816; it.n0 = 256 * nt; it.sca = 256 * nt; it.scb = 256 * nt + 128; it.k0 = 64 * kt; }
  else if (kind == 2) { const int nt = r >> 4, kt = r & 15; it.W = a.in[14] + (size_t)m * 1024 * NIN; it.WT = (bf16_t*)(a.ws + WS_WIN) + (size_t)m * NINP * 1024; it.Nsrc = NIN; it.K = 1024; it.n0 = 256 * nt; it.sca = 256 * nt; it.scb = 256 * nt + 128; it.k0 = 64 * kt; }
  else { const int nt = r >> 4, kt = r & 15; it.W = a.in[15] + (size_t)m * 1024 * 1024; it.WT = (bf16_t*)(a.ws + WS_WOUT) + (size_t)m * 1024 * 1024; it.Nsrc = 1024; it.K = 1024; it.n0 = 256 * nt; it.sca = 256 * nt; it.scb = 256 * nt + 128; it.k0 = 64 * kt; }
  return it;
}
#define CV_LOAD(v, it) do { const int c4_ = tid & 63, col_ = ((c4_ >> 5) ? (it).scb : (it).sca) + 4 * (c4_ & 31); _Pragma("unroll") for (int rr = 0; rr < 8; ++rr) { const int r_ = (tid >> 6) + 8 * rr; \
    v[rr] = (f32x4){0.f, 0.f, 0.f, 0.f}; if (col_ < (it).Nsrc) v[rr] = __builtin_nontemporal_load((const f32x4*)((it).W + (size_t)((it).k0 + r_) * (it).Nsrc + col_)); } } while (0)
DI void p0_convert_range(CArgs& a, unsigned char* ldsb, int tid, int lo, int hi, int j, int nj) {
  float* tile = (float*)ldsb;
  int idx = lo + j;
  if (idx >= hi) return;
  f32x4 v[8];
  CvItem it = cv_decode(a, idx);
  CV_LOAD(v, it);
  for (;;) {
    const int c4 = tid & 63;
#pragma unroll
    for (int rr = 0; rr < 8; ++rr) { const int r = (tid >> 6) + 8 * rr; float* tp = tile + r * 257 + 4 * c4; tp[0] = v[rr][0]; tp[1] = v[rr][1]; tp[2] = v[rr][2]; tp[3] = v[rr][3]; }
    __syncthreads();
    const int nxt = idx + nj;
    CvItem itn = it;
    if (nxt < hi) { itn = cv_decode(a, nxt); CV_LOAD(v, itn); }
    const int n = tid >> 1, kh = tid & 1;
#pragma unroll
    for (int q = 0; q < 4; ++q) {
      const float* sp = tile + (32 * kh + 8 * q) * 257 + n;
      u32x4 w; w.x = cvtpk(sp[0], sp[257]); w.y = cvtpk(sp[514], sp[771]); w.z = cvtpk(sp[1028], sp[1285]); w.w = cvtpk(sp[1542], sp[1799]);
      *(u32x4*)(it.WT + (size_t)(it.n0 + n) * it.K + it.k0 + 32 * kh + 8 * q) = w;
    }
    __syncthreads();
    if (nxt >= hi) break;
    idx = nxt; it = itn;
  }
}

DI void p0_modulation(CArgs& a, unsigned char* ldsb, int tid, int l, int j0, int nj) {
  float* sc = (float*)ldsb;
  float* red = sc + 3072;
  float* modp = (float*)(a.ws + WS_MODP);
  for (int i = tid; i < 3072; i += 512) { const int g = i >> 10, k = i & 1023; const float x = g == 0 ? a.in[8][k] : a.in[7][(g - 1) * 1024 + k]; sc[i] = x / (1.f + expf(-x)); }
  __syncthreads();
  for (int item = j0; item < 144; item += nj) {
    const int rem = item, nt = rem >> 2, kq = rem & 3, n0 = nt * 256, c4 = tid & 63, kg = tid >> 6;
    const int kbase = kq * 256 + kg * 32;
    const float* wp = a.in[9] + (size_t)l * 1024 * 9216 + (size_t)kbase * 9216 + n0 + 4 * c4;
    f32x4 acc0 = {0, 0, 0, 0}, acc1 = {0, 0, 0, 0}, acc2 = {0, 0, 0, 0};
#pragma unroll 16
    for (int kk = 0; kk < 32; ++kk) {
      const f32x4 w = __builtin_nontemporal_load((const f32x4*)(wp + (size_t)kk * 9216));
      const int k = kbase + kk;
      acc0 += w * sc[k]; acc1 += w * sc[1024 + k]; acc2 += w * sc[2048 + k];
    }
    float* rp = red + kg * 768 + 4 * c4;
#pragma unroll
    for (int e = 0; e < 4; ++e) { rp[e] = acc0[e]; rp[256 + e] = acc1[e]; rp[512 + e] = acc2[e]; }
    __syncthreads();
    for (int o = tid; o < 768; o += 512) {
      const int g = o >> 8, n = o & 255; float s = 0.f;
#pragma unroll
      for (int q = 0; q < 8; ++q) s += red[q * 768 + o];
      modp[(size_t)kq * 55296 + (size_t)(l * 3 + g) * 9216 + n0 + n] = s;
    }
    __syncthreads();
  }
}
DI void mod_finalize(CArgs& a, int tid, int lsel) {
  const float* modp = (const float*)(a.ws + WS_MODP); float* mod = (float*)(a.ws + WS_MOD);
  for (int idx = lsel * 27648 + BID() * 512 + tid; idx < (lsel + 1) * 27648; idx += gridDim.x * 512) {
    const int l = lsel, n = idx % 9216;
    mod[idx] = modp[idx] + modp[55296 + idx] + modp[2 * 55296 + idx] + modp[3 * 55296 + idx] + a.in[10][l * 9216 + n];
  }
}

DI void p0_filters(CArgs& a, unsigned char* ldsb, int tid, int lo, int hi, int j0, int nj) {
  float* w3s = (float*)ldsb;
  float* w1s = w3s + 16384;
  float* w2s = w1s + 2112;
  float* prm = w2s + 4096;
  float* zs = prm + 256;
  float* h1s = zs + 64 * 34;
  float* h2s = h1s + 64 * 65;
  bf16_t* F = (bf16_t*)(a.ws + WS_FILT);
  const int lane = tid & 63, tq = tid >> 6;
  for (int item = lo + j0; item < hi; item += nj) {
    const int l = item / 80, r = item % 80, tbk = r >> 2, qq = r & 3;
    const int L = tbk < 4 ? 256 : 1024, t0 = tbk < 4 ? 64 * tbk : 64 * (tbk - 4), Loff = tbk < 4 ? 0 : 512;
    {
      const float* w3 = a.in[25] + (size_t)l * 64 * 1024 + 256 * qq;
#pragma unroll
      for (int k = 0; k < 8; ++k) { const int e = tid + 512 * k, row = e >> 6, c4 = e & 63; *(f32x4*)(w3s + row * 256 + 4 * c4) = *(const f32x4*)(w3 + (size_t)row * 1024 + 4 * c4); }
      for (int e = tid; e < 2112; e += 512) w1s[e] = a.in[21][l * 2112 + e];
#pragma unroll
      for (int k = 0; k < 8; ++k) w2s[tid + 512 * k] = a.in[23][l * 4096 + tid + 512 * k];
      if (tid < 256) { const int which = tid >> 6, j = tid & 63; prm[tid] = which == 0 ? a.in[22][l * 64 + j] : which == 1 ? a.in[24][l * 64 + j] : a.in[26][(l * 2 + (which - 2)) * 64 + j]; }
      for (int e = tid; e < 64 * 33; e += 512) {
        const int tl = e / 33, f = e - tl * 33, t = t0 + tl;
        const float tt = (float)t / (float)(L - 1), wt = (6.283185307179586f / (float)L) * (float)t;
        float z;
        if (f == 0) z = tt; else { const int bi = (f - 1) & 15; const float band = 1e-4f + (float)bi * ((15.f - 1e-4f) / 15.f); z = f <= 16 ? __cosf(band * wt) : -__sinf(band * wt); }
        zs[tl * 34 + f] = z;
      }
    }
    __syncthreads();
#pragma unroll
    for (int k = 0; k < 8; ++k) {
      const int tl = 8 * tq + k; float s = prm[lane];
      for (int i = 0; i < 33; ++i) s += zs[tl * 34 + i] * w1s[i * 64 + lane];
      h1s[tl * 65 + lane] = __sinf(prm[128 + lane] * s);
    }
    __syncthreads();
#pragma unroll
    for (int k = 0; k < 8; ++k) {
      const int tl = 8 * tq + k; float s = prm[64 + lane];
      for (int i = 0; i < 64; ++i) s += h1s[tl * 65 + i] * w2s[i * 64 + lane];
      h2s[tl * 65 + lane] = __sinf(prm[192 + lane] * s);
    }
    __syncthreads();
    f32x4 acc[8];
#pragma unroll
    for (int k = 0; k < 8; ++k) acc[k] = (f32x4){0.f, 0.f, 0.f, 0.f};
#pragma unroll 4
    for (int i = 0; i < 64; ++i) {
      const f32x4 wv = *(const f32x4*)(w3s + i * 256 + 4 * lane);
#pragma unroll
      for (int k = 0; k < 8; ++k) acc[k] += wv * h2s[(8 * tq + k) * 65 + i];
    }
    __syncthreads();
    bf16_t* st = (bf16_t*)w3s;
#pragma unroll
    for (int e = 0; e < 4; ++e) {
      const int ch = 4 * lane + e;
      const float d0 = -4.605170185988091f / 1.5f, d1 = -4.605170185988091f / 0.3f;
      const float ad = fabsf(d0 + (float)ch * ((d1 - d0) / 255.f));
#pragma unroll
      for (int k = 0; k < 8; ++k) {
        const int t = t0 + 8 * tq + k;
        st[ch * 66 + 8 * tq + k] = f2bf(acc[k][e] * __expf(-((float)t / (float)(L - 1)) * ad));
      }
    }
    __syncthreads();
    {
      const int dir = qq >> 1, o = qq & 1, t = t0 + lane;
#pragma unroll 8
      for (int cc = 0; cc < 32; ++cc) {
        const int ch = 32 * tq + cc;
        bf16_t* fp = F + ((size_t)((l * 2 + o) * 256 + ch)) * 2560 + Loff;
        const bf16_t v = st[ch * 66 + lane];
        if (dir == 0) fp[L - t] = v;
        else { if (t == 0) fp[0] = 0; else fp[L + t] = v; }
      }
    }
    __syncthreads();
  }
}

DI const float* xrow(const float* A, const float* B, int row) { return row < MCTX ? A + (size_t)row * DM : B + (size_t)(row - MCTX) * DM; }
DI int grp_of(int row) { return row < MCTX ? 0 : 1 + ((row - MCTX) >> 10); }

constexpr int RB = 5;
DI void norm_mod_phase(const float* srcA, const float* srcB, bf16_t* xn, const float* ng, const float* mod_l, int j, int tid, const float* modp, const float* bmod) {
  const int w = tid >> 6, lane = tid & 63, stride = gridDim.x * 8;
  for (int base = BID() * 8 + w; base < MT; base += stride * RB) {
    f32x4 v[RB][4];
#pragma unroll
    for (int r = 0; r < RB; ++r) {
      const int row = base + r * stride;
      if (row < MT) { const float* x = xrow(srcA, srcB, row);
#pragma unroll
        for (int q = 0; q < 4; ++q) v[r][q] = *(const f32x4*)(x + 256 * q + 4 * lane); }
      else {
#pragma unroll
        for (int q = 0; q < 4; ++q) v[r][q] = (f32x4){0.f, 0.f, 0.f, 0.f}; }
    }
#pragma unroll
    for (int r = 0; r < RB; ++r) {
      const int row = base + r * stride;
      float ss = 0.f;
#pragma unroll
      for (int q = 0; q < 4; ++q) ss += v[r][q][0] * v[r][q][0] + v[r][q][1] * v[r][q][1] + v[r][q][2] * v[r][q][2] + v[r][q][3] * v[r][q][3];
      ss = wave_sum(ss);
      const float rstd = rsqrtf(ss * (1.f / 1024.f) + EPSF);
      if (row < MT) {
        const float* mg = mod_l + (size_t)grp_of(row) * 9216 + (3 * j) * 1024;
#pragma unroll
        for (int q = 0; q < 4; ++q) {
          const int k = 256 * q + 4 * lane;
          const f32x4 g = *(const f32x4*)(ng + k);
          f32x4 sh, sc;
          if (modp) {
            const size_t o = (size_t)grp_of(row) * 9216 + (3 * j) * 1024 + k;
            sh = *(const f32x4*)(modp + o) + *(const f32x4*)(modp + 55296 + o) + *(const f32x4*)(modp + 2 * 55296 + o) + *(const f32x4*)(modp + 3 * 55296 + o) + *(const f32x4*)(bmod + (3 * j) * 1024 + k);
            sc = *(const f32x4*)(modp + o + 1024) + *(const f32x4*)(modp + 55296 + o + 1024) + *(const f32x4*)(modp + 2 * 55296 + o + 1024) + *(const f32x4*)(modp + 3 * 55296 + o + 1024) + *(const f32x4*)(bmod + (3 * j) * 1024 + 1024 + k);
          } else { sh = *(const f32x4*)(mg + k); sc = *(const f32x4*)(mg + 1024 + k); }
          const f32x4 y = (v[r][q] * rstd * g) * (sc + 1.f) + sh;
          u32x2 o; o.x = cvtpk(y[0], y[1]); o.y = cvtpk(y[2], y[3]);
          *(u32x2*)(xn + (size_t)row * DM + k) = o;
        }
      }
    }
  }
}

DI void final_norm_phase(const float* h, float* out, const float* fg, int tid) {
  const int w = tid >> 6, lane = tid & 63, stride = gridDim.x * 8;
  for (int base = BID() * 8 + w; base < MT; base += stride * RB) {
    f32x4 v[RB][4];
#pragma unroll
    for (int r = 0; r < RB; ++r) {
      const int row = base + r * stride;
      if (row < MT) {
#pragma unroll
        for (int q = 0; q < 4; ++q) v[r][q] = *(const f32x4*)(h + (size_t)row * DM + 256 * q + 4 * lane); }
      else {
#pragma unroll
        for (int q = 0; q < 4; ++q) v[r][q] = (f32x4){0.f, 0.f, 0.f, 0.f}; }
    }
#pragma unroll
    for (int r = 0; r < RB; ++r) {
      const int row = base + r * stride;
      float ss = 0.f;
#pragma unroll
      for (int q = 0; q < 4; ++q) ss += v[r][q][0] * v[r][q][0] + v[r][q][1] * v[r][q][1] + v[r][q][2] * v[r][q][2] + v[r][q][3] * v[r][q][3];
      ss = wave_sum(ss);
      const float rstd = rsqrtf(ss * (1.f / 1024.f) + EPSF);
      if (row < MT) {
#pragma unroll
        for (int q = 0; q < 4; ++q) { const int k = 256 * q + 4 * lane; *(f32x4*)(out + (size_t)row * DM + k) = v[r][q] * rstd * *(const f32x4*)(fg + k); }
      }
    }
  }
}

DI int pp_base(int s) { return (s < 4) ? U_QA + 64 * s : (s < 6) ? U_KA + 64 * (s - 4) : (s < 10) ? U_QC + 64 * (s - 6) : U_KC + 64 * (s - 10); }
DI void post_proj_phase(bf16_t* U, bf16_t* Ud, float* out, const float* qkg, int l, int tid) {
  const int w = tid >> 6, lane = tid & 63, stride = gridDim.x * 8;
  const float g0 = qkg[lane], g1 = qkg[64 + lane];
  for (int base = BID() * 8 + w; base < MT; base += stride * RB) {
    float xv[RB][12];
#pragma unroll
    for (int r = 0; r < RB; ++r) {
      const int row = base + r * stride;
#pragma unroll
      for (int s = 0; s < 12; ++s) xv[r][s] = row < MT ? bf2f(U[(size_t)row * UW + pp_base(s) + lane]) : 0.f;
    }
#pragma unroll
    for (int r = 0; r < RB; ++r) {
      const int row = base + r * stride;
      const bool lat = row >= MCTX;
      float cs = 1.f, sn = 0.f;
      if (lat) {
        const int t = (row - MCTX) & 1023, i = lane & 31, f = i & 15;
        const float inv = exp2f(-(float)f * (13.287712379549449f / 16.f));
        const float ang = (float)(i < 16 ? (t >> 6) : (t & 63)) * inv;
        sincosf(ang, &sn, &cs);
      }
#pragma unroll
      for (int s = 0; s < 12; ++s) {
        const bool isq = (s < 4) || (s >= 6 && s < 10), nrm = s >= 6;
        float x = xv[r][s];
        if (nrm) { const float ss = wave_sum(x * x); x = x * rsqrtf(ss * (1.f / 64.f) + EPSF) * (s < 10 ? g0 : g1); }
        if (lat) { const float p = __shfl_xor(x, 32, 64); x = lane < 32 ? x * cs - p * sn : x * cs + p * sn; }
        if (row < MT) {
          if (s >= 10 && !lat) { const int b = row >> 8, t = row & 255; out[OUT_GQAK + ((size_t)(b * 512 + l * 256 + t)) * 128 + (s - 10) * 64 + lane] = x; }
          if (isq) x *= QSCALE;
          if (Ud) Ud[(size_t)row * UW + pp_base(s) + lane] = f2bf(x);
        }
      }
    }
  }
}

struct KVRegs { u32x4 k, v; };
constexpr int KROW = 72;
constexpr int KVBUF = 64 * KROW * 2;

DI KVRegs attn_load(const bf16_t* __restrict__ U, int R0, int kcol, int vcol, int k0start, int nt0, const float* __restrict__ ck, const float* __restrict__ cv, int ti, int tid) {
  KVRegs r; const int key = tid >> 3, ds = tid & 7;
  if (ti < nt0) {
    const bf16_t* p = U + (size_t)(R0 + k0start + 64 * ti + key) * UW;
    r.k = *(const u32x4*)(p + kcol + 8 * ds); r.v = *(const u32x4*)(p + vcol + 8 * ds);
  } else {
    const size_t off = (size_t)(64 * (ti - nt0) + key) * 128 + 8 * ds;
    const f32x4 a0 = *(const f32x4*)(ck + off), a1 = *(const f32x4*)(ck + off + 4), b0 = *(const f32x4*)(cv + off), b1 = *(const f32x4*)(cv + off + 4);
    r.k.x = cvtpk(a0[0], a0[1]); r.k.y = cvtpk(a0[2], a0[3]); r.k.z = cvtpk(a1[0], a1[1]); r.k.w = cvtpk(a1[2], a1[3]);
    r.v.x = cvtpk(b0[0], b0[1]); r.v.y = cvtpk(b0[2], b0[3]); r.v.z = cvtpk(b1[0], b1[1]); r.v.w = cvtpk(b1[2], b1[3]);
  }
  return r;
}
DI void attn_write(unsigned char* kb, unsigned char* vb, const KVRegs& r, int tid) {
  const int key = tid >> 3, ds = tid & 7;
  *(u32x4*)(kb + (key * KROW + 8 * ds) * 2) = r.k;
  bf16_t* vt = (bf16_t*)vb + (8 * ds) * KROW + key;
  vt[0] = (bf16_t)(r.v.x & 0xffff); vt[KROW] = (bf16_t)(r.v.x >> 16); vt[2 * KROW] = (bf16_t)(r.v.y & 0xffff); vt[3 * KROW] = (bf16_t)(r.v.y >> 16);
  vt[4 * KROW] = (bf16_t)(r.v.z & 0xffff); vt[5 * KROW] = (bf16_t)(r.v.z >> 16); vt[6 * KROW] = (bf16_t)(r.v.w & 0xffff); vt[7 * KROW] = (bf16_t)(r.v.w >> 16);
}

DI void attn_unit(CArgs& a, int l, int uidx, unsigned char* ldsb, int tid) {
  const bf16_t* U = (const bf16_t*)(a.ws + WS_ACT);
  bf16_t* O = (bf16_t*)(a.ws + WS_O);
  int type, b, kvh, qb;
  if (uidx < 64) { type = uidx < 32 ? 3 : 2; const int j = uidx & 31; b = j >> 4; kvh = (j >> 3) & 1; qb = j & 7; }
  else { type = uidx < 192 ? 0 : 1; const int j = (uidx - 64) & 127; b = j >> 2; kvh = (j >> 1) & 1; qb = j & 1; }
  const bool lat = type >= 2, isA = (type == 0 || type == 2);
  const int R0 = lat ? MCTX + b * 1024 : b * 256;
  const int w = tid >> 6, lane = tid & 63, hh = lane >> 5, l31 = lane & 31, g = w >> 2, head = 2 * kvh + g;
  const int qcol = (isA ? U_QA : U_QC) + head * 64, kcol = (isA ? U_KA : U_KC) + kvh * 64, vcol = (isA ? U_VA : U_VC) + kvh * 64;
  int k0start = 0, nk0 = lat ? 1024 : 256;
  if (type == 2) { const int lo = qb > 0 ? (qb - 1) * 128 : 0, hi = qb < 7 ? (qb + 2) * 128 : 1024; k0start = lo; nk0 = hi - lo; }
  const int nt0 = nk0 >> 6, nt = nt0 + (lat ? 8 : 0);
  const float* ck = nullptr; const float* cv = nullptr;
  if (lat) { const size_t co = ((size_t)((b * 2 + l) * 512)) * 128 + kvh * 64; ck = a.in[isA ? 2 : 4] + co; cv = a.in[isA ? 3 : 5] + co; }
  const int qrow = R0 + qb * 128 + (w & 3) * 32 + l31;
  const int qpos = qb * 128 + (w & 3) * 32 + l31;
  bf16x8 qf[4];
#pragma unroll
  for (int ks = 0; ks < 4; ++ks) qf[ks] = *(const bf16x8*)(U + (size_t)qrow * UW + qcol + 16 * ks + 8 * hh);
  float m_run = -1e30f, l_run = 0.f;
  if (isA) { m_run = a.in[17][l * 4 + head] * 1.4426950408889634f; l_run = hh == 0 ? 1.f : 0.f; }
  f32x16 o0, o1;
#pragma unroll
  for (int i = 0; i < 16; ++i) { o0[i] = 0.f; o1[i] = 0.f; }
  KVRegs regs = attn_load(U, R0, kcol, vcol, k0start, nt0, ck, cv, 0, tid);
  attn_write(ldsb, ldsb + KVBUF, regs, tid);
  __syncthreads();
  for (int ti = 0; ti < nt; ++ti) {
    const int cur = ti & 1;
    if (ti + 1 < nt) regs = attn_load(U, R0, kcol, vcol, k0start, nt0, ck, cv, ti + 1, tid);
    const unsigned char* kb = cur ? ldsb + 2 * KVBUF : ldsb;
    const unsigned char* vb = kb + KVBUF;
    const bool domask = (type == 2) && (ti < nt0);
#pragma unroll
    for (int sub = 0; sub < 2; ++sub) {
      f32x16 s;
#pragma unroll
      for (int i = 0; i < 16; ++i) s[i] = 0.f;
#pragma unroll
      for (int ks = 0; ks < 4; ++ks) {
        const bf16x8 ka = *(const bf16x8*)(kb + ((32 * sub + l31) * KROW + 16 * ks + 8 * hh) * 2);
        s = __builtin_amdgcn_mfma_f32_32x32x16_bf16(ka, qf[ks], s, 0, 0, 0);
      }
      if (domask) {
        const int kp0 = k0start + 64 * ti + 32 * sub;
#pragma unroll
        for (int i = 0; i < 16; ++i) { const int d = qpos - (kp0 + crow(i, hh)); if (d > 128 || d < -128) s[i] = -1e30f; }
      }
      float mt = s[0];
#pragma unroll
      for (int i = 1; i < 16; ++i) mt = fmaxf(mt, s[i]);
      mt = fmaxf(mt, __shfl_xor(mt, 32, 64));
      const float mn = fmaxf(m_run, mt);
      const float alpha = __builtin_amdgcn_exp2f(m_run - mn);
      m_run = mn;
      float ps = 0.f;
#pragma unroll
      for (int i = 0; i < 16; ++i) { s[i] = __builtin_amdgcn_exp2f(s[i] - mn); ps += s[i]; }
      l_run = l_run * alpha + ps;
#pragma unroll
      for (int i = 0; i < 16; ++i) { o0[i] *= alpha; o1[i] *= alpha; }
#pragma unroll
      for (int st = 0; st < 2; ++st) {
        u32x4 pw; pw.x = cvtpk(s[8 * st], s[8 * st + 1]); pw.y = cvtpk(s[8 * st + 2], s[8 * st + 3]); pw.z = cvtpk(s[8 * st + 4], s[8 * st + 5]); pw.w = cvtpk(s[8 * st + 6], s[8 * st + 7]);
        const bf16x8 pf = __builtin_bit_cast(bf16x8, pw);
        const int kofs = 32 * sub + 16 * st + 4 * hh;
        {
          const u32x2 lo = *(const u32x2*)(vb + (l31 * KROW + kofs) * 2), hi = *(const u32x2*)(vb + (l31 * KROW + kofs + 8) * 2);
          u32x4 vw; vw.x = lo.x; vw.y = lo.y; vw.z = hi.x; vw.w = hi.y;
          o0 = __builtin_amdgcn_mfma_f32_32x32x16_bf16(__builtin_bit_cast(bf16x8, vw), pf, o0, 0, 0, 0);
        }
        {
          const u32x2 lo = *(const u32x2*)(vb + ((32 + l31) * KROW + kofs) * 2), hi = *(const u32x2*)(vb + ((32 + l31) * KROW + kofs + 8) * 2);
          u32x4 vw; vw.x = lo.x; vw.y = lo.y; vw.z = hi.x; vw.w = hi.y;
          o1 = __builtin_amdgcn_mfma_f32_32x32x16_bf16(__builtin_bit_cast(bf16x8, vw), pf, o1, 0, 0, 0);
        }
      }
    }
    if (ti + 1 < nt) { unsigned char* nb = cur ? ldsb : ldsb + 2 * KVBUF; attn_write(nb, nb + KVBUF, regs, tid); }
    __syncthreads();
  }
  const float lt = l_run + __shfl_xor(l_run, 32, 64);
  const float inv = 1.f / lt;
  bf16_t* ost = (bf16_t*)(ldsb + w * (32 * KROW * 2));
#pragma unroll
  for (int gq = 0; gq < 4; ++gq) {
    u32x2 p0, p1;
    p0.x = cvtpk(o0[4 * gq] * inv, o0[4 * gq + 1] * inv); p0.y = cvtpk(o0[4 * gq + 2] * inv, o0[4 * gq + 3] * inv);
    p1.x = cvtpk(o1[4 * gq] * inv, o1[4 * gq + 1] * inv); p1.y = cvtpk(o1[4 * gq + 2] * inv, o1[4 * gq + 3] * inv);
    *(u32x2*)(ost + l31 * KROW + 8 * gq + 4 * hh) = p0;
    *(u32x2*)(ost + l31 * KROW + 32 + 8 * gq + 4 * hh) = p1;
  }
  __syncthreads();
  {
    const int q = lane >> 1, half = lane & 1;
    const int orow = R0 + qb * 128 + (w & 3) * 32 + q;
    bf16_t* op = O + (size_t)orow * 768 + (isA ? 0 : 256) + head * 64 + 32 * half;
    const bf16_t* sp = ost + q * KROW + 32 * half;
#pragma unroll
    for (int e = 0; e < 4; ++e) *(u32x4*)(op + 8 * e) = *(const u32x4*)(sp + 8 * e);
  }
  __syncthreads();
}

DI void hyena_unit(CArgs& a, int l, int conv, int c, int type, unsigned char* ldsb, int tid) {
  const int L = type ? 1024 : 256, nseq = type ? 2 : 32, tokbase = type ? MCTX : 0, L2 = 2 * L, L3 = 3 * L, CPS = L2 + 8;
  bf16_t* cp = (bf16_t*)ldsb;
  bf16_t* up = (bf16_t*)(ldsb + 33024);
  bf16_t* gt = (bf16_t*)(ldsb + 33024 + 49152);
  float* red = (float*)(ldsb + 33024 + 49152 + 16384);
  const bf16_t* HYT = (const bf16_t*)(a.ws + WS_HYT);
  bf16_t* Y1T = (bf16_t*)(a.ws + WS_Y1T);
  bf16_t* OBT = (bf16_t*)(a.ws + WS_OBT);
  const bf16_t* Kr = (const bf16_t*)(a.ws + WS_FILT) + ((size_t)((l * 2 + conv) * 256 + c)) * 2560 + (type ? 512 : 0);
  const float* cw = a.in[19] + l * 3 * 768; const float* cb = a.in[20] + l * 768;
  const int gc = (conv == 0 ? 256 : 512) + c;
  const float vw0 = cw[c], vw1 = cw[768 + c], vw2 = cw[1536 + c], vb = cb[c];
  const float gw0 = cw[gc], gw1 = cw[768 + gc], gw2 = cw[1536 + gc], gb = cb[gc];
  const int ntok = nseq * L, nch = L2 >> 3, nck = ntok >> 3;
  bf16_t* rawv = (bf16_t*)red;
  bf16_t* rawg = rawv + ntok + 16;
  {
    if (tid < nch) *(u32x4*)(cp + 8 * tid) = *(const u32x4*)(Kr + 8 * tid);
    const bf16_t* sg = HYT + (size_t)gc * MT + tokbase;
    const bf16_t* sv = (conv == 0 ? HYT : (const bf16_t*)Y1T) + (size_t)c * MT + tokbase;
    for (int ck = tid; ck < nck; ck += 512) {
      *(u32x4*)(rawg + 8 + 8 * ck) = *(const u32x4*)(sg + 8 * ck);
      *(u32x4*)(rawv + 8 + 8 * ck) = *(const u32x4*)(sv + 8 * ck);
    }
  }
  __syncthreads();
  if (tid < nch) {
    const u32x4 lo = *(const u32x4*)(cp + 8 * tid), hi = *(const u32x4*)(cp + 8 * tid + 8);
    const unsigned wv[8] = {lo.x, lo.y, lo.z, lo.w, hi.x, hi.y, hi.z, hi.w};
#pragma unroll
    for (int r = 1; r < 8; ++r) {
      u32x4 o;
      if ((r & 1) == 0) { o.x = wv[r / 2]; o.y = wv[r / 2 + 1]; o.z = wv[r / 2 + 2]; o.w = wv[r / 2 + 3]; }
      else { const int b = (r - 1) / 2;
        o.x = (wv[b] >> 16) | (wv[b + 1] << 16); o.y = (wv[b + 1] >> 16) | (wv[b + 2] << 16); o.z = (wv[b + 2] >> 16) | (wv[b + 3] << 16); o.w = (wv[b + 3] >> 16) | (wv[b + 4] << 16); }
      *(u32x4*)(cp + r * CPS + 8 * tid) = o;
    }
  }
  for (int ck = tid; ck < nck; ck += 512) {
    const int t0 = 8 * ck, s = t0 / L, p0 = t0 - s * L;
    const bool first = p0 == 0, last = p0 + 8 == L;
    float gx[10], vx[10];
    { const u32x4 m = *(const u32x4*)(rawg + 8 + t0);
      gx[0] = first ? 0.f : bf2f(rawg[8 + t0 - 1]); gx[9] = last ? 0.f : bf2f(rawg[8 + t0 + 8]);
      gx[1] = bflo(m.x); gx[2] = bfhi(m.x); gx[3] = bflo(m.y); gx[4] = bfhi(m.y); gx[5] = bflo(m.z); gx[6] = bfhi(m.z); gx[7] = bflo(m.w); gx[8] = bfhi(m.w); }
    u32x4 go, uo;
    { float y[8];
#pragma unroll
      for (int e = 0; e < 8; ++e) y[e] = gw0 * gx[e] + gw1 * gx[e + 1] + gw2 * gx[e + 2] + gb;
      go.x = cvtpk(y[0], y[1]); go.y = cvtpk(y[2], y[3]); go.z = cvtpk(y[4], y[5]); go.w = cvtpk(y[6], y[7]); }
    const u32x4 mv = *(const u32x4*)(rawv + 8 + t0);
    if (conv == 0) {
      vx[0] = first ? 0.f : bf2f(rawv[8 + t0 - 1]); vx[9] = last ? 0.f : bf2f(rawv[8 + t0 + 8]);
      vx[1] = bflo(mv.x); vx[2] = bfhi(mv.x); vx[3] = bflo(mv.y); vx[4] = bfhi(mv.y); vx[5] = bflo(mv.z); vx[6] = bfhi(mv.z); vx[7] = bflo(mv.w); vx[8] = bfhi(mv.w);
      float y[8];
#pragma unroll
      for (int e = 0; e < 8; ++e) y[e] = vw0 * vx[e] + vw1 * vx[e + 1] + vw2 * vx[e + 2] + vb;
      uo.x = cvtpk(y[0], y[1]); uo.y = cvtpk(y[2], y[3]); uo.z = cvtpk(y[4], y[5]); uo.w = cvtpk(y[6], y[7]);
    } else uo = mv;
    *(u32x4*)(gt + t0) = go;
    bf16_t* ub = up + s * L3 + p0;
    const u32x4 zz = {0u, 0u, 0u, 0u};
    *(u32x4*)(ub) = zz; *(u32x4*)(ub + L) = uo; *(u32x4*)(ub + L2) = zz;
  }
  __syncthreads();
  const int w = tid >> 6, lane = tid & 63, hh = lane >> 5, i = lane & 31, r = (8 - (i & 7)) & 7;
  int aa, sq, mlo, mhi;
  if (type == 0) { aa = i & 7; sq = 4 * w + (i >> 3); mlo = -7; mhi = 7; }
  else { aa = i; sq = w >> 2; mlo = -31 + 16 * (w & 3); mhi = mlo + 15 > 31 ? 31 : mlo + 15; }
  const bf16_t* useq = up + sq * L3;
  const bf16_t* cpr = cp + r * CPS;
  f32x16 acc;
#pragma unroll
  for (int q = 0; q < 16; ++q) acc[q] = 0.f;
  for (int m = mlo; m <= mhi; ++m) {
#pragma unroll
    for (int ks = 0; ks < 2; ++ks) {
      const int xi0 = L + 16 * ks + 8 * hh - i - 32 * m;
      const bf16x8 A = *(const bf16x8*)(cpr + (xi0 - r));
      const bf16x8 B = *(const bf16x8*)(useq + 32 * (aa - m) + 16 * ks + 8 * hh + L);
      acc = __builtin_amdgcn_mfma_f32_32x32x16_bf16(A, B, acc, 0, 0, 0);
    }
  }
  if (type == 1) {
#pragma unroll
    for (int q = 0; q < 16; ++q) red[w * 1024 + q * 64 + lane] = acc[q];
    __syncthreads();
    if ((w & 3) == 0) {
#pragma unroll
      for (int q = 0; q < 16; ++q) acc[q] += red[(w + 1) * 1024 + q * 64 + lane] + red[(w + 2) * 1024 + q * 64 + lane] + red[(w + 3) * 1024 + q * 64 + lane];
    }
  }
  if (type == 0 || (w & 3) == 0) {
    const float bias = a.in[27][(l * 2 + conv) * 256 + c];
    bf16_t* dst = (conv == 0 ? Y1T : OBT) + (size_t)c * MT + tokbase + sq * L;
#pragma unroll
    for (int gq = 0; gq < 4; ++gq) {
      float y[4];
#pragma unroll
      for (int e = 0; e < 4; ++e) {
        const int t = 32 * aa + 8 * gq + 4 * hh + e;
        y[e] = (acc[4 * gq + e] + bias * bf2f(useq[L + t])) * bf2f(gt[sq * L + t]);
      }
      u32x2 o; o.x = cvtpk(y[0], y[1]); o.y = cvtpk(y[2], y[3]);
      *(u32x2*)(dst + 32 * aa + 8 * gq + 4 * hh) = o;
    }
  }
  __syncthreads();
}

struct GlaLds { float *qs, *ks, *vs, *gls, *Ws, *bs, *gb, *A1, *A2; };
DI GlaLds gla_lds(unsigned char* ldsb) {
  GlaLds g; float* p = (float*)ldsb;
  g.qs = p; p += 64 * 33; g.ks = p; p += 64 * 33; g.vs = p; p += 64 * 65; g.gls = p; p += 64 * 32; g.Ws = p; p += 1024; g.bs = p; p += 64;
  g.gb = p; p += 2 * 64 * 33; g.A1 = p; p += 64 * 65; g.A2 = p; p += 64 * 65; return g;
}
DI int gla_row0(int seq, int cidx) { return (seq < 32 ? seq * 256 : MCTX + (seq - 32) * 1024) + 64 * cidx; }
DI int gla_gc(int seq, int n) { return (seq < 32 ? 4 * seq : 128 + 16 * (seq - 32)) + n; }

DI void gla_prep(CArgs& a, int l, int seq, int h, int cidx, const GlaLds& G, int tid) {
  const bf16_t* U = (const bf16_t*)(a.ws + WS_ACT);
  const int R0 = gla_row0(seq, cidx);
  { const int i = tid >> 3, d4 = (tid & 7) * 4; const bf16_t* rp = U + (size_t)(R0 + i) * UW;
    const u32x2 qv = *(const u32x2*)(rp + U_QD + h * 32 + d4), kv = *(const u32x2*)(rp + U_KD + h * 32 + d4);
    float* qd = G.qs + i * 33 + d4; qd[0] = bflo(qv.x); qd[1] = bfhi(qv.x); qd[2] = bflo(qv.y); qd[3] = bfhi(qv.y);
    float* kd = G.ks + i * 33 + d4; kd[0] = bflo(kv.x); kd[1] = bfhi(kv.x); kd[2] = bflo(kv.y); kd[3] = bfhi(kv.y);
    const int v8 = (tid & 7) * 8; const u32x4 vv = *(const u32x4*)(rp + U_VD + h * 64 + v8);
    float* vd = G.vs + i * 65 + v8; vd[0] = bflo(vv.x); vd[1] = bfhi(vv.x); vd[2] = bflo(vv.y); vd[3] = bfhi(vv.y); vd[4] = bflo(vv.z); vd[5] = bfhi(vv.z); vd[6] = bflo(vv.w); vd[7] = bfhi(vv.w);
    if (tid < 256) { const int i2 = tid >> 2, c8 = (tid & 3) * 8; const u32x4 gv = *(const u32x4*)(U + (size_t)(R0 + i2) * UW + U_GD + c8);
      float* gd = G.gls + i2 * 32 + c8; gd[0] = bflo(gv.x); gd[1] = bfhi(gv.x); gd[2] = bflo(gv.y); gd[3] = bfhi(gv.y); gd[4] = bflo(gv.z); gd[5] = bfhi(gv.z); gd[6] = bflo(gv.w); gd[7] = bfhi(gv.w); }
  }
  for (int e = tid; e < 1024; e += 512) { const int z = e >> 9, r = (e >> 5) & 15, d = e & 31; G.Ws[e] = a.in[28][(size_t)((l * 2 + z) * 16 + r) * 128 + h * 32 + d]; }
  if (tid < 64) G.bs[tid] = a.in[29][(l * 2 + (tid >> 5)) * 128 + h * 32 + (tid & 31)];
  for (int e = tid; e < 64 * 65; e += 512) { G.A1[e] = 0.f; G.A2[e] = 0.f; }
  __syncthreads();
#pragma unroll
  for (int e = 0; e < 8; ++e) {
    const int idx = tid * 8 + e, z = idx >> 11, i = (idx >> 5) & 63, d = idx & 31;
    float s = G.bs[z * 32 + d];
#pragma unroll
    for (int r = 0; r < 16; ++r) s += G.gls[i * 32 + z * 16 + r] * G.Ws[z * 512 + r * 32 + d];
    const float ls = fminf(s, 0.f) - log1pf(expf(-fabsf(s)));
    G.gb[z * 2112 + i * 33 + d] = ls * (1.f / 16.f);
  }
  __syncthreads();
  {
    const int w = tid >> 6, lane = tid & 63;
#pragma unroll
    for (int cc = 0; cc < 8; ++cc) {
      const int col = 8 * w + cc, z = col >> 5, d = col & 31, i = z == 0 ? lane : 63 - lane;
      float x = G.gb[z * 2112 + i * 33 + d];
#pragma unroll
      for (int o = 1; o < 64; o <<= 1) { const float y = __shfl_up(x, o, 64); if (lane >= o) x += y; }
      G.gb[z * 2112 + i * 33 + d] = x;
    }
  }
  __syncthreads();
}

constexpr float GLA_QS = 0.17677669529663687f;

DI void gla_a_unit(CArgs& a, int l, int uidx, unsigned char* ldsb, int tid) {
  int seq, h, cidx, nc;
  if (uidx < 512) { seq = uidx >> 4; h = (uidx >> 2) & 3; cidx = uidx & 3; nc = 4; } else { const int j = uidx - 512; seq = 32 + (j >> 6); h = (j >> 4) & 3; cidx = j & 15; nc = 16; }
  const GlaLds G = gla_lds(ldsb);
  gla_prep(a, l, seq, h, cidx, G, tid);
  const int w = tid >> 6, lane = tid & 63, hh = lane >> 5, l31 = lane & 31;
  const int R0 = gla_row0(seq, cidx);
  if (w < 6) {
    const int dir = w / 3, which = w % 3;
    const int ib = dir == 0 ? (which > 0) : (which == 2), jb = dir == 0 ? (which == 2) : (which > 0);
    const float* bz = G.gb + dir * 2112;
    f32x16 acc;
#pragma unroll
    for (int q = 0; q < 16; ++q) acc[q] = 0.f;
    const int ii = 32 * ib + l31, jj = 32 * jb + l31;
#pragma unroll 4
    for (int kk = 0; kk < 16; ++kk) {
      const int d = 2 * kk + hh;
      const float av = G.qs[ii * 33 + d] * __expf(bz[ii * 33 + d]) * GLA_QS;
      const float bv = G.ks[jj * 33 + d] * __expf(-bz[jj * 33 + d]);
      acc = __builtin_amdgcn_mfma_f32_32x32x2f32(av, bv, acc, 0, 0, 0);
    }
    float* Az = dir == 0 ? G.A1 : G.A2;
#pragma unroll
    for (int q = 0; q < 16; ++q) {
      const int i2 = 32 * ib + crow(q, hh);
      const bool keep = dir == 0 ? (jj <= i2) : (jj >= i2);
      Az[i2 * 65 + jj] = keep ? acc[q] : 0.f;
    }
  }
  __syncthreads();
  if (w < 4) {
    const int ib = w >> 1, vb = w & 1, ii = 32 * ib + l31;
    f32x16 acc;
#pragma unroll
    for (int q = 0; q < 16; ++q) acc[q] = 0.f;
#pragma unroll 4
    for (int kk = 0; kk < 32; ++kk) {
      const int j = 2 * kk + hh;
      const float av = G.A1[ii * 65 + j] + G.A2[ii * 65 + j];
      const float bv = G.vs[j * 65 + 32 * vb + l31];
      acc = __builtin_amdgcn_mfma_f32_32x32x2f32(av, bv, acc, 0, 0, 0);
    }
    float* od = (float*)(a.ws + WS_OD);
#pragma unroll
    for (int q = 0; q < 16; ++q) od[(size_t)(R0 + 32 * ib + crow(q, hh)) * 256 + h * 64 + 32 * vb + l31] = acc[q];
  } else {
    const int dir = (w - 4) >> 1, vb = w & 1;
    const float* bz = G.gb + dir * 2112;
    const float blast = dir == 0 ? bz[63 * 33 + l31] : bz[l31];
    f32x16 acc;
#pragma unroll
    for (int q = 0; q < 16; ++q) acc[q] = 0.f;
#pragma unroll 4
    for (int kk = 0; kk < 32; ++kk) {
      const int j = 2 * kk + hh;
      const float av = G.ks[j * 33 + l31] * __expf(blast - bz[j * 33 + l31]);
      const float bv = G.vs[j * 65 + 32 * vb + l31];
      acc = __builtin_amdgcn_mfma_f32_32x32x2f32(av, bv, acc, 0, 0, 0);
    }
    const int n = dir == 0 ? cidx : nc - 1 - cidx;
    const size_t gi = (size_t)(gla_gc(seq, n) * 4 + h) * 2 + dir;
    float* glc = (float*)(a.ws + WS_GLC) + gi * 2048;
#pragma unroll
    for (int q = 0; q < 16; ++q) glc[crow(q, hh) * 64 + 32 * vb + l31] = acc[q];
    if (vb == 0 && hh == 0) ((float*)(a.ws + WS_GLD))[gi * 32 + l31] = __expf(blast);
  }
  __syncthreads();
}

DI void gla_b_unit(CArgs& a, int l, int uidx, unsigned char* ldsb, int tid) {
  int seq, h, cidx, nc;
  if (uidx < 512) { seq = uidx >> 4; h = (uidx >> 2) & 3; cidx = uidx & 3; nc = 4; } else { const int j = uidx - 512; seq = 32 + (j >> 6); h = (j >> 4) & 3; cidx = j & 15; nc = 16; }
  const GlaLds G = gla_lds(ldsb);
  gla_prep(a, l, seq, h, cidx, G, tid);
  float* Ss = G.A1;
  const int w = tid >> 6, lane = tid & 63, hh = lane >> 5, l31 = lane & 31;
  const int R0 = gla_row0(seq, cidx);
  {
    const int dir = tid >> 8, e = tid & 255, d = e >> 3, v0 = (e & 7) * 8;
    float S[8];
    if (seq >= 32) { const float* sp = a.in[6] + ((size_t)((((seq - 32) * 2 + l) * 2 + dir) * 4 + h)) * 2048 + d * 64 + v0;
#pragma unroll
      for (int j = 0; j < 8; ++j) S[j] = sp[j]; }
    else {
#pragma unroll
      for (int j = 0; j < 8; ++j) S[j] = 0.f; }
    const int npos = dir == 0 ? cidx : nc - 1 - cidx;
    const float* glc = (const float*)(a.ws + WS_GLC); const float* gld = (const float*)(a.ws + WS_GLD);
    for (int n = 0; n < npos; n += 4) {
      float dec[4]; f32x4 c0[4], c1[4];
#pragma unroll
      for (int u = 0; u < 4; ++u) {
        dec[u] = 1.f; c0[u] = (f32x4){0.f, 0.f, 0.f, 0.f}; c1[u] = c0[u];
        if (n + u < npos) {
          const size_t gi = (size_t)(gla_gc(seq, n + u) * 4 + h) * 2 + dir;
          dec[u] = gld[gi * 32 + d]; c0[u] = *(const f32x4*)(glc + gi * 2048 + d * 64 + v0); c1[u] = *(const f32x4*)(glc + gi * 2048 + d * 64 + v0 + 4);
        }
      }
#pragma unroll
      for (int u = 0; u < 4; ++u) {
#pragma unroll
        for (int j = 0; j < 4; ++j) { S[j] = dec[u] * S[j] + c0[u][j]; S[4 + j] = dec[u] * S[4 + j] + c1[u][j]; }
      }
    }
#pragma unroll
    for (int j = 0; j < 8; ++j) Ss[dir * 2080 + d * 65 + v0 + j] = S[j];
    if (seq < 32 && npos == nc - 1) {
      const size_t gi = (size_t)(gla_gc(seq, npos) * 4 + h) * 2 + dir;
      const float dec = gld[gi * 32 + d];
      float* op = a.out + OUT_STATE + ((size_t)(((seq * 2 + l) * 2 + dir) * 4 + h)) * 2048 + d * 64 + v0;
#pragma unroll
      for (int j = 0; j < 8; ++j) op[j] = dec * S[j] + glc[gi * 2048 + d * 64 + v0 + j];
    }
  }
  __syncthreads();
  if (w < 4) {
    const int ib = w >> 1, vb = w & 1, ii = 32 * ib + l31;
    f32x16 acc;
#pragma unroll
    for (int q = 0; q < 16; ++q) acc[q] = 0.f;
#pragma unroll
    for (int dir = 0; dir < 2; ++dir) {
      const float* bz = G.gb + dir * 2112;
#pragma unroll 4
      for (int kk = 0; kk < 16; ++kk) {
        const int d = 2 * kk + hh;
        const float av = G.qs[ii * 33 + d] * __expf(bz[ii * 33 + d]) * GLA_QS;
        const float bv = Ss[dir * 2080 + d * 65 + 32 * vb + l31];
        acc = __builtin_amdgcn_mfma_f32_32x32x2f32(av, bv, acc, 0, 0, 0);
      }
    }
    const float* od = (const float*)(a.ws + WS_OD);
    bf16_t* O = (bf16_t*)(a.ws + WS_O);
#pragma unroll
    for (int q = 0; q < 16; ++q) {
      const int row = R0 + 32 * ib + crow(q, hh);
      O[(size_t)row * 768 + 512 + h * 64 + 32 * vb + l31] = f2bf(acc[q] + od[(size_t)row * 256 + h * 64 + 32 * vb + l31]);
    }
  }
  __syncthreads();
}

DI void merge_phase(CArgs& a, int l, unsigned char* ldsb, int tid) {
  bf16_t* obs = (bf16_t*)ldsb;
  const bf16_t* O = (const bf16_t*)(a.ws + WS_O); const bf16_t* OBT = (const bf16_t*)(a.ws + WS_OBT); const bf16_t* U = (const bf16_t*)(a.ws + WS_ACT);
  bf16_t* cat = (bf16_t*)(a.ws + WS_XN);
  const float* mg = a.in[16] + l * 1024;
  const int w = tid >> 6, lane = tid & 63;
  for (int tile = BID(); tile < MT / 32; tile += gridDim.x) {
    const int t0 = tile * 32;
    { const int c = tid >> 1, half = tid & 1;
      const u32x4 x0 = *(const u32x4*)(OBT + (size_t)c * MT + t0 + 16 * half), x1 = *(const u32x4*)(OBT + (size_t)c * MT + t0 + 16 * half + 8);
      bf16_t* d = obs + (16 * half) * 264 + c;
      d[0] = (bf16_t)(x0.x & 0xffff); d[264] = (bf16_t)(x0.x >> 16); d[2 * 264] = (bf16_t)(x0.y & 0xffff); d[3 * 264] = (bf16_t)(x0.y >> 16);
      d[4 * 264] = (bf16_t)(x0.z & 0xffff); d[5 * 264] = (bf16_t)(x0.z >> 16); d[6 * 264] = (bf16_t)(x0.w & 0xffff); d[7 * 264] = (bf16_t)(x0.w >> 16);
      d[8 * 264] = (bf16_t)(x1.x & 0xffff); d[9 * 264] = (bf16_t)(x1.x >> 16); d[10 * 264] = (bf16_t)(x1.y & 0xffff); d[11 * 264] = (bf16_t)(x1.y >> 16);
      d[12 * 264] = (bf16_t)(x1.z & 0xffff); d[13 * 264] = (bf16_t)(x1.z >> 16); d[14 * 264] = (bf16_t)(x1.w & 0xffff); d[15 * 264] = (bf16_t)(x1.w >> 16); }
    __syncthreads();
#pragma unroll
    for (int k = 0; k < 4; ++k) {
      const int tl = 4 * w + k, row = t0 + tl;
      const u32x2 wa = *(const u32x2*)(O + (size_t)row * 768 + 4 * lane), wc = *(const u32x2*)(O + (size_t)row * 768 + 256 + 4 * lane), wd = *(const u32x2*)(O + (size_t)row * 768 + 512 + 4 * lane);
      const u32x2 wb = *(const u32x2*)(obs + tl * 264 + 4 * lane), wr = *(const u32x2*)(U + (size_t)row * UW + U_RD + 4 * lane);
      float xa[4] = {bflo(wa.x), bfhi(wa.x), bflo(wa.y), bfhi(wa.y)}, xb[4] = {bflo(wb.x), bfhi(wb.x), bflo(wb.y), bfhi(wb.y)};
      float xc[4] = {bflo(wc.x), bfhi(wc.x), bflo(wc.y), bfhi(wc.y)}, xd[4] = {bflo(wd.x), bfhi(wd.x), bflo(wd.y), bfhi(wd.y)};
      float rd[4] = {bflo(wr.x), bfhi(wr.x), bflo(wr.y), bfhi(wr.y)};
      float sa = xa[0] * xa[0] + xa[1] * xa[1] + xa[2] * xa[2] + xa[3] * xa[3];
      float sb = xb[0] * xb[0] + xb[1] * xb[1] + xb[2] * xb[2] + xb[3] * xb[3];
      float sc = xc[0] * xc[0] + xc[1] * xc[1] + xc[2] * xc[2] + xc[3] * xc[3];
      float sd = xd[0] * xd[0] + xd[1] * xd[1] + xd[2] * xd[2] + xd[3] * xd[3];
      sa = wave_sum(sa); sb = wave_sum(sb); sc = wave_sum(sc);
#pragma unroll
      for (int o = 8; o >= 1; o >>= 1) sd += __shfl_xor(sd, o, 64);
      const float ra = rsqrtf(sa * (1.f / 256.f) + EPSF), rb = rsqrtf(sb * (1.f / 256.f) + EPSF), rc = rsqrtf(sc * (1.f / 256.f) + EPSF), rdn = rsqrtf(sd * (1.f / 64.f) + EPSF);
      const f32x4 ga = *(const f32x4*)(mg + 4 * lane), gb = *(const f32x4*)(mg + 256 + 4 * lane), gc = *(const f32x4*)(mg + 512 + 4 * lane), gd = *(const f32x4*)(mg + 768 + 4 * lane);
      float ya[4], yb[4], yc[4], yd[4];
#pragma unroll
      for (int e = 0; e < 4; ++e) { ya[e] = xa[e] * ra * ga[e]; yb[e] = xb[e] * rb * gb[e]; yc[e] = xc[e] * rc * gc[e]; yd[e] = xd[e] * rdn * gd[e] * (rd[e] / (1.f + __expf(-rd[e]))); }
      bf16_t* cp = cat + (size_t)row * DM + 4 * lane;
      u32x2 o;
      o.x = cvtpk(ya[0], ya[1]); o.y = cvtpk(ya[2], ya[3]); *(u32x2*)(cp) = o;
      o.x = cvtpk(yb[0], yb[1]); o.y = cvtpk(yb[2], yb[3]); *(u32x2*)(cp + 256) = o;
      o.x = cvtpk(yc[0], yc[1]); o.y = cvtpk(yc[2], yc[3]); *(u32x2*)(cp + 512) = o;
      o.x = cvtpk(yd[0], yd[1]); o.y = cvtpk(yd[2], yd[3]); *(u32x2*)(cp + 768) = o;
    }
    __syncthreads();
  }
}
#ifndef REP_ATTN
#define REP_ATTN 1
#endif
#ifndef REP_GLA
#define REP_GLA 1
#endif
#ifndef REP_HY
#define REP_HY 1
#endif

#ifndef REP_G1
#define REP_G1 1
#endif
#ifndef REP_G2
#define REP_G2 1
#endif
#ifndef REP_G3
#define REP_G3 1
#endif
#ifndef REP_N
#define REP_N 1
#endif
#ifndef REP_M1
#define REP_M1 1
#endif
#ifndef REP_M2
#define REP_M2 1
#endif
#ifndef REP_MG
#define REP_MG 1
#endif
#ifndef REP_P0
#define REP_P0 1
#endif
#ifndef REP_PP
#define REP_PP 1
#endif
#ifndef REP_SYNC
#define REP_SYNC 1
#endif

#ifdef NO_ATTN
#define ATTN(...) do{}while(0)
#else
#define ATTN(...) do { for (int rr_ = 0; rr_ < REP_ATTN; ++rr_) attn_unit(__VA_ARGS__); } while (0)
#endif
#ifdef NO_GLAA
#define GLAA(...) do{}while(0)
#else
#define GLAA(...) do { for (int rr_ = 0; rr_ < REP_GLA; ++rr_) gla_a_unit(__VA_ARGS__); } while (0)
#endif
#ifdef NO_GLAB
#define GLAB(...) do{}while(0)
#else
#define GLAB(...) do { for (int rr_ = 0; rr_ < REP_GLA; ++rr_) gla_b_unit(__VA_ARGS__); } while (0)
#endif
#ifdef NO_HY
#define HYEN(...) do{}while(0)
#else
#define HYEN(...) do { for (int rr_ = 0; rr_ < REP_HY; ++rr_) hyena_unit(__VA_ARGS__); } while (0)
#endif

DI int q_fetch(unsigned* ctr, int tid) { int v = 0; if (tid == 0) v = (int)__hip_atomic_fetch_add(ctr, 1u, __ATOMIC_RELAXED, __HIP_MEMORY_SCOPE_AGENT); return v; }
DI int q_bcast(int v, unsigned char* ldsb, int tid) {
  volatile int* slot = (volatile int*)(ldsb + LDS_CTL_OFF);
  if (tid == 0) *slot = v;
  __syncthreads();
  const int r = *slot;
  __syncthreads();
  return r;
}

#ifndef N_LAUNCH_PER_PHASE
#define N_LAUNCH_PER_PHASE 0
#endif
constexpr int NPHASE = 28;

__global__ void __launch_bounds__(512, 2) fwd_kernel(Args a_) {
  extern __shared__ __attribute__((aligned(16))) unsigned char lds[];
  cg::grid_group grid = cg::this_grid();
  if (threadIdx.x < 16) ((volatile LAS unsigned*)((LAS unsigned char*)lds + LDS_CTL_OFF))[threadIdx.x] = 0u;
  __syncthreads();
  XcdBarrier xbar = xcd_barrier_post((unsigned*)(a_.ws + WS_BAR), (volatile LAS unsigned*)((LAS unsigned char*)lds + LDS_CTL_OFF + 16));
  const int ph_hi = a_.ph_hi;
  for (int ph = a_.ph_lo; ph < ph_hi; ++ph) {
    CArgs* ap = (CArgs*)__builtin_amdgcn_kernarg_segment_ptr();
    asm volatile("" : "+s"(ap));
    CArgs& a = *ap;
    unsigned char* ws_ts = a.ws + WS_CTL + 2048;
    int tid = threadIdx.x; asm volatile("" : "+v"(tid));
    int bid = blockIdx.x; asm volatile("" : "+s"(bid));
#ifdef TS_A
    if (bid == 0 && tid == 0) ((unsigned long long*)(ws_ts))[ph] = __builtin_amdgcn_s_memrealtime();
#endif
    unsigned char* ws = a.ws;
    float* mod = (float*)(ws + WS_MOD);
    bf16_t* XN = (bf16_t*)(ws + WS_XN); bf16_t* ACT = (bf16_t*)(ws + WS_ACT); float* H = (float*)(ws + WS_H);
    if (ph == 0) {

#ifndef NO_P0
      for (int rep = 0; rep < REP_P0; ++rep) {
#ifdef TS_A
      if (bid == 0 && tid == 0) ((unsigned long long*)(ws_ts))[40] = __builtin_amdgcn_s_memrealtime();
#endif
      p0_modulation(a, lds, tid, 0, bid, gridDim.x);
#ifdef TS_A
      if (bid == 0 && tid == 0) ((unsigned long long*)(ws_ts))[41] = __builtin_amdgcn_s_memrealtime();
#endif
      p0_convert_range(a, lds, tid, 0, 352, bid, gridDim.x);
      }
#endif

    } else if (ph == NPHASE - 1) {
      for (int rep = 0; rep < REP_PP; ++rep) final_norm_phase(H, a.out, a.in[30], tid);
#ifdef TS_A
      if (bid == 0 && tid == 0) { unsigned long long* tsp = (unsigned long long*)ws_ts; tsp[NPHASE] = __builtin_amdgcn_s_memrealtime(); a.out[0] += (float)(tsp[TS_B] - tsp[TS_A]) * (0.01f / (float)TS_DIV); }
#endif
    } else {
      const int l = (ph - 1) / 13, s = (ph - 1) % 13;
      const float* mod_l = mod + (size_t)l * 3 * 9216;
      if (s == 0 || s == 3 || s == 10) {
        const int j = s == 0 ? 0 : (s == 3 ? 1 : 2);
        const bool first = (l == 0 && s == 0);
        for (int rep = 0; rep < REP_N; ++rep) norm_mod_phase(first ? a.in[0] : H, first ? a.in[1] : H + (size_t)MCTX * DM, XN, a.in[11] + (l * 3 + j) * 1024, mod_l, j, tid, first ? (const float*)(ws + WS_MODP) : nullptr, a.in[10]);
        if (first) mod_finalize(a, tid, 0);
      } else if (s == 1 || s == 11) {
        const int f = s == 1 ? 0 : 1;
        pg8::Gemm g; g.A = XN; g.Bt = (const bf16_t*)(ws + WS_WFI) + (size_t)(l * 2 + f) * 5632 * 1024; g.M = MT; g.N = 5632; g.K = 1024;
        pg8::StaticOrder S; S.init(MT, 5632, gridDim.x, bid);
        EpiSwiglu E; E.act = ACT;

#ifndef NO_G1
for (int rep = 0; rep < REP_G1; ++rep) pg8::gemm_phase<EpiSwiglu, pg8::StaticOrder, true, true>((PG8_LAS unsigned char*)lds, g, S, E);
        if (l == 0 && s == 11) {
          const int Gn = gridDim.x, nb = 880 % Gn, nidle = Gn - nb;
          if (nb > 0 && nidle >= 64) { if (bid >= nb) p0_modulation(a, lds, tid, 1, bid - nb, nidle); } else p0_modulation(a, lds, tid, 1, bid, Gn);
        }
        if (l == 0 && s == 1) {
          const int Gn = gridDim.x, nb = 880 % Gn, nidle = Gn - nb;
          if (nb > 0 && nidle >= 64) { if (bid >= nb) p0_convert_range(a, lds, tid, 352, 704, bid - nb, nidle); } else p0_convert_range(a, lds, tid, 352, 704, bid, Gn);
        }
#endif

      } else if (s == 2 || s == 9 || s == 12) {
        if (l == 0 && s == 12) mod_finalize(a, tid, 1);
        pg8::Gemm g; g.M = MT; g.N = 1024;
        EpiRes E; E.h = H; E.resA = H; E.resB = H;
        if (s == 9) { g.A = XN; g.Bt = (const bf16_t*)(ws + WS_WOUT) + (size_t)l * 1024 * 1024; g.K = 1024; E.gate = mod_l + 5 * 1024; E.coef = 1.f; }
        else { const int f = s == 2 ? 0 : 1; g.A = ACT; g.Bt = (const bf16_t*)(ws + WS_WFO) + (size_t)(l * 2 + f) * 1024 * 2816; g.K = 2816; E.gate = mod_l + (f == 0 ? 2 : 8) * 1024; E.coef = 0.5f;
          if (l == 0 && s == 2) { E.resA = a.in[0]; E.resB = a.in[1] - (size_t)MCTX * DM; } }
        pg8::StaticOrder S; S.init(MT, 1024, gridDim.x, bid);

#ifndef NO_G2
for (int rep = 0; rep < REP_G2; ++rep) { E.h = rep + 1 < REP_G2 ? (float*)(ws + WS_O) : H; pg8::gemm_phase<EpiRes, pg8::StaticOrder, true, true>((PG8_LAS unsigned char*)lds, g, S, E); }
        if (l == 0) { const int lo = s == 2 ? 704 : (s == 9 ? 1596 : 1980), hi = s == 2 ? 1296 : (s == 9 ? 1980 : 2592), Gn = gridDim.x;
          const int flo = s == 2 ? 0 : 80, fhi = s == 2 ? 80 : (s == 12 ? 160 : 80);
          if (Gn > 160) { if (bid >= 160) { p0_filters(a, lds, tid, flo, fhi, bid - 160, Gn - 160); p0_convert_range(a, lds, tid, lo, hi, Gn - 1 - bid, Gn - 160); } }
          else { p0_filters(a, lds, tid, flo, fhi, bid, Gn); p0_convert_range(a, lds, tid, lo, hi, bid, Gn); } }
#endif

      } else if (s == 4) {
        pg8::Gemm g; g.A = XN; g.Bt = (const bf16_t*)(ws + WS_WIN) + (size_t)l * NINP * 1024; g.M = MT; g.N = NINP; g.K = 1024;
        pg8::StaticOrder S; S.init(MT, NINP, gridDim.x, bid);
        EpiInproj E; E.U = ACT; E.HYT = (bf16_t*)(ws + WS_HYT); E.out = a.out; E.l = l;

#ifndef NO_G3
for (int rep = 0; rep < REP_G3; ++rep) pg8::gemm_phase<EpiInproj, pg8::StaticOrder, true, true>((PG8_LAS unsigned char*)lds, g, S, E);
        if (l == 0) { const int Gn = gridDim.x, nb = 440 % Gn, nidle = Gn - nb;
          if (nb > 0 && nidle >= 32) { if (bid >= nb) p0_convert_range(a, lds, tid, 1296, 1596, bid - nb, nidle); } else p0_convert_range(a, lds, tid, 1296, 1596, bid, Gn); }
#endif

      } else if (s == 5) {
        for (int rep = 0; rep < REP_PP; ++rep) post_proj_phase(ACT, rep + 1 < REP_PP ? (bf16_t*)nullptr : ACT, a.out, a.in[18] + l * 128, l, tid);
      } else if (s == 6) {
        for (int rep = 0; rep < REP_M1; ++rep) {
        unsigned* ctr = (unsigned*)(ws + WS_CTL) + 64 * (l * 2 + 0) + 16 * rep;
        int q = q_bcast(q_fetch(ctr, tid), lds, tid);
        for (;;) {
          if (q >= 1472) break;
          const int qn = q_fetch(ctr, tid);
          if (q < 64) { ATTN(a, l, q, lds, tid); }
          else if (q < 704) { const int j = q - 64; GLAA(a, l, j < 128 ? 512 + j : j - 128, lds, tid); }
          else if (q < 1216) { const int j = q - 704; HYEN(a, l, 0, j & 255, j < 256 ? 1 : 0, lds, tid); }
          else { ATTN(a, l, 64 + (q - 1216), lds, tid); }
          q = q_bcast(qn, lds, tid);
        }
        }
      } else if (s == 7) {
        for (int rep = 0; rep < REP_M2; ++rep) {
        unsigned* ctr = (unsigned*)(ws + WS_CTL) + 64 * (l * 2 + 1) + 16 * rep;
        int q = q_bcast(q_fetch(ctr, tid), lds, tid);
        for (;;) {
          if (q >= 1152) break;
          const int qn = q_fetch(ctr, tid);
          if (q < 640) { GLAB(a, l, q < 128 ? 512 + q : q - 128, lds, tid); }
          else { const int j = q - 640; HYEN(a, l, 1, j & 255, j < 256 ? 1 : 0, lds, tid); }
          q = q_bcast(qn, lds, tid);
        }
        }
      } else if (s == 8) {

#ifndef NO_MERGE
for (int rep = 0; rep < REP_MG; ++rep) merge_phase(a, l, lds, tid);
#endif

      }
    }
    if (ph + 1 < ph_hi) { for (int rep = 0; rep < REP_SYNC; ++rep) { if (a_.ph_lo < 0) grid.sync(); xcd_barrier(xbar); } }
  }
}

extern "C" void kernel_launch(void* const* d_in, const int* in_sizes, int n_in, void* d_out, int out_size, void* d_ws, size_t ws_size, hipStream_t stream) {
  static int grid = 0;
  if (grid == 0) {
    if (n_in != 31 || ws_size < WS_END) { fprintf(stderr, "kernel_launch: need 31 inputs and >= %zu bytes of workspace; got %d, %zu\n", (size_t)WS_END, n_in, ws_size); grid = -1; return; }
    int dev = 0, cus = 0, per_cu = 0;
    (void)hipGetDevice(&dev);
    (void)hipDeviceGetAttribute(&cus, hipDeviceAttributeMultiprocessorCount, dev);
    if (hipFuncSetAttribute((const void*)fwd_kernel, hipFuncAttributeMaxDynamicSharedMemorySize, LDS_BYTES) != hipSuccess) { fprintf(stderr, "kernel_launch: hipFuncSetAttribute failed\n"); grid = -1; return; }
    if (hipOccupancyMaxActiveBlocksPerMultiprocessor(&per_cu, (const void*)fwd_kernel, 512, LDS_BYTES) != hipSuccess || per_cu < 1) { fprintf(stderr, "kernel_launch: occupancy query says %d\n", per_cu); per_cu = 1; }
    (void)hipGetLastError();
    grid = cus * 1;
    if (grid <= 0) grid = 256;
  }
  if (grid < 0) return;
  (void)hipMemsetAsync((char*)d_ws + WS_CTL, 0, 32768, stream);
  Args a{};
  for (int i = 0; i < 31; ++i) a.in[i] = (const float*)d_in[i];
  a.out = (float*)d_out; a.ws = (unsigned char*)d_ws;
#if N_LAUNCH_PER_PHASE
  for (int ph = 0; ph < NPHASE; ++ph) { a.ph_lo = ph; a.ph_hi = ph + 1; hipLaunchKernelGGL(fwd_kernel, dim3(grid), dim3(512), LDS_BYTES, stream, a); }
#else
  a.ph_lo = 0; a.ph_hi = NPHASE;
  void* args[] = {&a};
  hipError_t e = hipLaunchCooperativeKernel((const void*)fwd_kernel, dim3(grid), dim3(512), args, LDS_BYTES, stream);
  if (e != hipSuccess) fprintf(stderr, "kernel_launch: cooperative launch failed: %s (grid %d)\n", hipGetErrorString(e), grid);
#endif
}
```
